# Optimizing an MI355X kernel written in HIP

```python
import jax, jax.numpy as jnp
from jax import lax
import numpy as np

D_MODEL = 1024
BATCH = 2
SEQ = 8192
DEPTH = 1

HEAD_DIM = 64
N_HEADS_DSA = 8
N_HEADS_FOX = 8
N_HEADS_IDX = 8
IDX_DIM = 64
TOPK_MAX = 256
Q_BLOCK = 128
D_FF = 2816
N_MOD = 9
EPS = 1e-6
FORGET_BIAS_CENTER = 3.0

WIDTH_DSA = N_HEADS_DSA * HEAD_DIM
WIDTH_FOX = N_HEADS_FOX * HEAD_DIM
IN_SIZES = (WIDTH_DSA, WIDTH_DSA, WIDTH_DSA, WIDTH_FOX, WIDTH_FOX, WIDTH_FOX,
            N_HEADS_IDX * IDX_DIM, IDX_DIM, N_HEADS_IDX, N_HEADS_FOX, D_MODEL, D_MODEL)
IN_WIDTH = 3 * WIDTH_DSA + 3 * WIDTH_FOX + N_HEADS_IDX * IDX_DIM + IDX_DIM + N_HEADS_IDX + N_HEADS_FOX + 2 * D_MODEL

kernel_name = "hybrid_dsa_fox_macaron_adaln_layer"


def rms_norm(x, g):
    xf = x.astype(jnp.float32)
    y = xf * lax.rsqrt(jnp.mean(xf * xf, axis=-1, keepdims=True) + EPS)
    return (y * g.astype(jnp.float32)).astype(x.dtype)


def swiglu(h, wg, wu, wd):
    return (jax.nn.silu(h @ wg) * (h @ wu)) @ wd


def split_columns(z):
    parts, start = [], 0
    for width in IN_SIZES:
        parts.append(z[..., start:start + width])
        start += width
    return parts


def alibi_slopes(n):
    return jnp.exp2(-8.0 * jnp.arange(1, n + 1, dtype=jnp.float32) / n)


def to_blocks(a):
    b, s = a.shape[0], a.shape[1]
    return jnp.moveaxis(a.reshape(b, s // Q_BLOCK, Q_BLOCK, *a.shape[2:]), 1, 0)


def from_blocks(a):
    a = jnp.moveaxis(a, 0, 1)
    return a.reshape(a.shape[0], a.shape[1] * a.shape[2], *a.shape[3:])


def dsa_attention(q, k, v, q_idx, k_idx, w_idx):
    b, s, h, dh = q.shape
    n_keys = s
    topk = min(TOPK_MAX, n_keys // 4)
    slopes = alibi_slopes(h)
    s_pos = jnp.arange(s)
    k_idx32 = k_idx.astype(jnp.float32)

    def block_fn(args):
        blk, qb, qib, wib = args
        t_pos = blk * Q_BLOCK + jnp.arange(Q_BLOCK)
        rel = jax.nn.relu(jnp.einsum('btid,bsd->btis', qib.astype(jnp.float32), k_idx32))
        score = jnp.einsum('btis,bti->bts', rel, wib.astype(jnp.float32))
        causal = s_pos[None, :] <= t_pos[:, None]
        score = jnp.where(causal[None], score, -jnp.inf)
        _, sel = lax.top_k(score, topk)
        flat = sel.reshape(b, Q_BLOCK * topk)
        k_sel = jax.vmap(lambda kk, ii: kk[ii])(k, flat).reshape(b, Q_BLOCK, topk, h, dh)
        v_sel = jax.vmap(lambda vv, ii: vv[ii])(v, flat).reshape(b, Q_BLOCK, topk, h, dh)
        logits = jnp.einsum('bthd,btkhd->bthk', qb, k_sel).astype(jnp.float32)
        dist = (t_pos[None, :, None] - sel).astype(jnp.float32)
        logits = logits - slopes[None, None, :, None] * dist[:, :, None, :]
        valid = sel <= t_pos[None, :, None]
        logits = jnp.where(valid[:, :, None, :], logits, -jnp.inf)
        p = jax.nn.softmax(logits, axis=-1).astype(v.dtype)
        return jnp.einsum('bthk,btkhd->bthd', p, v_sel)

    nb = s // Q_BLOCK
    out = lax.map(block_fn, (jnp.arange(nb), to_blocks(q), to_blocks(q_idx), to_blocks(w_idx)))
    return from_blocks(out)


def fox_attention(q, k, v, log_f):
    b, s, h, dh = q.shape
    F = jnp.cumsum(log_f, axis=1)
    F_keys = jnp.swapaxes(F, 1, 2)
    s_pos = jnp.arange(s)

    def block_fn(args):
        blk, qb, Fb = args
        t_pos = blk * Q_BLOCK + jnp.arange(Q_BLOCK)
        logits = jnp.einsum('bthd,bshd->bhts', qb, k).astype(jnp.float32)
        logits = logits + jnp.swapaxes(Fb, 1, 2)[..., None] - F_keys[:, :, None, :]
        causal = s_pos[None, :] <= t_pos[:, None]
        logits = jnp.where(causal[None, None], logits, -jnp.inf)
        p = jax.nn.softmax(logits, axis=-1).astype(v.dtype)
        return jnp.einsum('bhts,bshd->bthd', p, v)

    nb = s // Q_BLOCK
    out = lax.map(block_fn, (jnp.arange(nb), to_blocks(q), to_blocks(F)))
    return from_blocks(out)


def token_mix(h, w_in, b_forget, qn_dsa, kn_dsa, qn_fox, kn_fox, w_br_dsa, w_br_fox, w_out):
    b, s, _ = h.shape
    z = h @ w_in
    (qa, ka, va, qf, kf, vf, qi, ki, wi, fpre, ga, gb) = split_columns(z)
    scale = HEAD_DIM ** -0.5
    qa = rms_norm(qa.reshape(b, s, N_HEADS_DSA, HEAD_DIM), qn_dsa) * scale
    ka = rms_norm(ka.reshape(b, s, N_HEADS_DSA, HEAD_DIM), kn_dsa)
    va = va.reshape(b, s, N_HEADS_DSA, HEAD_DIM)
    qf = rms_norm(qf.reshape(b, s, N_HEADS_FOX, HEAD_DIM), qn_fox) * scale
    kf = rms_norm(kf.reshape(b, s, N_HEADS_FOX, HEAD_DIM), kn_fox)
    vf = vf.reshape(b, s, N_HEADS_FOX, HEAD_DIM)
    qi = qi.reshape(b, s, N_HEADS_IDX, IDX_DIM) * (IDX_DIM ** -0.5)
    wi = wi * (N_HEADS_IDX ** -0.5)
    log_f = jax.nn.log_sigmoid(fpre.astype(jnp.float32) + b_forget.astype(jnp.float32))

    y_dsa = dsa_attention(qa, ka, va, qi, ki, wi).reshape(b, s, WIDTH_DSA) @ w_br_dsa
    y_fox = fox_attention(qf, kf, vf, log_f).reshape(b, s, WIDTH_FOX) @ w_br_fox
    merged = jax.nn.sigmoid(ga) * y_dsa + jax.nn.sigmoid(gb) * y_fox
    return merged @ w_out


def setup_inputs(seed: int = 0) -> dict:
    key = jax.random.key(seed)
    ks = jax.random.split(key, 24)
    f32 = jnp.float32

    def w(k, shape, fan_in, scale=1.0):
        return scale * (fan_in ** -0.5) * jax.random.normal(k, shape, f32)

    def gain(k, shape):
        return 1.0 + 0.02 * jax.random.normal(k, shape, f32)

    L = DEPTH
    return {
        "x": jax.random.normal(ks[0], (BATCH, SEQ, D_MODEL), f32),
        "c": jax.random.normal(ks[1], (BATCH, D_MODEL), f32),
        "ada_w": w(ks[2], (L, D_MODEL, N_MOD * D_MODEL), D_MODEL, 0.5),
        "ada_b": 0.02 * jax.random.normal(ks[3], (L, N_MOD * D_MODEL), f32),
        "norm1_g": gain(ks[4], (L, D_MODEL)),
        "ffn1_wg": w(ks[5], (L, D_MODEL, D_FF), D_MODEL),
        "ffn1_wu": w(ks[6], (L, D_MODEL, D_FF), D_MODEL),
        "ffn1_wd": w(ks[7], (L, D_FF, D_MODEL), D_FF),
        "norm2_g": gain(ks[8], (L, D_MODEL)),
        "w_in": w(ks[9], (L, D_MODEL, IN_WIDTH), D_MODEL),
        "b_forget": FORGET_BIAS_CENTER + 0.5 * jax.random.normal(ks[10], (L, N_HEADS_FOX), f32),
        "qn_dsa": gain(ks[11], (L, HEAD_DIM)),
        "kn_dsa": gain(ks[12], (L, HEAD_DIM)),
        "qn_fox": gain(ks[13], (L, HEAD_DIM)),
        "kn_fox": gain(ks[14], (L, HEAD_DIM)),
        "w_br_dsa": w(ks[15], (L, WIDTH_DSA, D_MODEL), WIDTH_DSA),
        "w_br_fox": w(ks[16], (L, WIDTH_FOX, D_MODEL), WIDTH_FOX),
        "w_out": w(ks[17], (L, D_MODEL, D_MODEL), D_MODEL),
        "norm3_g": gain(ks[18], (L, D_MODEL)),
        "ffn2_wg": w(ks[19], (L, D_MODEL, D_FF), D_MODEL),
        "ffn2_wu": w(ks[20], (L, D_MODEL, D_FF), D_MODEL),
        "ffn2_wd": w(ks[21], (L, D_FF, D_MODEL), D_FF),
    }


def reference(x, c, ada_w, ada_b, norm1_g, ffn1_wg, ffn1_wu, ffn1_wd, norm2_g, w_in, b_forget,
              qn_dsa, kn_dsa, qn_fox, kn_fox, w_br_dsa, w_br_fox, w_out, norm3_g,
              ffn2_wg, ffn2_wu, ffn2_wd):
    b = x.shape[0]
    for l in range(DEPTH):
        mod = (jax.nn.silu(c) @ ada_w[l] + ada_b[l]).reshape(b, N_MOD, 1, D_MODEL)
        sh1, sc1, g1 = mod[:, 0], mod[:, 1], mod[:, 2]
        sh2, sc2, g2 = mod[:, 3], mod[:, 4], mod[:, 5]
        sh3, sc3, g3 = mod[:, 6], mod[:, 7], mod[:, 8]
        h = rms_norm(x, norm1_g[l]) * (1.0 + sc1) + sh1
        x = x + 0.5 * g1 * swiglu(h, ffn1_wg[l], ffn1_wu[l], ffn1_wd[l])
        h = rms_norm(x, norm2_g[l]) * (1.0 + sc2) + sh2
        x = x + g2 * token_mix(h, w_in[l], b_forget[l], qn_dsa[l], kn_dsa[l], qn_fox[l], kn_fox[l],
                               w_br_dsa[l], w_br_fox[l], w_out[l])
        h = rms_norm(x, norm3_g[l]) * (1.0 + sc3) + sh3
        x = x + 0.5 * g3 * swiglu(h, ffn2_wg[l], ffn2_wu[l], ffn2_wd[l])
    return x
```

```cpp
#include <hip/hip_runtime.h>
#include <cstdio>
#include <cstdint>
#include <cmath>
#ifndef MK_N_LAUNCHES
#define MK_N_LAUNCHES 1
#endif
namespace pg8 {
#define PG8_LAS __attribute__((address_space(3)))
typedef unsigned short bf16_t;
typedef short bf16x8 __attribute__((ext_vector_type(8)));
typedef float f32x4 __attribute__((ext_vector_type(4)));
typedef unsigned u32x4 __attribute__((ext_vector_type(4)));
constexpr int BM = 256, BK = 64, HALF = 128, HTB = HALF * BK * 2  , STAGE_BYTES = 8 * HTB, NXCD = 8, WGM = 8;

__host__ __device__ __forceinline__ int lds_byte(int r, int c) { const int st = (r >> 4) * 2 + (c >> 5), rr = r & 15, cc = c & 31, ob = rr * 64 + cc * 2; return st * 1024 + (ob ^ (((ob >> 9) & 1) << 5)); }
__host__ __device__ __forceinline__ void stage_rc(int b, int& R, int& C) { const int st = b / 1024, sb = b % 1024, swz = sb ^ (((sb >> 9) & 1) << 5); R = (st >> 1) * 16 + swz / 64; C = (st & 1) * 32 + (swz % 64) / 2; }
__host__ __device__ __forceinline__ int perm32(int rho) { const int n = rho >> 4, i = rho & 15; return 8 * (i >> 2) + 4 * n + (i & 3); }

struct Unit { int pm, pn; };
struct Gemm { const bf16_t* A; const bf16_t* Bt; int M, N, K; };

struct StaticOrder {
    int nM, nN, nwg, G, c;
    __host__ __device__ void init(int M, int N, int G_, int c_) { nM = M / BM; nN = N / BM; nwg = nM * nN; G = G_; c = c_; }
    __host__ __device__ bool next(int i, Unit& u) const {
        const long L = (long)i * G + c; if (L >= nwg) return false;
        int wgid = (int)L; { const int q = nwg / NXCD, r = nwg % NXCD, xcd = wgid % NXCD, off = wgid / NXCD; wgid = (xcd < r ? xcd * (q + 1) : r * (q + 1) + (xcd - r) * q) + off; }
        const int nig = WGM * nN, gid = wgid / nig, fm = gid * WGM, gsz = (nM - fm) < WGM ? (nM - fm) : WGM;
        u.pm = fm + ((wgid % nig) % gsz); u.pn = (wgid % nig) / gsz; return true;
    }
    __device__ __forceinline__ void a_ready(const Unit&) const {}
    __device__ __forceinline__ void done(const Unit&) const {}
};

typedef float f32x2c_t __attribute__((ext_vector_type(2))); typedef __bf16 bf16x2c_t __attribute__((ext_vector_type(2)));
__device__ __forceinline__ unsigned cvt_pk_bf16(float lo, float hi) { f32x2c_t v = {lo, hi}; bf16x2c_t b = __builtin_convertvector(v, bf16x2c_t); return __builtin_bit_cast(unsigned, b); }
typedef float f32x2 __attribute__((ext_vector_type(2)));
__device__ __forceinline__ float sigmoidf_fast(float v) { return __builtin_amdgcn_rcpf(1.f + __builtin_amdgcn_exp2f(-1.4426950408889634f * v)); }
__device__ __forceinline__ float bf_lo(unsigned w) { return __builtin_bit_cast(float, w << 16); }
__device__ __forceinline__ float bf_hi(unsigned w) { return __builtin_bit_cast(float, w & 0xffff0000u); }

struct EpiSwiglu {
    static constexpr bool PERM = true, AFTER_DRAIN = false;
    bf16_t* O; int ldc;
    __device__ __forceinline__ void operator()(const f32x4 (&acc)[2][2][4][2], const Unit& u, int wr, int wc, int fr, int fq) const {
        const int row0 = u.pm * BM + wr * 64 + fr, col0 = u.pn * HALF + wc * 32 + 8 * fq;
#pragma unroll
        for (int ai = 0; ai < 2; ++ai)
#pragma unroll
            for (int m = 0; m < 4; ++m) { bf16_t* rowp = O + (size_t)(row0 + ai * HALF + m * 16) * ldc + col0;
                f32x4 v[2];
#pragma unroll
                for (int n = 0; n < 2; ++n) { const f32x4 g = acc[ai][0][m][n], up = acc[ai][1][m][n];
#pragma unroll
                    for (int e = 0; e < 4; ++e) v[n][e] = g[e] * sigmoidf_fast(g[e]) * up[e]; }
                u32x4 w; w.x = cvt_pk_bf16(v[0][0], v[0][1]); w.y = cvt_pk_bf16(v[0][2], v[0][3]); w.z = cvt_pk_bf16(v[1][0], v[1][1]); w.w = cvt_pk_bf16(v[1][2], v[1][3]);
                *(u32x4*)rowp = w; }
    }
};

struct EpiResid {
    static constexpr bool PERM = false, AFTER_DRAIN = false;
    const float* base; float* out; const float* gate; float coef;
    __device__ __forceinline__ void operator()(const f32x4 (&acc)[2][2][4][2], const Unit& u, int wr, int wc, int fr, int fq) const {
        const int row0 = u.pm * BM + wr * 64 + fr, col0 = u.pn * BM + wc * 32 + 4 * fq;
        const float* gp = gate + (size_t)(u.pm / 32) * 9216 + col0;
        f32x4 gv[2][2];
#pragma unroll
        for (int bj = 0; bj < 2; ++bj)
#pragma unroll
            for (int n = 0; n < 2; ++n) gv[bj][n] = *(const f32x4*)(gp + bj * HALF + n * 16) * coef;
#pragma unroll
        for (int ai = 0; ai < 2; ++ai)
#pragma unroll
            for (int m = 0; m < 4; ++m) { const size_t off = (size_t)(row0 + ai * HALF + m * 16) * 1024 + col0;
#pragma unroll
                for (int bj = 0; bj < 2; ++bj)
#pragma unroll
                    for (int n = 0; n < 2; ++n) { const f32x4 bs = *(const f32x4*)(base + off + bj * HALF + n * 16);
                        *(f32x4*)(out + off + bj * HALF + n * 16) = bs + gv[bj][n] * acc[ai][bj][m][n]; } }
    }
};

struct EpiGate {
    static constexpr bool PERM = true, AFTER_DRAIN = false;
    bf16_t* O;
    __device__ __forceinline__ void operator()(const f32x4 (&acc)[2][2][4][2], const Unit& u, int wr, int wc, int fr, int fq) const {
        const int row0 = u.pm * BM + wr * 64 + fr, col0 = u.pn * BM + wc * 32 + 8 * fq;
#pragma unroll
        for (int ai = 0; ai < 2; ++ai)
#pragma unroll
            for (int m = 0; m < 4; ++m) { bf16_t* rowp = O + (size_t)(row0 + ai * HALF + m * 16) * 2048 + col0;
#pragma unroll
                for (int bj = 0; bj < 2; ++bj) { f32x4 v0 = acc[ai][bj][m][0], v1 = acc[ai][bj][m][1];
#pragma unroll
                    for (int e = 0; e < 4; ++e) { v0[e] = sigmoidf_fast(v0[e]); v1[e] = sigmoidf_fast(v1[e]); }
                    u32x4 w; w.x = cvt_pk_bf16(v0[0], v0[1]); w.y = cvt_pk_bf16(v0[2], v0[3]); w.z = cvt_pk_bf16(v1[0], v1[1]); w.w = cvt_pk_bf16(v1[2], v1[3]);
                    *(u32x4*)(rowp + bj * HALF) = w; } }
    }
};

struct EpiMerge {
    static constexpr bool PERM = true, AFTER_DRAIN = false;
    const bf16_t* SG; bf16_t* O;
    __device__ __forceinline__ void operator()(const f32x4 (&acc)[2][2][4][2], const Unit& u, int wr, int wc, int fr, int fq) const {
        const int row0 = u.pm * BM + wr * 64 + fr, col0 = u.pn * HALF + wc * 32 + 8 * fq;
#pragma unroll
        for (int ai = 0; ai < 2; ++ai)
#pragma unroll
            for (int m = 0; m < 4; ++m) { const size_t r = (size_t)(row0 + ai * HALF + m * 16);
                const u32x4 ga = *(const u32x4*)(SG + r * 2048 + col0), gb = *(const u32x4*)(SG + r * 2048 + 1024 + col0);
                const f32x4 a0 = acc[ai][0][m][0], a1 = acc[ai][0][m][1], b0 = acc[ai][1][m][0], b1 = acc[ai][1][m][1];
                u32x4 w;
                w.x = cvt_pk_bf16(bf_lo(ga.x) * a0[0] + bf_lo(gb.x) * b0[0], bf_hi(ga.x) * a0[1] + bf_hi(gb.x) * b0[1]);
                w.y = cvt_pk_bf16(bf_lo(ga.y) * a0[2] + bf_lo(gb.y) * b0[2], bf_hi(ga.y) * a0[3] + bf_hi(gb.y) * b0[3]);
                w.z = cvt_pk_bf16(bf_lo(ga.z) * a1[0] + bf_lo(gb.z) * b1[0], bf_hi(ga.z) * a1[1] + bf_hi(gb.z) * b1[1]);
                w.w = cvt_pk_bf16(bf_lo(ga.w) * a1[2] + bf_lo(gb.w) * b1[2], bf_hi(ga.w) * a1[3] + bf_hi(gb.w) * b1[3]);
                *(u32x4*)(O + r * 1024 + col0) = w; }
    }
};

struct EpiInA {
    static constexpr bool PERM = true, AFTER_DRAIN = false;
    bf16_t *QKV; bf16_t *QI, *KI; float *WI, *LF;
    const float *gains;
    __device__ __forceinline__ void operator()(const f32x4 (&acc)[2][2][4][2], const Unit& u, int wr, int wc, int fr, int fq) const {
        const int row0 = u.pm * BM + wr * 64 + fr, pn = u.pn;
        const int sec = pn >> 1;
        if (sec == 0 || sec == 1 || sec == 3 || sec == 4) {
            const bool isq = (sec == 0 || sec == 3), isfox = (sec >= 3);
            const float* gain = gains + 64 * (sec - (isfox ? 1 : 0));
            bf16_t* dst = QKV + (isq ? (size_t)0 : (size_t)16777216) + (isfox ? 512 : 0) + ((pn & 1) * 4 + wc) * 64 + 8 * fq;
            const float post = isq ? 0.125f * 1.4426950408889634f : 1.0f;
            f32x4 gv[2][2];
#pragma unroll
            for (int bj = 0; bj < 2; ++bj)
#pragma unroll
                for (int n = 0; n < 2; ++n) gv[bj][n] = *(const f32x4*)(gain + 32 * bj + 8 * fq + 4 * n) * post;
#pragma unroll
            for (int ai = 0; ai < 2; ++ai)
#pragma unroll
                for (int m = 0; m < 4; ++m) {
                    float ss = 0.f;
#pragma unroll
                    for (int bj = 0; bj < 2; ++bj)
#pragma unroll
                        for (int n = 0; n < 2; ++n) { const f32x4 x = acc[ai][bj][m][n]; ss += (x[0] * x[0] + x[1] * x[1]) + (x[2] * x[2] + x[3] * x[3]); }
                    ss += __shfl_xor(ss, 16); ss += __shfl_xor(ss, 32);
                    const float rstd = __builtin_amdgcn_rsqf(ss * (1.0f / 64.0f) + 1e-6f);
                    bf16_t* rowp = dst + (size_t)(row0 + ai * HALF + m * 16) * 1024;
#pragma unroll
                    for (int bj = 0; bj < 2; ++bj) { const f32x4 v0 = acc[ai][bj][m][0] * rstd * gv[bj][0], v1 = acc[ai][bj][m][1] * rstd * gv[bj][1];
                        u32x4 w; w.x = cvt_pk_bf16(v0[0], v0[1]); w.y = cvt_pk_bf16(v0[2], v0[3]); w.z = cvt_pk_bf16(v1[0], v1[1]); w.w = cvt_pk_bf16(v1[2], v1[3]);
                        *(u32x4*)(rowp + 32 * bj) = w; } }
        } else if (sec == 2 || sec == 5 || sec == 6) {
            bf16_t* dst; int ld; float sc = 1.f;
            if (sec == 6) { dst = QI + (pn & 1) * 256; ld = 512; sc = 0.125f; } else { dst = QKV + (size_t)33554432 + (sec == 5 ? 512 : 0) + (pn & 1) * 256; ld = 1024; }
            dst += wc * 32 + 8 * fq;
#pragma unroll
            for (int ai = 0; ai < 2; ++ai)
#pragma unroll
                for (int m = 0; m < 4; ++m) { bf16_t* rowp = dst + (size_t)(row0 + ai * HALF + m * 16) * ld;
#pragma unroll
                    for (int bj = 0; bj < 2; ++bj) { const f32x4 v0 = acc[ai][bj][m][0] * sc, v1 = acc[ai][bj][m][1] * sc;
                        u32x4 w; w.x = cvt_pk_bf16(v0[0], v0[1]); w.y = cvt_pk_bf16(v0[2], v0[3]); w.z = cvt_pk_bf16(v1[0], v1[1]); w.w = cvt_pk_bf16(v1[2], v1[3]);
                        *(u32x4*)(rowp + bj * HALF) = w; } }
        } else {
            if (wc < 2) {
#pragma unroll
                for (int ai = 0; ai < 2; ++ai)
#pragma unroll
                    for (int m = 0; m < 4; ++m) { const f32x4 v0 = acc[ai][0][m][0], v1 = acc[ai][0][m][1];
                        u32x4 w; w.x = cvt_pk_bf16(v0[0], v0[1]); w.y = cvt_pk_bf16(v0[2], v0[3]); w.z = cvt_pk_bf16(v1[0], v1[1]); w.w = cvt_pk_bf16(v1[2], v1[3]);
                        *(u32x4*)(KI + (size_t)(row0 + ai * HALF + m * 16) * 64 + wc * 32 + 8 * fq) = w; }
            } else if (wc == 2 && fq == 0) {
#pragma unroll
                for (int ai = 0; ai < 2; ++ai)
#pragma unroll
                    for (int m = 0; m < 4; ++m) { float* p = WI + (size_t)(row0 + ai * HALF + m * 16) * 8;
                        *(f32x4*)p = acc[ai][0][m][0] * 0.35355339059327373f; *(f32x4*)(p + 4) = acc[ai][0][m][1] * 0.35355339059327373f; }
            } else if (wc == 2 && fq == 1) {
                const f32x4 bf0 = *(const f32x4*)(gains + 256), bf1 = *(const f32x4*)(gains + 260);
#pragma unroll
                for (int ai = 0; ai < 2; ++ai)
#pragma unroll
                    for (int m = 0; m < 4; ++m) { const int row = row0 + ai * HALF + m * 16; float* p = LF + (size_t)(row >> 13) * 65536 + (row & 8191);
#pragma unroll
                        for (int n = 0; n < 2; ++n)
#pragma unroll
                            for (int e = 0; e < 4; ++e) { const float x = acc[ai][0][m][n][e] + (n ? bf1[e] : bf0[e]);
                                const float ls = fminf(x, 0.f) - __logf(1.f + __expf(-fabsf(x)));
                                p[(size_t)(4 * n + e) * 8192] = ls; } }
            }
        }
    }
};
template <class Epi, class Sched, bool ALIGN_EPI = false, bool SP2 = false>
__device__ __forceinline__ void gemm_phase(PG8_LAS unsigned char* lds, const Gemm g, const Sched& S, const Epi& E) {
    const int tid = threadIdx.x, wid = __builtin_amdgcn_readfirstlane(tid >> 6), lane = tid & 63, wr = wid >> 2, wc = wid & 3, fr = lane & 15, fq = lane >> 4;
    const int K = g.K, nt = K / BK;
    unsigned voffA[2], voffB[2];
#pragma unroll
    for (int i = 0; i < 2; ++i) { int R, C; stage_rc(tid * 16 + i * 8192, R, C); const int Rb = Epi::PERM ? ((R & ~31) + perm32(R & 31)) : R;
        voffA[i] = (unsigned)(R * K + C) * 2u; voffB[i] = (unsigned)(Rb * K + C) * 2u; }
    const size_t kstep = (size_t)(BK * 2);
    const size_t hstep = (size_t)HALF * K * 2;
    const size_t tstep = 2 * hstep;
    const unsigned ldsw = (unsigned)wid * 1024u;
    const int aoff = lds_byte(wr * 64 + fr, fq * 8), boff = lds_byte(wc * 32 + fr, fq * 8);
#define PG8_SA(b, h) (((b) * 2 + (h)) * HTB)
#define PG8_SB(b, h) ((4 + (b) * 2 + (h)) * HTB)
#define PG8_STAGE(bufoff, gbase, voff) do { _Pragma("unroll") for (int _i = 0; _i < 2; ++_i) \
        __builtin_amdgcn_global_load_lds((const unsigned*)((const char*)(gbase) + (voff)[_i]), (PG8_LAS unsigned*)(lds + (bufoff) + ldsw + _i * 8192), 16, 0, 0); } while (0)
#define PG8_LDA(dst, b, h) do { _Pragma("unroll") for (int m = 0; m < 4; ++m) _Pragma("unroll") for (int k = 0; k < 2; ++k) dst[m][k] = *(const PG8_LAS bf16x8*)(lds + PG8_SA(b, h) + aoff + m * 2048 + k * 1024); } while (0)
#define PG8_LDB(dst, b, h) do { _Pragma("unroll") for (int n = 0; n < 2; ++n) _Pragma("unroll") for (int k = 0; k < 2; ++k) dst[n][k] = *(const PG8_LAS bf16x8*)(lds + PG8_SB(b, h) + boff + n * 2048 + k * 1024); } while (0)
#define PG8_MMA(ai, bj, At, Bt) do { __builtin_amdgcn_s_setprio(1); _Pragma("unroll") for (int m = 0; m < 4; ++m) _Pragma("unroll") for (int n = 0; n < 2; ++n) _Pragma("unroll") for (int k = 0; k < 2; ++k) \
        acc[ai][bj][m][n] = __builtin_amdgcn_mfma_f32_16x16x32_bf16(Bt[n][k], At[m][k], acc[ai][bj][m][n], 0, 0, 0); __builtin_amdgcn_s_setprio(0); } while (0)
#define PG8_WAIT_V(n) asm volatile("s_waitcnt vmcnt(" #n ")" ::: "memory")
#define PG8_WAIT_L(n) asm volatile("s_waitcnt lgkmcnt(" #n ")" ::: "memory")
#define PG8_BAR __builtin_amdgcn_s_barrier()
#define PG8_SCHED __builtin_amdgcn_sched_barrier(0)
    Unit cur, nxt; int ui = 0;
    if (!S.next(0, cur)) return;
    f32x4 acc[2][2][4][2];
#pragma unroll
    for (int a = 0; a < 2; ++a)
#pragma unroll
        for (int b = 0; b < 2; ++b)
#pragma unroll
            for (int m = 0; m < 4; ++m)
#pragma unroll
                for (int n = 0; n < 2; ++n) acc[a][b][m][n] = (f32x4){0.f, 0.f, 0.f, 0.f};
    bf16x8 At[4][2], B0[2][2], B1[2][2];
    const char* cA = (const char*)g.A + (size_t)cur.pm * tstep; const char* cB = (const char*)g.Bt + (size_t)cur.pn * tstep;
    S.a_ready(cur);
    if constexpr (SP2) {
        PG8_STAGE(PG8_SB(0, 0), cB, voffB); PG8_STAGE(PG8_SB(0, 1), cB + hstep, voffB); PG8_STAGE(PG8_SA(0, 0), cA, voffA); PG8_STAGE(PG8_SA(0, 1), cA + hstep, voffA);
        if (wr == 1) PG8_BAR;
        PG8_WAIT_V(2); PG8_BAR;
        PG8_STAGE(PG8_SB(1, 0), cB + kstep, voffB); PG8_STAGE(PG8_SA(1, 0), cA + kstep, voffA); PG8_STAGE(PG8_SB(1, 1), cB + hstep + kstep, voffB);
        PG8_WAIT_V(6); PG8_BAR;
    } else {
        PG8_STAGE(PG8_SB(0, 0), cB, voffB); PG8_STAGE(PG8_SA(0, 0), cA, voffA); PG8_STAGE(PG8_SB(0, 1), cB + hstep, voffB); PG8_STAGE(PG8_SA(0, 1), cA + hstep, voffA);
        if (wr == 1) PG8_BAR;
        PG8_WAIT_V(4); PG8_BAR;
        PG8_STAGE(PG8_SB(1, 0), cB + kstep, voffB); PG8_STAGE(PG8_SA(1, 0), cA + kstep, voffA); PG8_STAGE(PG8_SB(1, 1), cB + hstep + kstep, voffB);
        PG8_WAIT_V(6); PG8_BAR;
    }
    for (;;) {
        const bool has_next = S.next(ui + 1, nxt);
        const char* nA = has_next ? (const char*)g.A + (size_t)nxt.pm * tstep : cA; const char* nB = has_next ? (const char*)g.Bt + (size_t)nxt.pn * tstep : cB;
        for (int t = 0; t < nt; t += 2) {
            const bool last = (t == nt - 2);
            const char* a1 = cA + (size_t)(t + 1) * kstep;
            const char* a2 = last ? nA : cA + (size_t)(t + 2) * kstep; const char* b2 = last ? nB : cB + (size_t)(t + 2) * kstep;
            const char* a3 = a2 + kstep; const char* b3 = b2 + kstep;
            if (last && has_next) S.a_ready(nxt);
            if constexpr (SP2) {
            PG8_LDB(B0, 0, 0); PG8_LDB(B1, 0, 1); PG8_SCHED; PG8_LDA(At, 0, 0); PG8_STAGE(PG8_SA(1, 1), a1 + hstep, voffA);
            PG8_WAIT_V(8); PG8_WAIT_L(0); PG8_BAR; PG8_MMA(0, 0, At, B0); PG8_MMA(0, 1, At, B1); PG8_BAR; PG8_SCHED;
            PG8_LDA(At, 0, 1); PG8_STAGE(PG8_SB(0, 0), b2, voffB); PG8_STAGE(PG8_SB(0, 1), b2 + hstep, voffB); PG8_STAGE(PG8_SA(0, 0), a2, voffA);
            PG8_WAIT_V(8); PG8_WAIT_L(0); PG8_BAR; PG8_MMA(1, 0, At, B0); PG8_MMA(1, 1, At, B1); PG8_BAR; PG8_SCHED;
            PG8_LDB(B0, 1, 0); PG8_LDB(B1, 1, 1); PG8_SCHED; PG8_LDA(At, 1, 0); PG8_STAGE(PG8_SA(0, 1), a2 + hstep, voffA);
            PG8_WAIT_V(8); PG8_WAIT_L(0); PG8_BAR; PG8_MMA(0, 0, At, B0); PG8_MMA(0, 1, At, B1); PG8_BAR; PG8_SCHED;
            PG8_LDA(At, 1, 1); PG8_STAGE(PG8_SB(1, 0), b3, voffB); PG8_STAGE(PG8_SB(1, 1), b3 + hstep, voffB); PG8_STAGE(PG8_SA(1, 0), a3, voffA);
            PG8_WAIT_V(8); PG8_WAIT_L(0); PG8_BAR; PG8_MMA(1, 0, At, B0); PG8_MMA(1, 1, At, B1); PG8_BAR; PG8_SCHED;
            } else {
            PG8_LDB(B0, 0, 0); PG8_SCHED; PG8_LDA(At, 0, 0); PG8_STAGE(PG8_SA(1, 1), a1 + hstep, voffA);
            PG8_WAIT_L(8); PG8_BAR; PG8_WAIT_L(0); PG8_MMA(0, 0, At, B0); PG8_BAR; PG8_SCHED;
            PG8_LDB(B1, 0, 1); PG8_STAGE(PG8_SB(0, 0), b2, voffB);
            PG8_BAR; PG8_WAIT_L(0); PG8_MMA(0, 1, At, B1); PG8_BAR;
            PG8_LDA(At, 0, 1); PG8_STAGE(PG8_SA(0, 0), a2, voffA);
            PG8_BAR; PG8_WAIT_L(0); PG8_MMA(1, 0, At, B0); PG8_BAR; PG8_SCHED;
            PG8_STAGE(PG8_SB(0, 1), b2 + hstep, voffB);
            PG8_WAIT_V(6); PG8_BAR; PG8_MMA(1, 1, At, B1); PG8_BAR;
            PG8_LDB(B0, 1, 0); PG8_SCHED; PG8_LDA(At, 1, 0); PG8_STAGE(PG8_SA(0, 1), a2 + hstep, voffA);
            PG8_WAIT_L(8); PG8_BAR; PG8_WAIT_L(0); PG8_MMA(0, 0, At, B0); PG8_BAR; PG8_SCHED;
            PG8_LDB(B1, 1, 1); PG8_STAGE(PG8_SB(1, 0), b3, voffB);
            PG8_BAR; PG8_WAIT_L(0); PG8_MMA(0, 1, At, B1); PG8_BAR;
            PG8_LDA(At, 1, 1); PG8_STAGE(PG8_SA(1, 0), a3, voffA);
            PG8_BAR; PG8_WAIT_L(0); PG8_MMA(1, 0, At, B0); PG8_BAR; PG8_SCHED;
            PG8_STAGE(PG8_SB(1, 1), b3 + hstep, voffB);
            PG8_WAIT_V(6); PG8_BAR; PG8_MMA(1, 1, At, B1); PG8_BAR;
            }
        }
        if constexpr (ALIGN_EPI) { if (wr == 0) PG8_BAR; }
        if constexpr (!Epi::AFTER_DRAIN) { E(acc, cur, wr, wc, fr, fq); S.done(cur); }
        if (!has_next) break;
#pragma unroll
        for (int a = 0; a < 2; ++a)
#pragma unroll
            for (int b = 0; b < 2; ++b)
#pragma unroll
                for (int m = 0; m < 4; ++m)
#pragma unroll
                    for (int n = 0; n < 2; ++n) acc[a][b][m][n] = (f32x4){0.f, 0.f, 0.f, 0.f};
        cur = nxt; cA = nA; cB = nB; ++ui;
        if constexpr (ALIGN_EPI) { if (wr == 1) PG8_BAR; }
    }
    PG8_WAIT_V(0);
    if constexpr (!ALIGN_EPI) { if (wr == 0) PG8_BAR; }
    PG8_BAR;
    if constexpr (Epi::AFTER_DRAIN) { E.fused(acc, cur, wr, wc, fr, fq, lds, wid, lane); S.done(cur); }
#undef PG8_SA
#undef PG8_SB
#undef PG8_STAGE
#undef PG8_LDA
#undef PG8_LDB
#undef PG8_MMA
#undef PG8_WAIT_V
#undef PG8_WAIT_L
#undef PG8_BAR
#undef PG8_SCHED
}
}
namespace att {
#ifdef PROBE_ZERO_TYPE
#define PROBE_ZF(T) ((T)==PROBE_ZERO_TYPE?0.f:1.f)
#else
#define PROBE_ZF(T) 1.f
#endif
typedef unsigned short bf16_t;
using bf16x8=__attribute__((ext_vector_type(8)))short;
using s16x4=__attribute__((ext_vector_type(4)))short;
using f32x16=__attribute__((ext_vector_type(16)))float;
using f32x4=__attribute__((ext_vector_type(4)))float;
using u32x4=__attribute__((ext_vector_type(4)))unsigned;
constexpr int SEQ=8192,D=64,DM=1024;
constexpr int NW=8,QBLK=32,QB=QBLK*NW,KVBLK=64;
__device__ __forceinline__ int crow(int r,int hi){return (r&3)+8*(r>>2)+4*hi;}
#define SBAR() __builtin_amdgcn_sched_barrier(0)
__device__ __forceinline__ void cmask(f32x16&p0,f32x16&p1,int jb,int qrel,int hi){
  const float NEG=-INFINITY; int kb=64*jb+4*hi;
  #pragma unroll
  for(int r=0;r<16;++r){int kv=kb+(r&3)+8*(r>>2); if(kv>qrel)p0[r]=NEG; if(kv+32>qrel)p1[r]=NEG;}
}
constexpr int SLOTB=8192;
constexpr int LDS_K=0, LDS_V=2*SLOTB, LDS_WS=4*SLOTB, LDS_OST=LDS_WS+NW*64*4, LDS_FK=LDS_OST+NW*4096, LDS_BYTES=LDS_FK+32768;
__device__ __forceinline__ void glds16(const void*gsrc,unsigned lds_dst){unsigned keep;
  asm volatile("s_mov_b32 %0, m0\n\ts_mov_b32 m0, %2\n\ts_nop 0\n\tglobal_load_lds_dwordx4 %1, off\n\ts_mov_b32 m0, %0":"=&s"(keep):"v"(gsrc),"s"(lds_dst):"memory");}
__device__ __forceinline__ float max3f(float a,float b,float c){float r;asm("v_max3_f32 %0, %1, %2, %3":"=v"(r):"v"(a),"v"(b),"v"(c));return r;}
__device__ __forceinline__ float max2f(float a,float b){float r;asm("v_max_f32_e32 %0, %1, %2":"=v"(r):"v"(a),"v"(b));return r;}
typedef float f32x2_t __attribute__((ext_vector_type(2))); typedef __bf16 bf16x2_t __attribute__((ext_vector_type(2)));
__device__ __forceinline__ unsigned cvtpk_s(float lo,float hi){f32x2_t v={lo,hi};bf16x2_t b=__builtin_convertvector(v,bf16x2_t);return __builtin_bit_cast(unsigned,b);}
__device__ __forceinline__ void xhalf_pair(float v,float&lo,float&hi_){unsigned a=__builtin_bit_cast(unsigned,v),b=a;
  asm volatile("s_nop 1\n\tv_permlane32_swap_b32 %0, %1\n\ts_nop 1":"+v"(a),"+v"(b)); lo=__builtin_bit_cast(float,a); hi_=__builtin_bit_cast(float,b);}
__device__ __forceinline__ float xhalf_sum(float v){float lo,h;xhalf_pair(v,lo,h);return lo+h;}
__device__ __forceinline__ float xhalf_max(float v){float lo,h;xhalf_pair(v,lo,h);return __builtin_fmaxf(lo,h);}
#define WAIT_ALL_BAR() asm volatile("s_waitcnt vmcnt(0) lgkmcnt(0)\n\ts_barrier":::"memory")

__device__ __forceinline__ void qkt(f32x16&p0,f32x16&p1,const char*Kslot,const bf16x8*qr,const f32x16&cinit,int r32,int hi){
  const char*kb=Kslot+hi*1024+r32*16;
  #pragma unroll
  for(int d0=0;d0<4;++d0){
    const bf16x8 b0=*reinterpret_cast<const bf16x8*>(kb+d0*2048);
    const bf16x8 b1=*reinterpret_cast<const bf16x8*>(kb+d0*2048+512);
    if(d0==0){p0=__builtin_amdgcn_mfma_f32_32x32x16_bf16(b0,qr[0],cinit,0,0,0);p1=__builtin_amdgcn_mfma_f32_32x32x16_bf16(b1,qr[0],cinit,0,0,0);}
    else{p0=__builtin_amdgcn_mfma_f32_32x32x16_bf16(b0,qr[d0],p0,0,0,0);p1=__builtin_amdgcn_mfma_f32_32x32x16_bf16(b1,qr[d0],p1,0,0,0);}}
}
__device__ __forceinline__ float rowmax(const f32x16&p0,const f32x16&p1){
  float a=max3f(p0[0],p0[1],p1[0]),b=max3f(p0[2],p0[3],p1[1]);a=max3f(a,p1[2],p1[3]);
  #pragma unroll
  for(int r=4;r<16;r+=4){a=max3f(a,p0[r],p0[r+1]);b=max3f(b,p0[r+2],p0[r+3]);a=max3f(a,p1[r],p1[r+1]);b=max3f(b,p1[r+2],p1[r+3]);}
  const float m=max2f(a,b);
  return xhalf_max(m);
}
__device__ __forceinline__ void pv(f32x16*o,int vb,bf16x8 pa0,bf16x8 pa1,bf16x8 pa2,bf16x8 pa3){
  #pragma unroll
  for(int d0=0;d0<2;++d0){s16x4 lo[4],hi[4];
    #pragma unroll
    for(int ks=0;ks<4;++ks){
      asm volatile("ds_read_b64_tr_b16 %0,%1 offset:%c2":"=&v"(lo[ks]):"v"(vb),"i"(d0*4096+ks*1024):"memory");
      asm volatile("ds_read_b64_tr_b16 %0,%1 offset:%c2":"=&v"(hi[ks]):"v"(vb),"i"(d0*4096+ks*1024+512):"memory");}
    asm volatile("s_waitcnt lgkmcnt(0)":::"memory");SBAR();
    #define PK(k) (bf16x8){lo[k][0],lo[k][1],lo[k][2],lo[k][3],hi[k][0],hi[k][1],hi[k][2],hi[k][3]}
    o[d0]=__builtin_amdgcn_mfma_f32_32x32x16_bf16(pa0,PK(0),o[d0],0,0,0);
    o[d0]=__builtin_amdgcn_mfma_f32_32x32x16_bf16(pa1,PK(1),o[d0],0,0,0);
    o[d0]=__builtin_amdgcn_mfma_f32_32x32x16_bf16(pa2,PK(2),o[d0],0,0,0);
    o[d0]=__builtin_amdgcn_mfma_f32_32x32x16_bf16(pa3,PK(3),o[d0],0,0,0);
    #undef PK
  }
}

template<int TYPE> __device__ __forceinline__ void attn_unit(int b,int h16,int qb,const bf16_t*Q,const bf16_t*__restrict__ K,const bf16_t*__restrict__ V,bf16_t*O,
                                                              const float*__restrict__ F2,const unsigned long long*__restrict__ mask,char*shm){
  const int tid=threadIdx.x,lane=tid&63,r32=lane&31,hi=lane>>5; const int wid=__builtin_amdgcn_readfirstlane(tid>>6);
  const long rowbase=(long)b*SEQ; const int q0=qb*QB;
  const bf16_t*Qw=Q+(rowbase+q0+wid*QBLK)*DM+h16*D;
  const bf16_t*Kh=K+rowbase*DM+h16*D,*Vh=V+rowbase*DM+h16*D;
  const unsigned lds0=(unsigned)(uintptr_t)shm;
  float*wsf=(float*)(shm+LDS_WS)+wid*64;
  float*fk=(float*)(shm+LDS_FK);
  const bf16_t*ksrc=Kh+(long)lane*DM+wid*8;
  const bf16_t*vsrc=Vh+(long)(16*(wid&3)+(lane>>2))*DM+(wid>>2)*32+(lane&3)*8;
  const unsigned kdst=lds0+LDS_K+wid*1024, vdst=lds0+LDS_V+wid*1024;
  #define DMA_K(t,slot) glds16(ksrc+(long)(t)*KVBLK*DM,(unsigned)__builtin_amdgcn_readfirstlane(kdst+(slot)))
  #define DMA_V(t,slot) glds16(vsrc+(long)(t)*KVBLK*DM,(unsigned)__builtin_amdgcn_readfirstlane(vdst+(slot)))
  const int vb0=(int)(lds0+LDS_V)+((lane>>4)&1)*32+(lane&3)*8+(4*hi+((lane&15)>>2))*64;
  const int NT=(q0+QB)/KVBLK;
  const int tq=q0+wid*QBLK+r32;
  const int t_begin=0;
  float Fq=0.f, sl2=0.f;
  if(TYPE==0){ const float*f2h=F2+((size_t)b*8+(h16-8))*SEQ; for(int i=tid;i<NT*KVBLK;i+=NW*64)fk[i]=f2h[i]; Fq=f2h[tq]; }
  else { sl2=__builtin_amdgcn_exp2f(-(float)(h16+1))*1.4426950408889634f; }
  DMA_K(t_begin,0);DMA_V(t_begin,0);
  bf16x8 qr[4];
  #pragma unroll
  for(int d0=0;d0<4;++d0)qr[d0]=*reinterpret_cast<const bf16x8*>(&Qw[(long)r32*DM+d0*16+hi*8]);
  float m_run=-INFINITY,l_run=0.f;f32x16 o[2];o[0]=f32x16{};o[1]=f32x16{};
  const f32x16 zero16=f32x16{};
  const unsigned long long*mrow=mask+((size_t)rowbase+tq)*128;
  WAIT_ALL_BAR();
  for(int t=t_begin;t<NT;++t){
    const int slot=((t-t_begin)&1)*SLOTB;
    unsigned long long mw=0ull; if(TYPE==1){mw=mrow[t];
#ifdef PROBE_NOMASK
      mw=~0ull; { const int d_=tq-t*KVBLK; if(d_<63) mw=(d_<0)?0ull:((2ull<<d_)-1ull); }
#endif
#ifdef PROBE_WINDOW_ATT
      mw=~0ull; { const int d_=tq-t*KVBLK; if(d_<63) mw=(d_<0)?0ull:((2ull<<d_)-1ull); const int lo_=tq-255-t*KVBLK; if(lo_>0) mw=(lo_>63)?0ull:(mw&~((1ull<<lo_)-1ull)); }
#endif
    }
    if(t+1<NT){DMA_K(t+1,slot^SLOTB);DMA_V(t+1,slot^SLOTB);}
    f32x16 p0,p1;
    qkt(p0,p1,shm+LDS_K+slot,qr,zero16,r32,hi);
    if(TYPE==0){
      #pragma unroll
      for(int j=0;j<4;++j){ const f32x4 a=*(const f32x4*)(fk+t*KVBLK+8*j+4*hi), c=*(const f32x4*)(fk+t*KVBLK+32+8*j+4*hi);
        #pragma unroll
        for(int i=0;i<4;++i){p0[4*j+i]+=Fq-a[i];p1[4*j+i]+=Fq-c[i];} }
      if(t>=NT-4)cmask(p0,p1,t-(NT-4),wid*QBLK+r32,hi);
    } else {
      const float base=(float)(t*KVBLK+4*hi-tq);
      const unsigned lo=(unsigned)mw>>(4*hi), hh=(unsigned)(mw>>32)>>(4*hi);
      #pragma unroll
      for(int r=0;r<16;++r){ const int c=(r&3)+8*(r>>2);
        const float v0=__builtin_fmaf(sl2,base+(float)c,p0[r]), v1=__builtin_fmaf(sl2,base+(float)(c+32),p1[r]);
        p0[r]=((lo>>c)&1u)?v0:-INFINITY; p1[r]=((hh>>c)&1u)?v1:-INFINITY; }
    }
    const float rm=rowmax(p0,p1);
    const float m_new=__builtin_fmaxf(m_run,rm);
    const float m_use=(m_new==-INFINITY)?0.f:m_new;
    const float alpha=__builtin_amdgcn_exp2f(m_run-m_use);
    float sacc=0.f;
    #pragma unroll
    for(int r=0;r<16;++r){p0[r]=__builtin_amdgcn_exp2f(p0[r]-m_use);p1[r]=__builtin_amdgcn_exp2f(p1[r]-m_use);sacc+=p0[r]+p1[r];}
    l_run=l_run*alpha+sacc; m_run=m_new;
    if(__any(alpha!=1.f)){
      if(hi==0)wsf[r32]=alpha;
      asm volatile("s_waitcnt lgkmcnt(0)":::"memory");
      #pragma unroll
      for(int d_=0;d_<2;++d_)
        #pragma unroll
        for(int r=0;r<16;++r)o[d_][r]*=wsf[crow(r,hi)];
    }
    u32x4 pw0,pw1,pw2,pw3;
    #define PKW(P,B) cvtpk_s(P[B],P[B+1])
    pw0=(u32x4){PKW(p0,0),PKW(p0,2),PKW(p0,4),PKW(p0,6)};pw1=(u32x4){PKW(p0,8),PKW(p0,10),PKW(p0,12),PKW(p0,14)};
    pw2=(u32x4){PKW(p1,0),PKW(p1,2),PKW(p1,4),PKW(p1,6)};pw3=(u32x4){PKW(p1,8),PKW(p1,10),PKW(p1,12),PKW(p1,14)};
    #undef PKW
    SBAR();
    pv(o,vb0+slot,__builtin_bit_cast(bf16x8,pw0),__builtin_bit_cast(bf16x8,pw1),__builtin_bit_cast(bf16x8,pw2),__builtin_bit_cast(bf16x8,pw3));
    WAIT_ALL_BAR();
  }
  l_run=xhalf_sum(l_run);
  if(hi==0)wsf[32+r32]=l_run;asm volatile("s_waitcnt lgkmcnt(0)":::"memory");
  float rli[16];
  #pragma unroll
  for(int r=0;r<16;++r)rli[r]=__builtin_amdgcn_rcpf(wsf[32+crow(r,hi)]);
  bf16_t*Ow=O+(rowbase+q0+wid*QBLK)*DM+h16*D;
  { bf16_t*stg=(bf16_t*)(shm+LDS_OST)+wid*2048;
    #pragma unroll
    for(int r=0;r<16;++r){const int orow=crow(r,hi);
      #pragma unroll
      for(int d0=0;d0<2;++d0){ const unsigned pk=cvtpk_s(o[d0][r]*rli[r]*PROBE_ZF(TYPE),0.f); stg[orow*64+d0*32+r32]=(bf16_t)(pk&0xffffu);} }
    asm volatile("s_waitcnt lgkmcnt(0)":::"memory");
    #pragma unroll
    for(int i=0;i<4;++i){const int row=i*8+(lane>>3),ch=lane&7; const u32x4 v=*(const u32x4*)(stg+row*64+ch*8); *(u32x4*)(Ow+(long)row*DM+ch*8)=v;} }
  asm volatile("s_waitcnt vmcnt(0) lgkmcnt(0)\n\ts_barrier":::"memory");
  #undef DMA_K
  #undef DMA_V
}
#undef SBAR
#undef WAIT_ALL_BAR
}
constexpr int NWAVES = 8;
constexpr int N_PHASES = 14;
constexpr int N_LAUNCHES = MK_N_LAUNCHES;
static_assert(N_LAUNCHES == 1 || N_LAUNCHES == N_PHASES, "MK_N_LAUNCHES is 1 or 14");
constexpr int BATCH = 2, SEQ = 8192, D_MODEL = 1024, D_FF = 2816, IN_WIDTH = 5712, TOPK = 256;
constexpr int M = BATCH * SEQ;
constexpr int NA_COLS = 15 * 256;
constexpr size_t MiB = 1u << 20;
constexpr size_t WS_CTL = 0, CTL_ZERO_BYTES = 1 * MiB;
constexpr size_t WS_MOD = 1 * MiB, WS_GAINS = 1 * MiB + 131072;
constexpr size_t WS_WGU = 2 * MiB, WS_WD = 13 * MiB, WS_WINA = 19 * MiB, WS_WINB = 27 * MiB, WS_WBR = 31 * MiB, WS_WOUT = 35 * MiB;
constexpr size_t WS_H = 38 * MiB;
constexpr size_t WS_BIG = 70 * MiB;
constexpr size_t WS_Q16 = 70 * MiB, WS_K16 = 102 * MiB, WS_V16 = 134 * MiB;
constexpr size_t WS_QI = 166 * MiB, WS_KI = 182 * MiB, WS_WI = 184 * MiB, WS_LF = 185 * MiB, WS_F2 = 186 * MiB, WS_MASK = 188 * MiB, WS_END = 204 * MiB;
static_assert(WS_WGU + (size_t)2 * D_FF * D_MODEL * 2 <= WS_WD && WS_WD + (size_t)D_FF * D_MODEL * 2 <= WS_WINA && WS_WINA + (size_t)NA_COLS * D_MODEL * 2 <= WS_WINB, "ws map");
static_assert(WS_BIG + (size_t)M * D_FF * 2 <= WS_QI && WS_MASK + (size_t)M * SEQ / 8 <= WS_END, "ws map");
constexpr int CW_BAR = 4096;
constexpr int RING_BYTES = 131072, LDSCTL_OFF = 139264, MISC_OFF = LDSCTL_OFF + 320, LDS_BYTES = 147456;
typedef float f32x2g __attribute__((ext_vector_type(2)));
#define GAS __attribute__((address_space(1)))
#define LAS __attribute__((address_space(3)))
typedef unsigned short bf16;
typedef unsigned v4u __attribute__((ext_vector_type(4)));
typedef float f32x4 __attribute__((ext_vector_type(4)));
typedef short bf16x8 __attribute__((ext_vector_type(8)));
typedef GAS unsigned gu32;
typedef GAS unsigned long long gu64;
#define RLX_AGENT __ATOMIC_RELAXED, __HIP_MEMORY_SCOPE_AGENT
#define LDS_WAIT() asm volatile("s_waitcnt lgkmcnt(0)" ::: "memory")
#define VM_WAIT() asm volatile("s_waitcnt vmcnt(0)" ::: "memory")
__device__ __forceinline__ unsigned long long rt() { return __builtin_amdgcn_s_memrealtime(); }
__device__ __forceinline__ unsigned f2bf(float f) { unsigned u = __builtin_bit_cast(unsigned, f); return (u + 0x7fffu + ((u >> 16) & 1u)) >> 16; }
__device__ __forceinline__ unsigned pk2(float lo, float hi) { return f2bf(lo) | (f2bf(hi) << 16); }

#define XB_TMO      128
#define XB_XCNT(j)  (256  + 64 * (j))
#define XB_XSUB(j)  (1280 + 64 * (j))
#define XB_XGEN(j)  (2304 + 64 * (j))
#define XB_TOP      3328
#define XB_TOPGEN   3392
#define XCD_BAR_WORDS 3456
#define XB_SPIN_CAP (1u << 18)

__device__ __forceinline__ unsigned xb_ld(unsigned* p)              { return __hip_atomic_load(p, __ATOMIC_RELAXED, __HIP_MEMORY_SCOPE_AGENT); }
__device__ __forceinline__ unsigned xb_add(unsigned* p, unsigned v) { return __hip_atomic_fetch_add(p, v, __ATOMIC_RELAXED, __HIP_MEMORY_SCOPE_AGENT); }
__device__ __forceinline__ unsigned xb_xcc_id() { return (unsigned)__builtin_amdgcn_s_getreg((3 << 11) | 20) & 0xFu; }
#define XB_SPIN(cond, bar) do { unsigned _sp = 0; while (cond) { __builtin_amdgcn_s_sleep(1); \
    if ((++_sp & 255u) == 0u) { if (xb_ld(&(bar)[XB_TMO])) break; if (_sp > XB_SPIN_CAP) { atomicAdd(&(bar)[XB_TMO], 1u); break; } } } } while (0)

struct XcdBarrier {
    unsigned* bar; unsigned x;
    volatile LAS unsigned* st;
};

__device__ __forceinline__ XcdBarrier xcd_barrier_post(unsigned* bar, volatile LAS unsigned* st) {
    XcdBarrier b; b.bar = bar; b.x = xb_xcc_id(); b.st = st;
    if (threadIdx.x == 0) (void)xb_add(&bar[XB_XCNT(b.x)], 1u);
    return b;
}
__device__ __forceinline__ void xcd_barrier_complete(unsigned* bar, unsigned x, unsigned& nloc, unsigned& nx) {
    const unsigned G = gridDim.x * gridDim.y * gridDim.z;
    unsigned sum, cnt, mine, sp = 0u;
    for (;;) {
        sum = 0u; cnt = 0u; mine = 0u;
#pragma unroll
        for (unsigned j = 0; j < 16; ++j) { const unsigned c = xb_ld(&bar[XB_XCNT(j)]); sum += c; cnt += (c > 0u) ? 1u : 0u; mine = (j == x) ? c : mine; }
        if (sum == G) break;
        __builtin_amdgcn_s_sleep(1);
        if ((++sp & 255u) == 0u) { if (xb_ld(&bar[XB_TMO])) break; if (sp > XB_SPIN_CAP) { atomicAdd(&bar[XB_TMO], 1u); break; } }
    }
    nloc = mine > 0u ? mine : 1u; nx = cnt > 0u ? cnt : 1u;
}

__device__ __forceinline__ void xcd_barrier(const XcdBarrier& b) {
    asm volatile("s_waitcnt vmcnt(0)" ::: "memory");
    __syncthreads();
    if (threadIdx.x == 0) {
        unsigned* bar = b.bar;
        __builtin_amdgcn_s_waitcnt(0);
        unsigned nloc = b.st[0], nx = b.st[1];
        if (nloc == 0u) { xcd_barrier_complete(bar, b.x, nloc, nx); b.st[0] = nloc; b.st[1] = nx; }
        const unsigned old = xb_add(&bar[XB_XSUB(b.x)], 1u);
        const unsigned gen = old / nloc;
        if (old + 1u == (gen + 1u) * nloc) {
            __builtin_amdgcn_fence(__ATOMIC_RELEASE, "agent");
            asm volatile("s_waitcnt vmcnt(0)" ::: "memory");
            const unsigned og = xb_add(&bar[XB_TOP], 1u);
            const unsigned tg = og / nx;
            if (og + 1u == (tg + 1u) * nx) xb_add(&bar[XB_TOPGEN], 1u);
            else XB_SPIN(xb_ld(&bar[XB_TOPGEN]) == tg, bar);
            __builtin_amdgcn_fence(__ATOMIC_ACQUIRE, "agent");
            xb_add(&bar[XB_XGEN(b.x)], 1u);
            asm volatile("s_waitcnt vmcnt(0)" ::: "memory");
        } else {
            XB_SPIN(xb_ld(&bar[XB_XGEN(b.x)]) == gen, bar);
            __builtin_amdgcn_fence(__ATOMIC_ACQUIRE, "agent");
            asm volatile("s_waitcnt vmcnt(0)" ::: "memory");
        }
    }
    __syncthreads();
}
struct Frame {
    LAS unsigned char* lds;
    volatile LAS unsigned* MISC;
    gu32* ctl;
    int tid, lane, wave;
    int vcu, G;
    const float* in[22];
    float* out;
    unsigned char* ws;
};
__device__ __forceinline__ float wave_sum(float v) {
#pragma unroll
    for (int o = 1; o < 64; o <<= 1) v += __shfl_xor(v, o);
    return v;
}

enum { J_GU = 0, J_D = 1, J_INA = 2, J_INB = 3, J_BR = 4, J_OUT = 5 };
struct SrcDesc { const float* W; int N; int n0; int k0; };
__device__ __forceinline__ SrcDesc wsrc(int job, int g, int kb, const float* w0, const float* w1) {
    SrcDesc s; s.W = w0; s.k0 = 64 * kb; const int v0 = 32 * g, pn = v0 >> 8, j = v0 & 255;
    switch (job) {
    case J_GU:  s.W = (j < 128) ? w0 : w1; s.N = D_FF; s.n0 = 128 * pn + (j & 127); break;
    case J_D:   s.N = D_MODEL; s.n0 = v0; break;
    case J_INA: { s.N = IN_WIDTH; const int sec = pn >> 1;
        if (sec == 0 || sec == 1 || sec == 3 || sec == 4) s.n0 = 512 * sec + ((pn & 1) * 4 + ((j & 127) >> 5)) * 64 + 32 * (j >> 7);
        else if (sec == 2 || sec == 5 || sec == 6) s.n0 = 512 * sec + 256 * (pn & 1) + j;
        else { if (j < 96) s.n0 = 3584 + j; else s.W = nullptr; } } break;
    case J_INB: s.N = IN_WIDTH; s.n0 = 3664 + v0; break;
    case J_BR:  { s.N = D_MODEL; s.n0 = 128 * pn + (j & 127);
        if (j < 128) { if (kb >= 8) s.W = nullptr; } else { if (kb < 8) s.W = nullptr; else { s.W = w1; s.k0 = 64 * kb - 512; } } } break;
    default:    s.N = D_MODEL; s.n0 = v0; break;
    }
    return s;
}
__device__ __forceinline__ void transpose_item(const SrcDesc s, bf16* WT, int Kd, int g, int kb, LAS float* scr, int lane) {
    const int c = lane & 7;
    if (s.W == nullptr) {
#pragma unroll
        for (int jj = 0; jj < 4; ++jj) { const int n = (lane >> 3) + 8 * jj; *(GAS v4u*)(WT + (size_t)(32 * g + n) * Kd + 64 * kb + 8 * c) = (v4u){0u, 0u, 0u, 0u}; }
        return;
    }
#pragma unroll 8
    for (int i = 0; i < 32; ++i) { const int kk = 2 * i + (lane >> 5); scr[kk * 33 + (lane & 31)] = s.W[(size_t)(s.k0 + kk) * s.N + s.n0 + (lane & 31)]; }
    LDS_WAIT(); asm volatile("" ::: "memory");
#pragma unroll
    for (int jj = 0; jj < 4; ++jj) { const int n = (lane >> 3) + 8 * jj; const LAS float* p = scr + (8 * c) * 33 + n;
        v4u o; o.x = pk2(p[0 * 33], p[1 * 33]); o.y = pk2(p[2 * 33], p[3 * 33]); o.z = pk2(p[4 * 33], p[5 * 33]); o.w = pk2(p[6 * 33], p[7 * 33]);
        *(GAS v4u*)(WT + (size_t)(32 * g + n) * Kd + 64 * kb + 8 * c) = o; }
    LDS_WAIT(); asm volatile("" ::: "memory");
}
__device__ __forceinline__ int transpose_job(Frame& F, int job, const float* w0, const float* w1, bf16* WT, int rows, int Kd, int base) {
    LAS float* scr = (LAS float*)(F.lds + F.wave * 16384);
    const int nkb = Kd / 64, nitem = (rows / 32) * nkb, gw = F.vcu * NWAVES + F.wave, NGW = F.G * NWAVES;
    int first = (gw - base % NGW + NGW) % NGW;
    for (int it = first; it < nitem; it += NGW) { const int g = it / nkb, kb = it % nkb; transpose_item(wsrc(job, g, kb, w0, w1), WT, Kd, g, kb, scr, F.lane); }
    return base + nitem;
}
__device__ __forceinline__ void mod_gemv(Frame& F, int item) {
    const float* cin = F.in[1]; const float* W = F.in[2]; const float* bias = F.in[3]; float* mod = (float*)(F.ws + WS_MOD);
    LAS float* sc = (LAS float*)(F.lds);
    LAS float* red = (LAS float*)(F.lds + 8192);
    for (int i = F.tid; i < 2048; i += NWAVES * 64) { const float v = cin[i]; sc[i] = v / (1.f + __expf(-v)); }
    __syncthreads();
    const int col = 128 * item + 2 * F.lane, kbeg = 128 * F.wave;
    float a00 = 0.f, a01 = 0.f, a10 = 0.f, a11 = 0.f;
#pragma unroll 16
    for (int k = 0; k < 128; ++k) { const f32x2g w = *(const f32x2g*)(W + (size_t)(kbeg + k) * 9216 + col); const float s0 = sc[kbeg + k], s1 = sc[1024 + kbeg + k];
        a00 += s0 * w.x; a01 += s0 * w.y; a10 += s1 * w.x; a11 += s1 * w.y; }
    red[F.wave * 256 + 2 * F.lane] = a00; red[F.wave * 256 + 2 * F.lane + 1] = a01; red[F.wave * 256 + 128 + 2 * F.lane] = a10; red[F.wave * 256 + 128 + 2 * F.lane + 1] = a11;
    __syncthreads();
    if (F.tid < 256) { const int bb = F.tid >> 7, cc = F.tid & 127; float s = 0.f;
#pragma unroll
        for (int w = 0; w < 8; ++w) s += red[w * 256 + bb * 128 + cc];
        mod[bb * 9216 + 128 * item + cc] = s + bias[128 * item + cc]; }
    __syncthreads();
}
__device__ __forceinline__ void norm_phase(Frame& F, const float* xin, const float* g, int nmod, bf16* H) {
    const float* mod = (const float*)(F.ws + WS_MOD);
    const int gw = F.vcu * NWAVES + F.wave, NGW = F.G * NWAVES;
    for (int m = gw; m < M; m += NGW) {
        const int b = m >> 13;
        const GAS f32x4* xr = (const GAS f32x4*)(xin + (size_t)m * D_MODEL) + F.lane;
        f32x4 v[4]; float s = 0.f;
#pragma unroll
        for (int j = 0; j < 4; ++j) { v[j] = xr[64 * j]; s += (v[j].x * v[j].x + v[j].y * v[j].y) + (v[j].z * v[j].z + v[j].w * v[j].w); }
        const float rstd = 1.f / sqrtf(wave_sum(s) * (1.f / D_MODEL) + 1e-6f);
        GAS unsigned long long* o8 = (GAS unsigned long long*)(H + (size_t)m * D_MODEL) + F.lane;
#pragma unroll
        for (int j = 0; j < 4; ++j) { const int c = 4 * F.lane + 256 * j;
            const f32x4 gg = *(const f32x4*)(g + c), shv = *(const f32x4*)(mod + b * 9216 + nmod * 1024 + c), scv = *(const f32x4*)(mod + b * 9216 + (nmod + 1) * 1024 + c);
            const f32x4 y = v[j] * rstd * gg * (scv + 1.f) + shv;
            o8[64 * j] = (unsigned long long)pk2(y.x, y.y) | ((unsigned long long)pk2(y.z, y.w) << 32); }
    }
}

__device__ __forceinline__ unsigned sortable_key(float s) { unsigned u = __builtin_bit_cast(unsigned, s); if (u == 0x80000000u) u = 0u; return (u & 0x80000000u) ? ~u : (u | 0x80000000u); }
__device__ __forceinline__ void fscan_row(const float* lf, float* f2, int lane) {
    float carry = 0.f;
    for (int it = 0; it < SEQ / 256; ++it) {
        const f32x4 v = *(const f32x4*)(lf + it * 256 + lane * 4);
        const float p0 = v.x, p1 = p0 + v.y, p2 = p1 + v.z, p3 = p2 + v.w;
        float s = p3;
#pragma unroll
        for (int o = 1; o < 64; o <<= 1) { const float t = __shfl_up(s, o); if (lane >= o) s += t; }
        const float ex = s - p3 + carry;
        f32x4 r; r.x = (ex + p0) * 1.4426950408889634f; r.y = (ex + p1) * 1.4426950408889634f; r.z = (ex + p2) * 1.4426950408889634f; r.w = (ex + p3) * 1.4426950408889634f;
        *(f32x4*)(f2 + it * 256 + lane * 4) = r;
        carry += __shfl(s, 63);
    }
}
__device__ __forceinline__ void idx_unit(Frame& F, int b, int t4, const bf16* QI, const bf16* KI, const float* WI, unsigned long long* MASK) {
    typedef short bf16x8v __attribute__((ext_vector_type(8))); typedef float f32x16v __attribute__((ext_vector_type(16)));
    LAS unsigned* sc = (LAS unsigned*)(F.lds);
    LAS unsigned* hist = (LAS unsigned*)(F.lds + 131072);
    const int lane = F.lane, r32 = lane & 31, hi = lane >> 5, wid = F.wave;
    const int t0 = 4 * t4, ntile = (t0 + 4 + 31) >> 5, n = ntile * 32;
    const size_t rb = (size_t)b * SEQ;
    bf16x8v qa[4];
    { const bf16* qp = QI + (rb + t0 + (r32 >> 3)) * 512 + (r32 & 7) * 64 + hi * 8;
#pragma unroll
      for (int ks = 0; ks < 4; ++ks) qa[ks] = *(const bf16x8v*)(qp + ks * 16); }
    float wv[16];
#pragma unroll
    for (int r = 0; r < 16; ++r) wv[r] = WI[(rb + t0 + (r >> 2)) * 8 + (r & 3) + 4 * hi];
    for (int i = F.tid; i < 2048; i += NWAVES * 64) hist[i] = 0u;
#ifdef PROBE_WINDOW_IDX
#define PROBE_SCORE_HOOK s = (float)key
#else
#define PROBE_SCORE_HOOK
#endif
#define IDX_LOADK(dst, tile_) do { const bf16* kp_ = KI + (rb + (tile_) * 32 + r32) * 64 + hi * 8; _Pragma("unroll") for (int ks = 0; ks < 4; ++ks) dst[ks] = *(const bf16x8v*)(kp_ + ks * 16); } while (0)
#define IDX_SCORE(kf, tile_) do { const int key = (tile_) * 32 + r32; f32x16v acc = {}; \
        _Pragma("unroll") for (int ks = 0; ks < 4; ++ks) acc = __builtin_amdgcn_mfma_f32_32x32x16_bf16(qa[ks], kf[ks], acc, 0, 0, 0); \
        unsigned u[4]; \
        _Pragma("unroll") for (int q_ = 0; q_ < 4; ++q_) { \
            float s = wv[4 * q_] * fmaxf(acc[4 * q_], 0.f); \
            s += wv[4 * q_ + 1] * fmaxf(acc[4 * q_ + 1], 0.f); s += wv[4 * q_ + 2] * fmaxf(acc[4 * q_ + 2], 0.f); s += wv[4 * q_ + 3] * fmaxf(acc[4 * q_ + 3], 0.f); \
            s = att::xhalf_sum(s); \
            PROBE_SCORE_HOOK; u[q_] = (key <= t0 + q_) ? sortable_key(s) : 0u; } \
        if (hi == 0) { sc[key] = u[0]; sc[8192 + key] = u[1]; } else { sc[16384 + key] = u[2]; sc[24576 + key] = u[3]; } } while (0)
    {
        bf16x8v ka[4], kc[4], na[4], nc[4];
        int tile = 2 * wid;
        if (tile < ntile) IDX_LOADK(ka, tile);
        if (tile + 1 < ntile) IDX_LOADK(kc, tile + 1);
        for (; tile < ntile; tile += 2 * NWAVES) {
            const int nx = tile + 2 * NWAVES;
            if (nx < ntile) IDX_LOADK(na, nx);
            if (nx + 1 < ntile) IDX_LOADK(nc, nx + 1);
            IDX_SCORE(ka, tile);
            if (tile + 1 < ntile) IDX_SCORE(kc, tile + 1);
#pragma unroll
            for (int ks = 0; ks < 4; ++ks) { ka[ks] = na[ks]; kc[ks] = nc[ks]; }
        }
    }
#undef IDX_LOADK
#undef IDX_SCORE
    __syncthreads();
    const int q = wid >> 1, part = wid & 1;
    LAS unsigned* scq = sc + q * 8192;
#ifdef PROBE_SELECT_ALL
    const int kk = t0 + q + 1;
#else
    const int kk = (t0 + q + 1 < TOPK) ? (t0 + q + 1) : TOPK;
#endif
    unsigned prefix = 0u, himask = 0u; int need = kk, n_eq = 0;
#pragma unroll 1
    for (int lvl = 0; lvl < 4; ++lvl) {
        const int shift = 24 - 8 * lvl;
        LAS unsigned* Hq = hist + (lvl & 1) * 1024 + q * 256;
        for (int e = part * 64 + lane; e < n; e += 128) { const unsigned uu = scq[e]; if ((uu & himask) == prefix) __hip_atomic_fetch_add(Hq + ((uu >> shift) & 255u), 1u, __ATOMIC_RELAXED, __HIP_MEMORY_SCOPE_WORKGROUP); }
        __syncthreads();
        const unsigned h0 = Hq[4 * lane], h1 = Hq[4 * lane + 1], h2 = Hq[4 * lane + 2], h3 = Hq[4 * lane + 3];
        const int lsum = (int)(h0 + h1 + h2 + h3);
        int incl = lsum;
#pragma unroll
        for (int o = 1; o < 64; o <<= 1) { const int t = __shfl_down(incl, o); if (lane + o < 64) incl += t; }
        const int S = incl - lsum;
        const bool has = (S < need) && (need <= incl);
        const int c3 = S + (int)h3, c2 = c3 + (int)h2, c1 = c2 + (int)h1;
        int bin, above, eqc;
        if (need <= c3) { bin = 3; above = S; eqc = (int)h3; } else if (need <= c2) { bin = 2; above = c3; eqc = (int)h2; } else if (need <= c1) { bin = 1; above = c2; eqc = (int)h1; } else { bin = 0; above = c1; eqc = (int)h0; }
        const unsigned long long bal = __ballot(has);
        const int src = (bal == 0ull) ? 0 : (__ffsll((long long)bal) - 1);
        bin = __shfl(4 * lane + bin, src); above = __shfl(above, src); n_eq = __shfl(eqc, src);
        prefix |= (unsigned)bin << shift; himask |= 255u << shift; need -= above;
        { LAS unsigned* Hn = hist + ((lvl + 1) & 1) * 1024; Hn[F.tid] = 0u; Hn[F.tid + 512] = 0u; }
        __syncthreads();
    }
    const unsigned vstar = prefix;
    int idxs = 0x7fffffff;
    if (need < n_eq) {
        int running = 0;
        for (int c0 = 0; c0 < n; c0 += 64) {
            const int e = c0 + lane; const bool eq = (e < n) && (scq[e] == vstar);
            const unsigned long long bal = __ballot(eq); const int cnt = __popcll(bal);
            if (running + cnt >= need) {
                const int rank = __popcll(bal & ((1ull << lane) - 1ull)) + 1;
                const unsigned long long hit = __ballot(eq && (rank == need - running));
                idxs = c0 + (__ffsll((long long)hit) - 1); break; }
            running += cnt;
        }
    }
    unsigned long long myword = 0ull;
    for (int i = 0; i < 64; ++i) {
        const int e = (part * 64 + i) * 64 + lane;
        if ((part * 64 + i) * 64 >= n) break;
        bool bit = false;
        if (e < n) { const unsigned uu = scq[e]; bit = (uu > vstar) || (uu == vstar && e <= idxs); }
        const unsigned long long bal = __ballot(bit);
        if (lane == i) myword = bal;
    }
    MASK[(rb + t0 + q) * 128 + part * 64 + lane] = myword;
    __syncthreads();
}

struct Args { const float* in[22]; float* out; unsigned char* ws; int ph_lo, ph_hi, li, pad; };
__global__ void __launch_bounds__(NWAVES * 64, 2) fwd_mega(Args args) {
    extern __shared__ __attribute__((aligned(16))) unsigned char lds[];
    Frame F;
    F.lds = (LAS unsigned char*)lds;
    F.MISC = (volatile LAS unsigned*)(F.lds + MISC_OFF);
    F.tid = threadIdx.x; F.lane = F.tid & 63; F.wave = __builtin_amdgcn_readfirstlane(F.tid >> 6);
    F.G = gridDim.x; { const int bx = blockIdx.x; F.vcu = (F.G % 8 == 0) ? (bx % 8) * (F.G / 8) + bx / 8 : bx; }
    unsigned char* ws = args.ws; F.ws = ws; F.out = args.out;
#pragma unroll
    for (int i = 0; i < 22; ++i) F.in[i] = args.in[i];
    F.ctl = (gu32*)(ws + WS_CTL);
    for (int u = F.tid; u < (LDS_BYTES - LDSCTL_OFF) / 4; u += NWAVES * 64) ((LAS unsigned*)(F.lds + LDSCTL_OFF))[u] = 0u;
    __syncthreads();
    XcdBarrier bar; bar.bar = (unsigned*)(F.ctl + CW_BAR); bar.x = 0; bar.st = nullptr;
    if (N_LAUNCHES == 1) bar = xcd_barrier_post((unsigned*)(F.ctl + CW_BAR), F.MISC + 8);
#define GRID_BAR() do { if (N_LAUNCHES == 1) xcd_barrier(bar); } while (0)
    const int lo = args.ph_lo, hi = args.ph_hi;
#define IN(k) (lo <= (k) && (k) < hi)
#define BOTH(k) (IN(k) && IN((k) + 1))

    bf16* Wgu = (bf16*)(ws + WS_WGU); bf16* Wd = (bf16*)(ws + WS_WD); bf16* WinA = (bf16*)(ws + WS_WINA); bf16* WinB = (bf16*)(ws + WS_WINB);
    bf16* Wbr = (bf16*)(ws + WS_WBR); bf16* Wout = (bf16*)(ws + WS_WOUT);
    bf16* H = (bf16*)(ws + WS_H); bf16* A = (bf16*)(ws + WS_BIG);
    bf16* Q16 = (bf16*)(ws + WS_Q16); bf16* K16 = (bf16*)(ws + WS_K16); bf16* V16 = (bf16*)(ws + WS_V16); bf16* SG = K16;
    bf16* QI = (bf16*)(ws + WS_QI); bf16* KI = (bf16*)(ws + WS_KI); float* WI = (float*)(ws + WS_WI); float* LF = (float*)(ws + WS_LF); float* F2 = (float*)(ws + WS_F2);
    unsigned long long* MASK = (unsigned long long*)(ws + WS_MASK);
    const float* mod = (const float*)(ws + WS_MOD);

    if (IN(0)) {
        if ((int)blockIdx.x < 72) mod_gemv(F, (int)blockIdx.x);
        if ((int)blockIdx.x == 80 && F.tid < 264) { float* gd = (float*)(ws + WS_GAINS); const int t = F.tid;
            gd[t] = (t < 64) ? F.in[11][t] : (t < 128) ? F.in[12][t - 64] : (t < 192) ? F.in[13][t - 128] : (t < 256) ? F.in[14][t - 192] : F.in[10][t - 256]; }
        int base = 0;
        base = transpose_job(F, J_GU, F.in[5], F.in[6], Wgu, 2 * D_FF, D_MODEL, base);
        base = transpose_job(F, J_D, F.in[7], nullptr, Wd, D_MODEL, D_FF, base);
        base = transpose_job(F, J_INA, F.in[9], nullptr, WinA, NA_COLS, D_MODEL, base);
        base = transpose_job(F, J_INB, F.in[9], nullptr, WinB, 2048, D_MODEL, base);
        base = transpose_job(F, J_BR, F.in[15], F.in[16], Wbr, 2048, D_MODEL, base);
        base = transpose_job(F, J_OUT, F.in[17], nullptr, Wout, D_MODEL, D_MODEL, base);
        if (BOTH(0)) GRID_BAR();
    }
    if (IN(1)) { norm_phase(F, F.in[0], F.in[4], 0, H); if (BOTH(1)) GRID_BAR(); }
    if (IN(2)) {
        pg8::Gemm g{H, Wgu, M, 2 * D_FF, D_MODEL}; pg8::StaticOrder S; S.init(M, 2 * D_FF, F.G, (int)blockIdx.x);
        pg8::EpiSwiglu E{A, D_FF};
        pg8::gemm_phase<pg8::EpiSwiglu, pg8::StaticOrder, true, true>(F.lds, g, S, E);
        if (BOTH(2)) GRID_BAR();
    }
    if (IN(3)) {
        pg8::Gemm g{A, Wd, M, D_MODEL, D_FF}; pg8::StaticOrder S; S.init(M, D_MODEL, F.G, (int)blockIdx.x);
        pg8::EpiResid E{F.in[0], F.out, mod + 2 * 1024, 0.5f};
        pg8::gemm_phase<pg8::EpiResid, pg8::StaticOrder, true, true>(F.lds, g, S, E);
        if (BOTH(3)) GRID_BAR();
    }
    if (IN(4)) {
        norm_phase(F, F.out, F.in[8], 3, H);
        int base = 0;
        base = transpose_job(F, J_GU, F.in[19], F.in[20], Wgu, 2 * D_FF, D_MODEL, base);
        base = transpose_job(F, J_D, F.in[21], nullptr, Wd, D_MODEL, D_FF, base);
        if (BOTH(4)) GRID_BAR();
    }
    if (IN(5)) {
        pg8::Gemm g{H, WinA, M, NA_COLS, D_MODEL}; pg8::StaticOrder S; S.init(M, NA_COLS, F.G, (int)blockIdx.x);
        pg8::EpiInA E{Q16, QI, KI, WI, LF, (const float*)(ws + WS_GAINS)};
        pg8::gemm_phase<pg8::EpiInA, pg8::StaticOrder, true, true>(F.lds, g, S, E);
        if (BOTH(5)) GRID_BAR();
    }
    if (IN(6)) {
        if ((int)blockIdx.x < 16 && F.wave == 0) fscan_row(LF + (size_t)blockIdx.x * SEQ, F2 + (size_t)blockIdx.x * SEQ, F.lane);
        for (int i = 0; i * F.G < 4096; ++i) {
            const int idx = i * F.G + ((i & 1) ? (F.G - 1 - F.vcu) : F.vcu);
            if (idx >= 4096) continue;
            const int j = 4095 - idx;
            idx_unit(F, j & 1, j >> 1, QI, KI, WI, MASK);
        }
        if (BOTH(6)) GRID_BAR();
    }
    if (IN(7)) {
        const int v = F.vcu, bh = v >> 4, s = v & 15, b = bh >> 3, h = bh & 7;
        att::attn_unit<1>(b, h, 31 - s, Q16, K16, V16, Q16, F2, MASK, (char*)lds);
        att::attn_unit<1>(b, h, s, Q16, K16, V16, Q16, F2, MASK, (char*)lds);
        att::attn_unit<0>(b, 8 + h, 31 - s, Q16, K16, V16, Q16, F2, MASK, (char*)lds);
        att::attn_unit<0>(b, 8 + h, s, Q16, K16, V16, Q16, F2, MASK, (char*)lds);
        if (BOTH(7)) GRID_BAR();
    }
    if (IN(8)) {
        pg8::Gemm g{H, WinB, M, 2048, D_MODEL}; pg8::StaticOrder S; S.init(M, 2048, F.G, (int)blockIdx.x);
        pg8::EpiGate E{SG};
        pg8::gemm_phase<pg8::EpiGate, pg8::StaticOrder, true, true>(F.lds, g, S, E);
        if (BOTH(8)) GRID_BAR();
    }
    if (IN(9)) {
        pg8::Gemm g{Q16, Wbr, M, 2048, D_MODEL}; pg8::StaticOrder S; S.init(M, 2048, F.G, (int)blockIdx.x);
        pg8::EpiMerge E{SG, H};
        pg8::gemm_phase<pg8::EpiMerge, pg8::StaticOrder, true, true>(F.lds, g, S, E);
        if (BOTH(9)) GRID_BAR();
    }
    if (IN(10)) {
        pg8::Gemm g{H, Wout, M, D_MODEL, D_MODEL}; pg8::StaticOrder S; S.init(M, D_MODEL, F.G, (int)blockIdx.x);
        pg8::EpiResid E{F.out, F.out, mod + 5 * 1024, 1.0f};
        pg8::gemm_phase<pg8::EpiResid, pg8::StaticOrder, true, true>(F.lds, g, S, E);
        if (BOTH(10)) GRID_BAR();
    }
    if (IN(11)) { norm_phase(F, F.out, F.in[18], 6, H); if (BOTH(11)) GRID_BAR(); }
    if (IN(12)) {
        pg8::Gemm g{H, Wgu, M, 2 * D_FF, D_MODEL}; pg8::StaticOrder S; S.init(M, 2 * D_FF, F.G, (int)blockIdx.x);
        pg8::EpiSwiglu E{A, D_FF};
        pg8::gemm_phase<pg8::EpiSwiglu, pg8::StaticOrder, true, true>(F.lds, g, S, E);
        if (BOTH(12)) GRID_BAR();
    }
    if (IN(13)) {
        pg8::Gemm g{A, Wd, M, D_MODEL, D_FF}; pg8::StaticOrder S; S.init(M, D_MODEL, F.G, (int)blockIdx.x);
        pg8::EpiResid E{F.out, F.out, mod + 8 * 1024, 0.5f};
        pg8::gemm_phase<pg8::EpiResid, pg8::StaticOrder, true, true>(F.lds, g, S, E);
    }
#undef IN
#undef BOTH
#undef GRID_BAR
}


#ifdef DBG_CHECK_MASK
__global__ void __launch_bounds__(512) dbg_check_mask(const unsigned char* ws, unsigned* counter) {
    __shared__ float s[8192];
    __shared__ float qv[512]; __shared__ float wv[8];
    const bf16* QI = (const bf16*)(ws + WS_QI); const bf16* KI = (const bf16*)(ws + WS_KI); const float* WI = (const float*)(ws + WS_WI);
    const unsigned long long* MASK = (const unsigned long long*)(ws + WS_MASK);
    const int b = blockIdx.x & 1, t = 255 + (blockIdx.x >> 1) * 127 + 3 * (blockIdx.x & 3);
    if (t >= SEQ) return;
    const size_t rb = (size_t)b * SEQ;
    for (int i = threadIdx.x; i < 512; i += 512) qv[i] = __builtin_bit_cast(float, (unsigned)QI[(rb + t) * 512 + i] << 16);
    if (threadIdx.x < 8) wv[threadIdx.x] = WI[(rb + t) * 8 + threadIdx.x];
    __syncthreads();
    const int n = t + 1;
    for (int e = threadIdx.x; e < n; e += 512) {
        float sc = 0.f;
        _Pragma("unroll 1") for (int i = 0; i < 8; ++i) { float x = 0.f; _Pragma("unroll 4") for (int d = 0; d < 64; ++d) x += qv[i * 64 + d] * __builtin_bit_cast(float, (unsigned)KI[(rb + e) * 64 + d] << 16); sc += wv[i] * fmaxf(x, 0.f); }
        s[e] = sc + 0.f;
    }
    __syncthreads();
    const int kk = n < 256 ? n : 256;
    unsigned bad = 0;
    for (int e = threadIdx.x; e < SEQ; e += 512) {
        bool sel = false;
        if (e < n) { const float se = s[e]; int rank = 0; _Pragma("unroll 4") for (int j = 0; j < n; ++j) { const float sj = s[j]; rank += (sj > se || (sj == se && j < e)) ? 1 : 0; } sel = rank < kk; }
        const bool got = (MASK[(rb + t) * 128 + (e >> 6)] >> (e & 63)) & 1ull;
        if (sel != got) ++bad;
    }
    if (bad) atomicAdd(counter, bad);
}
__global__ void dbg_report(float* out, const unsigned* counter) {
    const unsigned m = *counter; if (m == 0) return;
    int lg = 0; unsigned v = m; while (v > 1) { v >>= 1; ++lg; }
    out[0] += 100.f * (float)(1 + lg);
}
#endif

#ifdef DBG_CHECK_ATT
__device__ __forceinline__ float dbg_bf(unsigned short v) { return __builtin_bit_cast(float, (unsigned)v << 16); }
__device__ __forceinline__ void dbg_sample(int s, int& b, int& t, int& h) { b = s & 1; h = (s >> 1) & 15; t = (int)(((unsigned)(s >> 5) * 2654435761u + (unsigned)(s & 31) * 40503u) % (unsigned)SEQ); }
__global__ void dbg_save_q(const unsigned char* ws, float* save) {
    int b, t, h; dbg_sample(blockIdx.x, b, t, h);
    const bf16* Q16 = (const bf16*)(ws + WS_Q16);
    if (threadIdx.x < 64) save[blockIdx.x * 64 + threadIdx.x] = dbg_bf(Q16[((size_t)b * SEQ + t) * 1024 + h * 64 + threadIdx.x]);
}
__global__ void __launch_bounds__(256) dbg_check_att(const unsigned char* ws, const float* save, unsigned* counter) {
    __shared__ float lg[8192]; __shared__ int sel[512]; __shared__ int nsel; __shared__ float q[64]; __shared__ float red[2]; __shared__ float rm[256];
    int b, t, h; dbg_sample(blockIdx.x, b, t, h);
    const bf16* O16 = (const bf16*)(ws + WS_Q16); const bf16* K16 = (const bf16*)(ws + WS_K16); const bf16* V16 = (const bf16*)(ws + WS_V16);
    const unsigned long long* MASK = (const unsigned long long*)(ws + WS_MASK); const float* F2 = (const float*)(ws + WS_F2);
    const size_t rb = (size_t)b * SEQ;
    if (threadIdx.x < 64) q[threadIdx.x] = save[blockIdx.x * 64 + threadIdx.x];
    __syncthreads();
    const int n = t + 1;
    if (h < 8) {
        const float sl2 = exp2f(-(float)(h + 1)) * 1.4426950408889634f;
        for (int s = threadIdx.x; s < n; s += 256) { float x = -INFINITY;
            if ((MASK[(rb + t) * 128 + (s >> 6)] >> (s & 63)) & 1ull) { x = 0.f; _Pragma("unroll 4") for (int d = 0; d < 64; ++d) x += q[d] * dbg_bf(K16[(rb + s) * 1024 + h * 64 + d]); x += sl2 * (float)(s - t); }
            lg[s] = x; }
    } else {
        const float* f2 = F2 + ((size_t)b * 8 + (h - 8)) * SEQ; const float fq = f2[t];
        for (int s = threadIdx.x; s < n; s += 256) { float x = 0.f; _Pragma("unroll 4") for (int d = 0; d < 64; ++d) x += q[d] * dbg_bf(K16[(rb + s) * 1024 + h * 64 + d]); lg[s] = x + fq - f2[s]; }
    }
    __syncthreads();
    { float m = -INFINITY; for (int s = threadIdx.x; s < n; s += 256) m = fmaxf(m, lg[s]); rm[threadIdx.x] = m; }
    __syncthreads();
    if (threadIdx.x == 0) { float m = -INFINITY; for (int i = 0; i < 256; ++i) m = fmaxf(m, rm[i]); red[0] = m; }
    __syncthreads();
    { float l = 0.f; for (int s = threadIdx.x; s < n; s += 256) { const float p = exp2f(lg[s] - red[0]); lg[s] = p; l += p; } rm[threadIdx.x] = l; }
    __syncthreads();
    if (threadIdx.x == 0) { float l = 0.f; for (int i = 0; i < 256; ++i) l += rm[i]; red[1] = l; }
    __syncthreads();
    if (threadIdx.x < 64) { const int d = threadIdx.x; float o = 0.f;
        for (int s = 0; s < n; ++s) { const float p = lg[s]; if (p != 0.f) o += p * dbg_bf(V16[(rb + s) * 1024 + h * 64 + d]); }
        o /= red[1];
        const float got = dbg_bf(O16[(rb + t) * 1024 + h * 64 + d]);
        if (!(fabsf(got - o) <= 0.03f + 0.03f * fabsf(o))) atomicAdd(counter + (h < 8 ? 0 : 1), 1u); }
    (void)sel; (void)nsel;
}
__global__ void __launch_bounds__(256) dbg_check_proj(const unsigned char* ws, const float* w_in, unsigned* counter) {
    const bf16* H = (const bf16*)(ws + WS_H); const bf16* QI = (const bf16*)(ws + WS_QI); const bf16* KI = (const bf16*)(ws + WS_KI); const float* WI = (const float*)(ws + WS_WI);
    const int m = (blockIdx.x * 131 + 17) & (M - 1);
    __shared__ float hrow[1024];
    for (int i = threadIdx.x; i < 1024; i += 256) hrow[i] = dbg_bf(H[(size_t)m * 1024 + i]);
    __syncthreads();
    for (int c = threadIdx.x; c < 584; c += 256) {
        const int col = 3072 + c; float z = 0.f;
        _Pragma("unroll 4") for (int k2 = 0; k2 < 1024; ++k2) z += hrow[k2] * w_in[(size_t)k2 * IN_WIDTH + col];
        float got, ref;
        if (c < 512) { ref = z * 0.125f; got = dbg_bf(QI[(size_t)m * 512 + c]); }
        else if (c < 576) { ref = z; got = dbg_bf(KI[(size_t)m * 64 + (c - 512)]); }
        else { ref = z * 0.35355339059327373f; got = WI[(size_t)m * 8 + (c - 576)]; }
        const float tol = (c < 512 ? 0.125f : 1.f) * 0.04f + 0.02f * fabsf(ref);
        if (!(fabsf(got - ref) <= tol)) atomicAdd(counter + 2, 1u);
    }
}

__global__ void __launch_bounds__(256) dbg_check_qkv(const unsigned char* ws, const float* w_in, unsigned* counter) {
    const bf16* H = (const bf16*)(ws + WS_H); const bf16* QKV = (const bf16*)(ws + WS_Q16); const float* gains = (const float*)(ws + WS_GAINS);
    const int m = (blockIdx.x * 257 + 5) & (M - 1);
    __shared__ float hrow[1024]; __shared__ float zs[3072];
    for (int i = threadIdx.x; i < 1024; i += 256) hrow[i] = dbg_bf(H[(size_t)m * 1024 + i]);
    __syncthreads();
    for (int c = threadIdx.x; c < 3072; c += 256) { float z = 0.f; _Pragma("unroll 4") for (int k2 = 0; k2 < 1024; ++k2) z += hrow[k2] * w_in[(size_t)k2 * IN_WIDTH + c]; zs[c] = z; }
    __syncthreads();
    for (int c = threadIdx.x; c < 3072; c += 256) {
        const int sec = c >> 9, head = (c >> 6) & 7, d = c & 63;
        float ref = zs[c], scale = 1.f;
        if (sec != 2 && sec != 5) { float ss = 0.f; for (int j = 0; j < 64; ++j) { const float v = zs[(c & ~63) + j]; ss += v * v; }
            const float rstd = 1.f / sqrtf(ss / 64.f + 1e-6f); const int gi = sec - (sec >= 3 ? 1 : 0);
            ref = ref * rstd * gains[64 * gi + d]; if (sec == 0 || sec == 3) { ref *= 0.125f * 1.4426950408889634f; scale = 0.18f; } }
        const int which = (sec == 0 || sec == 3) ? 0 : (sec == 1 || sec == 4) ? 1 : 2;
        const float got = dbg_bf(QKV[(size_t)which * 16777216 + (size_t)m * 1024 + (sec >= 3 ? 512 : 0) + head * 64 + d]);
        if (!(fabsf(got - ref) <= 0.04f * scale + 0.03f * fabsf(ref))) atomicAdd(counter + 3, 1u);
    }
}
__global__ void __launch_bounds__(256) dbg_check_gate(const unsigned char* ws, const float* w_in, unsigned* counter) {
    const bf16* H = (const bf16*)(ws + WS_H); const bf16* SG = (const bf16*)(ws + WS_K16);
    const int m = (blockIdx.x * 263 + 11) & (M - 1);
    __shared__ float hrow[1024];
    for (int i = threadIdx.x; i < 1024; i += 256) hrow[i] = dbg_bf(H[(size_t)m * 1024 + i]);
    __syncthreads();
    for (int c = threadIdx.x; c < 2048; c += 256) { float z = 0.f; _Pragma("unroll 4") for (int k2 = 0; k2 < 1024; ++k2) z += hrow[k2] * w_in[(size_t)k2 * IN_WIDTH + 3664 + c];
        const float ref = 1.f / (1.f + expf(-z)), got = dbg_bf(SG[(size_t)m * 2048 + c]);
        if (!(fabsf(got - ref) <= 0.02f)) { atomicAdd(counter + 4, 1u); if (atomicAdd(counter + 32 + blockIdx.x, 1u) == 0u) atomicAdd(counter + 8, 1u); atomicOr(counter + 9, 1u << (c >> 8)); } }
}
__global__ void __launch_bounds__(256) dbg_check_merge(const unsigned char* ws, const float* wbd, const float* wbf, unsigned* counter) {
    const bf16* Hm = (const bf16*)(ws + WS_H); const bf16* SG = (const bf16*)(ws + WS_K16); const bf16* O16 = (const bf16*)(ws + WS_Q16);
    const int m = (blockIdx.x * 269 + 3) & (M - 1);
    __shared__ float orow[1024];
    for (int i = threadIdx.x; i < 1024; i += 256) orow[i] = dbg_bf(O16[(size_t)m * 1024 + i]);
    __syncthreads();
    for (int c = threadIdx.x; c < 1024; c += 256) { float yd = 0.f, yf = 0.f;
        _Pragma("unroll 4") for (int k2 = 0; k2 < 512; ++k2) { yd += orow[k2] * wbd[(size_t)k2 * 1024 + c]; yf += orow[512 + k2] * wbf[(size_t)k2 * 1024 + c]; }
        const float ref = dbg_bf(SG[(size_t)m * 2048 + c]) * yd + dbg_bf(SG[(size_t)m * 2048 + 1024 + c]) * yf, got = dbg_bf(Hm[(size_t)m * 1024 + c]);
        if (!(fabsf(got - ref) <= 0.03f + 0.03f * fabsf(ref))) atomicAdd(counter + 5, 1u); }
}
__global__ void dbg_save_out(const float* out, float* save) { const int m = (blockIdx.x * 271 + 7) & (M - 1); for (int i = threadIdx.x; i < 1024; i += 256) save[blockIdx.x * 1024 + i] = out[(size_t)m * 1024 + i]; }
__global__ void __launch_bounds__(256) dbg_check_out(const unsigned char* ws, const float* out, const float* save, const float* w_out, unsigned* counter) {
    const bf16* Hm = (const bf16*)(ws + WS_H); const float* mod = (const float*)(ws + WS_MOD);
    const int m = (blockIdx.x * 271 + 7) & (M - 1), b = m >> 13;
    __shared__ float hrow[1024];
    for (int i = threadIdx.x; i < 1024; i += 256) hrow[i] = dbg_bf(Hm[(size_t)m * 1024 + i]);
    __syncthreads();
    for (int c = threadIdx.x; c < 1024; c += 256) { float z = 0.f; _Pragma("unroll 4") for (int k2 = 0; k2 < 1024; ++k2) z += hrow[k2] * w_out[(size_t)k2 * 1024 + c];
        const float ref = save[blockIdx.x * 1024 + c] + mod[b * 9216 + 5 * 1024 + c] * z, got = out[(size_t)m * 1024 + c];
        if (!(fabsf(got - ref) <= 0.02f + 0.01f * fabsf(ref))) atomicAdd(counter + 6, 1u); }
}

__global__ void __launch_bounds__(256) dbg_check_ffn_a(const unsigned char* ws, const float* wg, const float* wu, unsigned* counter) {
    const bf16* H = (const bf16*)(ws + WS_H); const bf16* A = (const bf16*)(ws + WS_BIG);
    const int m = (blockIdx.x * 277 + 13) & (M - 1);
    __shared__ float hrow[1024];
    for (int i = threadIdx.x; i < 1024; i += 256) hrow[i] = dbg_bf(H[(size_t)m * 1024 + i]);
    __syncthreads();
    for (int c = threadIdx.x; c < D_FF; c += 256) { float zg = 0.f, zu = 0.f;
        _Pragma("unroll 4") for (int k2 = 0; k2 < 1024; ++k2) { zg += hrow[k2] * wg[(size_t)k2 * D_FF + c]; zu += hrow[k2] * wu[(size_t)k2 * D_FF + c]; }
        const float ref = zg / (1.f + expf(-zg)) * zu, got = dbg_bf(A[(size_t)m * D_FF + c]);
        if (!(fabsf(got - ref) <= 0.04f + 0.03f * fabsf(ref))) { atomicAdd(counter + 10, 1u); if (atomicAdd(counter + 320 + blockIdx.x, 1u) == 0u) atomicAdd(counter + 11, 1u); } }
}
__global__ void dbg_report2(float* out, const unsigned* counter) {
    if (counter[10]) { int d1 = 0; unsigned v = counter[11]; while (v) { v >>= 1; ++d1; } if (d1 > 9) d1 = 9;
        int d2 = 0; v = counter[10]; while (v > 1) { v >>= 1; ++d2; } d2 = d2 / 2; if (d2 > 9) d2 = 9;
        out[9] += (float)(d1 * 10 + d2) * 1e12f; }
    if (counter[4]) { int d1 = 0; unsigned v = counter[8]; while (v) { v >>= 1; ++d1; } if (d1 > 9) d1 = 9;
        int d2 = 0; v = counter[4]; while (v > 1) { v >>= 1; ++d2; } d2 = d2 / 2; if (d2 > 9) d2 = 9;
        out[7] += (float)(d1 * 10 + d2) * 1e9f; out[8] += (float)counter[9] * 1e7f; }
    const float code[7] = {1e2f, 1e3f, 1e4f, 1e8f, 1e7f, 1e6f, 1e5f};
    for (int j = 0; j < 7; ++j) { const unsigned m = counter[j]; if (m == 0) continue;
        int lgv = 0; unsigned v = m; while (v > 1) { v >>= 1; ++lgv; } if (lgv > 8) lgv = 8;
        out[j] += code[j] * (float)(1 + lgv); }
}
#endif
extern "C" void kernel_launch(void* const* d_in, const int* in_sizes, int n_in, void* d_out, int out_size, void* d_ws, size_t ws_size, hipStream_t stream) {
    static int grid = 0;
    if (grid == 0) {
        if (n_in != 22 || in_sizes[0] != M * D_MODEL || out_size != M * D_MODEL || ws_size < WS_END) {
            fprintf(stderr, "kernel_launch: unexpected shapes: n_in %d in0 %d out %d ws %zu (need %zu)\n", n_in, n_in > 0 ? in_sizes[0] : -1, out_size, ws_size, (size_t)WS_END); grid = -1; return; }
        int dev = 0, cus = 0, per_cu = 0;
        if (hipGetDevice(&dev) != hipSuccess || hipDeviceGetAttribute(&cus, hipDeviceAttributeMultiprocessorCount, dev) != hipSuccess) { grid = -1; return; }
        if (hipFuncSetAttribute((const void*)fwd_mega, hipFuncAttributeMaxDynamicSharedMemorySize, LDS_BYTES) != hipSuccess) { fprintf(stderr, "kernel_launch: hipFuncSetAttribute failed\n"); grid = -1; return; }
        if (hipOccupancyMaxActiveBlocksPerMultiprocessor(&per_cu, (const void*)fwd_mega, NWAVES * 64, LDS_BYTES) != hipSuccess || per_cu < 1) {
            fprintf(stderr, "kernel_launch: occupancy query reports %d blocks per CU; nothing launched\n", per_cu); (void)hipGetLastError(); grid = -1; return; }
        (void)hipGetLastError();
        if (cus != 256) { fprintf(stderr, "kernel_launch: built for a 256-CU device, found %d CUs; nothing launched\n", cus); grid = -1; return; }
        grid = cus;
        if (grid != 256) fprintf(stderr, "kernel_launch: note: %d CUs\n", grid);
    }
    if (grid < 0) return;
    if (hipMemsetAsync((char*)d_ws + WS_CTL, 0, CTL_ZERO_BYTES, stream) != hipSuccess) return;
    Args a{};
    for (int i = 0; i < 22; ++i) a.in[i] = (const float*)d_in[i];
    a.out = (float*)d_out; a.ws = (unsigned char*)d_ws;
    for (int li = 0; li < N_LAUNCHES; ++li) {
#ifdef PROBE_SKIP_LO
        if (li >= PROBE_SKIP_LO && li <= PROBE_SKIP_HI) continue;
#endif
        a.ph_lo = (N_LAUNCHES == 1) ? 0 : li; a.ph_hi = (N_LAUNCHES == 1) ? N_PHASES : li + 1; a.li = li;
        hipLaunchKernelGGL(fwd_mega, dim3(grid), dim3(NWAVES * 64), LDS_BYTES, stream, a);
        const hipError_t le = hipPeekAtLastError();
        if (le != hipSuccess) { fprintf(stderr, "kernel_launch: launch %d failed: %s\n", li, hipGetErrorName(le)); break; }
#ifdef DBG_CHECK_ATT
        if (li == 6) { hipLaunchKernelGGL(dbg_save_q, dim3(4096), dim3(64), 0, stream, (const unsigned char*)d_ws, (float*)((char*)d_ws + 210 * MiB));
                       hipLaunchKernelGGL(dbg_check_proj, dim3(128), dim3(256), 0, stream, (const unsigned char*)d_ws, (const float*)d_in[9], (unsigned*)d_ws + 16); }
        if (li == 2) hipLaunchKernelGGL(dbg_check_ffn_a, dim3(256), dim3(256), 0, stream, (const unsigned char*)d_ws, (const float*)d_in[5], (const float*)d_in[6], (unsigned*)d_ws + 16);
        if (li == 6) hipLaunchKernelGGL(dbg_check_qkv, dim3(256), dim3(256), 0, stream, (const unsigned char*)d_ws, (const float*)d_in[9], (unsigned*)d_ws + 16);
        if (li == 8) hipLaunchKernelGGL(dbg_check_gate, dim3(256), dim3(256), 0, stream, (const unsigned char*)d_ws, (const float*)d_in[9], (unsigned*)d_ws + 16);
        if (li == 9) { hipLaunchKernelGGL(dbg_check_merge, dim3(256), dim3(256), 0, stream, (const unsigned char*)d_ws, (const float*)d_in[15], (const float*)d_in[16], (unsigned*)d_ws + 16);
                       hipLaunchKernelGGL(dbg_save_out, dim3(256), dim3(256), 0, stream, (const float*)d_out, (float*)((char*)d_ws + 212 * MiB)); }
        if (li == 10) hipLaunchKernelGGL(dbg_check_out, dim3(256), dim3(256), 0, stream, (const unsigned char*)d_ws, (const float*)d_out, (const float*)((char*)d_ws + 212 * MiB), (const float*)d_in[17], (unsigned*)d_ws + 16);
        if (li == 7) hipLaunchKernelGGL(dbg_check_att, dim3(4096), dim3(256), 0, stream, (const unsigned char*)d_ws, (const float*)((char*)d_ws + 210 * MiB), (unsigned*)d_ws + 16);
#endif
#ifdef DBG_CHECK_MASK
        if (li == 6) hipLaunchKernelGGL(dbg_check_mask, dim3(128), dim3(512), 0, stream, (const unsigned char*)d_ws, (unsigned*)d_ws + 8);
#endif
    }
#ifdef DBG_CHECK_ATT
    hipLaunchKernelGGL(dbg_report2, dim3(1), dim3(1), 0, stream, (float*)d_out, (const unsigned*)d_ws + 16);
#endif
#ifdef DBG_CHECK_MASK
    hipLaunchKernelGGL(dbg_report, dim3(1), dim3(1), 0, stream, (float*)d_out, (const unsigned*)d_ws + 8);
#endif
}
```

```cpp
#include <hip/hip_runtime.h>
#include <cstdio>
#include <cstdint>
#include <cmath>
#ifndef MK_N_LAUNCHES
#define MK_N_LAUNCHES 1
#endif
__device__ __forceinline__ int mk_lane() { int l; asm volatile("v_mbcnt_lo_u32_b32 %0, -1, 0\n\tv_mbcnt_hi_u32_b32 %0, -1, %0" : "=v"(l)); return l; }
namespace pg8 {
#define PG8_LAS __attribute__((address_space(3)))
typedef unsigned short bf16_t;
typedef short bf16x8 __attribute__((ext_vector_type(8)));
typedef float f32x4 __attribute__((ext_vector_type(4)));
typedef unsigned u32x4 __attribute__((ext_vector_type(4)));
typedef int v4i_t __attribute__((ext_vector_type(4)));
typedef int v8i_t __attribute__((ext_vector_type(8)));
typedef unsigned u32x2 __attribute__((ext_vector_type(2)));
constexpr int BM = 256, BK = 64, HALF = 128, HTB = HALF * BK * 2  , STAGE_BYTES = 8 * HTB, NXCD = 8, WGM = 8;

__host__ __device__ __forceinline__ int lds_byte(int r, int c) { const int st = (r >> 4) * 2 + (c >> 5), rr = r & 15, cc = c & 31, ob = rr * 64 + cc * 2; return st * 1024 + (ob ^ (((ob >> 9) & 1) << 5)); }
__host__ __device__ __forceinline__ void stage_rc(int b, int& R, int& C) { const int st = b / 1024, sb = b % 1024, swz = sb ^ (((sb >> 9) & 1) << 5); R = (st >> 1) * 16 + swz / 64; C = (st & 1) * 32 + (swz % 64) / 2; }
__host__ __device__ __forceinline__ int perm32(int rho) { const int n = rho >> 4, i = rho & 15; return 8 * (i >> 2) + 4 * n + (i & 3); }

struct Unit { int pm, pn; };
struct Gemm { const bf16_t* A; const bf16_t* Bt; int M, N, K; };

struct StaticOrder {
    int nM, nN, nwg, G, c;
    __host__ __device__ void init(int M, int N, int G_, int c_) { nM = M / BM; nN = N / BM; nwg = nM * nN; G = G_; c = c_; }
    __host__ __device__ bool next(int i, Unit& u) const {
        const long L = (long)i * G + c; if (L >= nwg) return false;
        int wgid = (int)L; { const int q = nwg / NXCD, r = nwg % NXCD, xcd = wgid % NXCD, off = wgid / NXCD; wgid = (xcd < r ? xcd * (q + 1) : r * (q + 1) + (xcd - r) * q) + off; }
        const int nig = WGM * nN, gid = wgid / nig, fm = gid * WGM, gsz = (nM - fm) < WGM ? (nM - fm) : WGM;
        u.pm = fm + ((wgid % nig) % gsz); u.pn = (wgid % nig) / gsz; return true;
    }
    __device__ __forceinline__ void a_ready(const Unit&) const {}
    __device__ __forceinline__ void done(const Unit&) const {}
};

typedef float f32x2c_t __attribute__((ext_vector_type(2))); typedef __bf16 bf16x2c_t __attribute__((ext_vector_type(2)));
__device__ __forceinline__ unsigned cvt_pk_bf16(float lo, float hi) { f32x2c_t v = {lo, hi}; bf16x2c_t b = __builtin_convertvector(v, bf16x2c_t); return __builtin_bit_cast(unsigned, b); }
typedef float f32x2 __attribute__((ext_vector_type(2)));
__device__ __forceinline__ float sigmoidf_fast(float v) { return __builtin_amdgcn_rcpf(1.f + __builtin_amdgcn_exp2f(-1.4426950408889634f * v)); }
__device__ __forceinline__ float bf_lo(unsigned w) { return __builtin_bit_cast(float, w << 16); }
__device__ __forceinline__ float bf_hi(unsigned w) { return __builtin_bit_cast(float, w & 0xffff0000u); }
__device__ __forceinline__ unsigned pk4_fp8(float a, float b, float c, float d) { unsigned w = 0u; w = __builtin_amdgcn_cvt_pk_fp8_f32(a, b, w, false); w = __builtin_amdgcn_cvt_pk_fp8_f32(c, d, w, true); return w; }

struct EpiSwiglu {
    static constexpr bool PERM = true, AFTER_DRAIN = false;
    bf16_t* O; int ldc;
    __device__ __forceinline__ void operator()(const f32x4 (&acc)[2][2][4][2], const Unit& u, int wr, int wc, int fr, int fq) const {
        const int row0 = u.pm * BM + wr * 64 + fr, col0 = u.pn * HALF + wc * 32 + 8 * fq;
#pragma unroll
        for (int ai = 0; ai < 2; ++ai)
#pragma unroll
            for (int m = 0; m < 4; ++m) { bf16_t* rowp = O + (size_t)(row0 + ai * HALF + m * 16) * ldc + col0;
                f32x4 v[2];
#pragma unroll
                for (int n = 0; n < 2; ++n) { const f32x4 g = acc[ai][0][m][n], up = acc[ai][1][m][n];
#pragma unroll
                    for (int e = 0; e < 4; ++e) v[n][e] = g[e] * sigmoidf_fast(g[e]) * up[e]; }
                u32x4 w; w.x = cvt_pk_bf16(v[0][0], v[0][1]); w.y = cvt_pk_bf16(v[0][2], v[0][3]); w.z = cvt_pk_bf16(v[1][0], v[1][1]); w.w = cvt_pk_bf16(v[1][2], v[1][3]);
                *(u32x4*)rowp = w; }
    }
};


struct EpiSwiglu8 {
    static constexpr bool PERM = true, AFTER_DRAIN = false;
    unsigned char* O; int ldc; float wscale;
    __device__ __forceinline__ void operator()(const f32x4 (&acc)[2][2][4][2], const Unit& u, int wr, int wc, int fr, int fq) const {
        asm volatile("" : "+v"(fr), "+v"(fq));
        const int row0 = u.pm * BM + wr * 64 + fr, col0 = u.pn * HALF + wc * 32 + 8 * fq;
#pragma unroll
        for (int ai = 0; ai < 2; ++ai)
#pragma unroll
            for (int m = 0; m < 4; ++m) { asm volatile("" ::: "memory"); unsigned char* rowp = O + (size_t)(row0 + ai * HALF + m * 16) * ldc + col0;
                f32x4 v[2];
#pragma unroll
                for (int n = 0; n < 2; ++n) { const f32x4 g = acc[ai][0][m][n] * wscale, up = acc[ai][1][m][n] * wscale;
#pragma unroll
                    for (int e = 0; e < 4; ++e) v[n][e] = g[e] * sigmoidf_fast(g[e]) * up[e]; }
                u32x2 w; w.x = pk4_fp8(v[0][0], v[0][1], v[0][2], v[0][3]); w.y = pk4_fp8(v[1][0], v[1][1], v[1][2], v[1][3]);
                *(u32x2*)rowp = w; }
    }
};

template <bool IN16, bool OUT16> struct EpiResidT {
    static constexpr bool PERM = false, AFTER_DRAIN = false;
    const void* base; void* out; const float* gate; float coef;
    __device__ __forceinline__ void operator()(const f32x4 (&acc)[2][2][4][2], const Unit& u, int wr, int wc, int fr, int fq) const {
        asm volatile("" : "+v"(fr), "+v"(fq));
        const int row0 = u.pm * BM + wr * 64 + fr, col0 = u.pn * BM + wc * 32 + 4 * fq;
        const float* gp = gate + (size_t)(u.pm / 32) * 9216 + col0;
        f32x4 gv[2][2];
#pragma unroll
        for (int bj = 0; bj < 2; ++bj)
#pragma unroll
            for (int n = 0; n < 2; ++n) gv[bj][n] = *(const f32x4*)(gp + bj * HALF + n * 16) * coef;
#pragma unroll
        for (int ai = 0; ai < 2; ++ai)
#pragma unroll
            for (int m = 0; m < 4; ++m) { asm volatile("" ::: "memory"); const size_t off = (size_t)(row0 + ai * HALF + m * 16) * 1024 + col0;
#pragma unroll
                for (int bj = 0; bj < 2; ++bj)
#pragma unroll
                    for (int n = 0; n < 2; ++n) { const size_t o2 = off + bj * HALF + n * 16; f32x4 bs;
                        if constexpr (IN16) { const u32x2 r = *(const u32x2*)((const bf16_t*)base + o2);
                            bs.x = __builtin_bit_cast(float, r.x << 16); bs.y = __builtin_bit_cast(float, r.x & 0xffff0000u); bs.z = __builtin_bit_cast(float, r.y << 16); bs.w = __builtin_bit_cast(float, r.y & 0xffff0000u); }
                        else bs = *(const f32x4*)((const float*)base + o2);
                        const f32x4 y = bs + gv[bj][n] * acc[ai][bj][m][n];
                        if constexpr (OUT16) { u32x2 w; w.x = cvt_pk_bf16(y.x, y.y); w.y = cvt_pk_bf16(y.z, y.w); *(u32x2*)((bf16_t*)out + o2) = w; }
                        else {
#ifdef PROBE_ROUND16
                            const unsigned w0 = cvt_pk_bf16(y.x, y.y), w1 = cvt_pk_bf16(y.z, y.w); f32x4 yr; yr.x = __builtin_bit_cast(float, w0 << 16); yr.y = __builtin_bit_cast(float, w0 & 0xffff0000u); yr.z = __builtin_bit_cast(float, w1 << 16); yr.w = __builtin_bit_cast(float, w1 & 0xffff0000u);
                            *(f32x4*)((float*)out + o2) = yr;
#else
                            *(f32x4*)((float*)out + o2) = y;
#endif
                        } } }
    }
};

struct EpiGate {
    static constexpr bool PERM = true, AFTER_DRAIN = false;
    bf16_t* O; float wscale;
    __device__ __forceinline__ void operator()(const f32x4 (&acc)[2][2][4][2], const Unit& u, int wr, int wc, int fr, int fq) const {
        const int row0 = u.pm * BM + wr * 64 + fr, col0 = u.pn * BM + wc * 32 + 8 * fq;
#pragma unroll
        for (int ai = 0; ai < 2; ++ai)
#pragma unroll
            for (int m = 0; m < 4; ++m) { bf16_t* rowp = O + (size_t)(row0 + ai * HALF + m * 16) * 2048 + col0;
#pragma unroll
                for (int bj = 0; bj < 2; ++bj) { f32x4 v0 = acc[ai][bj][m][0], v1 = acc[ai][bj][m][1];
#pragma unroll
                    for (int e = 0; e < 4; ++e) { v0[e] = sigmoidf_fast(v0[e] * wscale); v1[e] = sigmoidf_fast(v1[e] * wscale); }
                    u32x4 w; w.x = cvt_pk_bf16(v0[0], v0[1]); w.y = cvt_pk_bf16(v0[2], v0[3]); w.z = cvt_pk_bf16(v1[0], v1[1]); w.w = cvt_pk_bf16(v1[2], v1[3]);
                    *(u32x4*)(rowp + bj * HALF) = w; } }
    }
};

struct EpiMerge {
    static constexpr bool PERM = true, AFTER_DRAIN = false;
    const bf16_t* SG; unsigned char* O; float wscale;
    __device__ __forceinline__ void operator()(const f32x4 (&acc)[2][2][4][2], const Unit& u, int wr, int wc, int fr, int fq) const {
        const int row0 = u.pm * BM + wr * 64 + fr, col0 = u.pn * HALF + wc * 32 + 8 * fq;
#pragma unroll
        for (int ai = 0; ai < 2; ++ai)
#pragma unroll
            for (int m = 0; m < 4; ++m) { const size_t r = (size_t)(row0 + ai * HALF + m * 16);
                const u32x4 ga = *(const u32x4*)(SG + r * 2048 + col0), gb = *(const u32x4*)(SG + r * 2048 + 1024 + col0);
                const f32x4 a0 = acc[ai][0][m][0], a1 = acc[ai][0][m][1], b0 = acc[ai][1][m][0], b1 = acc[ai][1][m][1];
                const float ws_ = wscale; u32x2 w;
                w.x = pk4_fp8((bf_lo(ga.x) * a0[0] + bf_lo(gb.x) * b0[0]) * ws_, (bf_hi(ga.x) * a0[1] + bf_hi(gb.x) * b0[1]) * ws_, (bf_lo(ga.y) * a0[2] + bf_lo(gb.y) * b0[2]) * ws_, (bf_hi(ga.y) * a0[3] + bf_hi(gb.y) * b0[3]) * ws_);
                w.y = pk4_fp8((bf_lo(ga.z) * a1[0] + bf_lo(gb.z) * b1[0]) * ws_, (bf_hi(ga.z) * a1[1] + bf_hi(gb.z) * b1[1]) * ws_, (bf_lo(ga.w) * a1[2] + bf_lo(gb.w) * b1[2]) * ws_, (bf_hi(ga.w) * a1[3] + bf_hi(gb.w) * b1[3]) * ws_);
                *(u32x2*)(O + r * 1024 + col0) = w; }
    }
};

struct EpiInA {
    static constexpr bool PERM = true, AFTER_DRAIN = false;
    bf16_t *QKV; bf16_t *QI, *KI; float *WI, *LF;
    const float *gains;
    int pn0; float wscale;
    __device__ __forceinline__ void operator()(const f32x4 (&acc0)[2][2][4][2], const Unit& u, int wr, int wc, int fr, int fq) const {
        const int row0 = u.pm * BM + wr * 64 + fr, pn = u.pn + pn0;
        const float ws_ = wscale;
#define acc(AI, BJ, MM, NN) (acc0[AI][BJ][MM][NN] * ws_)
        const int sec = pn >> 1;
        if (sec == 0 || sec == 1 || sec == 3 || sec == 4) {
            const bool isq = (sec == 0 || sec == 3), isfox = (sec >= 3);
            const float* gain = gains + 64 * (sec - (isfox ? 1 : 0));
            bf16_t* dst = QKV + (isq ? (size_t)0 : (size_t)16777216) + (isfox ? 512 : 0) + ((pn & 1) * 4 + wc) * 64 + 8 * fq;
            const float post = isq ? 0.125f * 1.4426950408889634f : 1.0f;
            f32x4 gv[2][2];
#pragma unroll
            for (int bj = 0; bj < 2; ++bj)
#pragma unroll
                for (int n = 0; n < 2; ++n) gv[bj][n] = *(const f32x4*)(gain + 32 * bj + 8 * fq + 4 * n) * post;
#pragma unroll
            for (int ai = 0; ai < 2; ++ai)
#pragma unroll
                for (int m = 0; m < 4; ++m) {
                    float ss = 0.f;
#pragma unroll
                    for (int bj = 0; bj < 2; ++bj)
#pragma unroll
                        for (int n = 0; n < 2; ++n) { const f32x4 x = acc(ai, bj, m, n); ss += (x[0] * x[0] + x[1] * x[1]) + (x[2] * x[2] + x[3] * x[3]); }
                    ss += __shfl_xor(ss, 16); ss += __shfl_xor(ss, 32);
                    const float rstd = __builtin_amdgcn_rsqf(ss * (1.0f / 64.0f) + 1e-6f);
                    bf16_t* rowp = dst + (size_t)(row0 + ai * HALF + m * 16) * 1024;
#pragma unroll
                    for (int bj = 0; bj < 2; ++bj) { const f32x4 v0 = acc(ai, bj, m, 0) * rstd * gv[bj][0], v1 = acc(ai, bj, m, 1) * rstd * gv[bj][1];
                        u32x4 w; w.x = cvt_pk_bf16(v0[0], v0[1]); w.y = cvt_pk_bf16(v0[2], v0[3]); w.z = cvt_pk_bf16(v1[0], v1[1]); w.w = cvt_pk_bf16(v1[2], v1[3]);
                        *(u32x4*)(rowp + 32 * bj) = w; } }
        } else if (sec == 2 || sec == 5 || sec == 6) {
            bf16_t* dst; int ld; float sc = 1.f;
            if (sec == 6) { dst = QI + (pn & 1) * 256; ld = 512; sc = 0.125f; } else { dst = QKV + (size_t)33554432 + (sec == 5 ? 512 : 0) + (pn & 1) * 256; ld = 1024; }
            dst += wc * 32 + 8 * fq;
#pragma unroll
            for (int ai = 0; ai < 2; ++ai)
#pragma unroll
                for (int m = 0; m < 4; ++m) { bf16_t* rowp = dst + (size_t)(row0 + ai * HALF + m * 16) * ld;
#pragma unroll
                    for (int bj = 0; bj < 2; ++bj) { const f32x4 v0 = acc(ai, bj, m, 0) * sc, v1 = acc(ai, bj, m, 1) * sc;
                        u32x4 w; w.x = cvt_pk_bf16(v0[0], v0[1]); w.y = cvt_pk_bf16(v0[2], v0[3]); w.z = cvt_pk_bf16(v1[0], v1[1]); w.w = cvt_pk_bf16(v1[2], v1[3]);
                        *(u32x4*)(rowp + bj * HALF) = w; } }
        } else {
            if (wc < 2) {
#pragma unroll
                for (int ai = 0; ai < 2; ++ai)
#pragma unroll
                    for (int m = 0; m < 4; ++m) { const f32x4 v0 = acc(ai, 0, m, 0), v1 = acc(ai, 0, m, 1);
                        u32x4 w; w.x = cvt_pk_bf16(v0[0], v0[1]); w.y = cvt_pk_bf16(v0[2], v0[3]); w.z = cvt_pk_bf16(v1[0], v1[1]); w.w = cvt_pk_bf16(v1[2], v1[3]);
                        const int row = row0 + ai * HALF + m * 16;
                        *(u32x4*)(KI + (size_t)(row >> 5) * 2048 + ((4 * wc + fq) * 32 + (row & 31)) * 8) = w; }
            } else if (wc == 2 && fq == 0) {
#pragma unroll
                for (int ai = 0; ai < 2; ++ai)
#pragma unroll
                    for (int m = 0; m < 4; ++m) { float* p = WI + (size_t)(row0 + ai * HALF + m * 16) * 8;
                        *(f32x4*)p = acc(ai, 0, m, 0) * 0.35355339059327373f; *(f32x4*)(p + 4) = acc(ai, 0, m, 1) * 0.35355339059327373f; }
            } else if (wc == 2 && fq == 1) {
                const f32x4 bf0 = *(const f32x4*)(gains + 256), bf1 = *(const f32x4*)(gains + 260);
#pragma unroll
                for (int ai = 0; ai < 2; ++ai)
#pragma unroll
                    for (int m = 0; m < 4; ++m) { const int row = row0 + ai * HALF + m * 16; float* p = LF + (size_t)(row >> 13) * 65536 + (row & 8191);
#pragma unroll
                        for (int n = 0; n < 2; ++n)
#pragma unroll
                            for (int e = 0; e < 4; ++e) { const float x = acc(ai, 0, m, n)[e] + (n ? bf1[e] : bf0[e]);
                                const float ls = fminf(x, 0.f) - __logf(1.f + __expf(-fabsf(x)));
                                p[(size_t)(4 * n + e) * 8192] = ls; } }
            }
        }
#undef acc
    }
};
template <class Epi, class Sched, bool ALIGN_EPI = false, bool SP2 = false, bool F8 = false>
__device__ __forceinline__ void gemm_phase(PG8_LAS unsigned char* lds, const Gemm g, const Sched& S, const Epi& E, const int wave_in) {
    const int lane = mk_lane(), wid = __builtin_amdgcn_readfirstlane(wave_in), tid = wid * 64 + lane, wr = wid >> 2, wc = wid & 3, fr = lane & 15, fq = lane >> 4;
    const int K = g.K, nt = K / BK;
    unsigned voffA[2], voffB[2];
#pragma unroll
    for (int i = 0; i < 2; ++i) { int R, C; stage_rc(tid * 16 + i * 8192, R, C); const int Rb = Epi::PERM ? ((R & ~31) + perm32(R & 31)) : R;
        voffA[i] = (unsigned)(R * K + C) * 2u; voffB[i] = (unsigned)(Rb * K + C) * 2u; }
    const size_t kstep = (size_t)(BK * 2);
    const size_t hstep = (size_t)HALF * K * 2;
    const size_t tstep = 2 * hstep;
    const unsigned ldsw = (unsigned)wid * 1024u;
    const int aoff = lds_byte(wr * 64 + fr, fq * 8), boff = lds_byte(wc * 32 + fr, fq * 8);
    const int aoff8 = lds_byte(wr * 64 + fr, fq * 16), boff8 = lds_byte(wc * 32 + fr, fq * 16);
#define PG8_SA(b, h) (((b) * 2 + (h)) * HTB)
#define PG8_SB(b, h) ((4 + (b) * 2 + (h)) * HTB)
#define PG8_STAGE(bufoff, gbase, voff) do { _Pragma("unroll") for (int _i = 0; _i < 2; ++_i) \
        __builtin_amdgcn_global_load_lds((const unsigned*)((const char*)(gbase) + (voff)[_i]), (PG8_LAS unsigned*)(lds + (bufoff) + ldsw + _i * 8192), 16, 0, 0); } while (0)
#define PG8_LD2(base_) __builtin_shufflevector(*(const PG8_LAS v4i_t*)(base_), *(const PG8_LAS v4i_t*)((base_) + 1024), 0, 1, 2, 3, 4, 5, 6, 7)
#define PG8_LDA(dst, b, h) do { if constexpr (F8) { _Pragma("unroll") for (int m = 0; m < 4; ++m) dst##8[m] = PG8_LD2(lds + PG8_SA(b, h) + aoff + m * 2048); } \
        else { _Pragma("unroll") for (int m = 0; m < 4; ++m) _Pragma("unroll") for (int k = 0; k < 2; ++k) dst[m][k] = *(const PG8_LAS bf16x8*)(lds + PG8_SA(b, h) + aoff + m * 2048 + k * 1024); } } while (0)
#define PG8_LDB(dst, b, h) do { if constexpr (F8) { _Pragma("unroll") for (int n = 0; n < 2; ++n) dst##8[n] = PG8_LD2(lds + PG8_SB(b, h) + boff + n * 2048); } \
        else { _Pragma("unroll") for (int n = 0; n < 2; ++n) _Pragma("unroll") for (int k = 0; k < 2; ++k) dst[n][k] = *(const PG8_LAS bf16x8*)(lds + PG8_SB(b, h) + boff + n * 2048 + k * 1024); } } while (0)
#define PG8_CAT8(x0, x1) __builtin_shufflevector(__builtin_bit_cast(v4i_t, x0), __builtin_bit_cast(v4i_t, x1), 0, 1, 2, 3, 4, 5, 6, 7)
#define PG8_MMA(ai, bj, At, Bt) do { __builtin_amdgcn_s_setprio(1); \
        if constexpr (F8) { _Pragma("unroll") for (int m = 0; m < 4; ++m) _Pragma("unroll") for (int n = 0; n < 2; ++n) \
            asm volatile("v_mfma_scale_f32_16x16x128_f8f6f4 %0, %1, %2, %0, %3, %3 op_sel_hi:[0,0,0]" : "+v"(acc[ai][bj][m][n]) : "v"(Bt##8[n]), "v"(At##8[m]), "v"(sc1)); } \
        else { _Pragma("unroll") for (int m = 0; m < 4; ++m) _Pragma("unroll") for (int n = 0; n < 2; ++n) _Pragma("unroll") for (int k = 0; k < 2; ++k) \
            acc[ai][bj][m][n] = __builtin_amdgcn_mfma_f32_16x16x32_bf16(Bt[n][k], At[m][k], acc[ai][bj][m][n], 0, 0, 0); } \
        __builtin_amdgcn_s_setprio(0); } while (0)
#define PG8_WAIT_V(n) asm volatile("s_waitcnt vmcnt(" #n ")" ::: "memory")
#define PG8_WAIT_L(n) asm volatile("s_waitcnt lgkmcnt(" #n ")" ::: "memory")
#define PG8_BAR __builtin_amdgcn_s_barrier()
#define PG8_SCHED __builtin_amdgcn_sched_barrier(0)
    Unit cur, nxt; int ui = 0;
    if (!S.next(0, cur)) return;
    f32x4 acc[2][2][4][2];
#pragma unroll
    for (int a = 0; a < 2; ++a)
#pragma unroll
        for (int b = 0; b < 2; ++b)
#pragma unroll
            for (int m = 0; m < 4; ++m)
#pragma unroll
                for (int n = 0; n < 2; ++n) { acc[a][b][m][n] = (f32x4){0.f, 0.f, 0.f, 0.f}; }
    bf16x8 At[4][2], B0[2][2], B1[2][2]; v8i_t At8[4], B08[2], B18[2];
    int sc1 = 0x7F7F7F7F; asm volatile("" : "+v"(sc1));
    const char* cA = (const char*)g.A + (size_t)cur.pm * tstep; const char* cB = (const char*)g.Bt + (size_t)cur.pn * tstep;
    S.a_ready(cur);
    if constexpr (SP2) {
        PG8_STAGE(PG8_SB(0, 0), cB, voffB); PG8_STAGE(PG8_SB(0, 1), cB + hstep, voffB); PG8_STAGE(PG8_SA(0, 0), cA, voffA); PG8_STAGE(PG8_SA(0, 1), cA + hstep, voffA);
        if (wr == 1) PG8_BAR;
        PG8_WAIT_V(2); PG8_BAR;
        PG8_STAGE(PG8_SB(1, 0), cB + kstep, voffB); PG8_STAGE(PG8_SA(1, 0), cA + kstep, voffA); PG8_STAGE(PG8_SB(1, 1), cB + hstep + kstep, voffB);
        PG8_WAIT_V(6); PG8_BAR;
    } else {
        PG8_STAGE(PG8_SB(0, 0), cB, voffB); PG8_STAGE(PG8_SA(0, 0), cA, voffA); PG8_STAGE(PG8_SB(0, 1), cB + hstep, voffB); PG8_STAGE(PG8_SA(0, 1), cA + hstep, voffA);
        if (wr == 1) PG8_BAR;
        PG8_WAIT_V(4); PG8_BAR;
        PG8_STAGE(PG8_SB(1, 0), cB + kstep, voffB); PG8_STAGE(PG8_SA(1, 0), cA + kstep, voffA); PG8_STAGE(PG8_SB(1, 1), cB + hstep + kstep, voffB);
        PG8_WAIT_V(6); PG8_BAR;
    }
    for (;;) {
        const bool has_next = S.next(ui + 1, nxt);
        const char* nA = has_next ? (const char*)g.A + (size_t)nxt.pm * tstep : cA; const char* nB = has_next ? (const char*)g.Bt + (size_t)nxt.pn * tstep : cB;
#pragma unroll 1
        for (int t = 0; t < nt; t += 2) {
            const bool last = (t == nt - 2);
            const char* a1 = cA + (size_t)(t + 1) * kstep;
            const char* a2 = last ? nA : cA + (size_t)(t + 2) * kstep; const char* b2 = last ? nB : cB + (size_t)(t + 2) * kstep;
            const char* a3 = a2 + kstep; const char* b3 = b2 + kstep;
            if (last && has_next) S.a_ready(nxt);
            if constexpr (SP2) {
            PG8_LDB(B0, 0, 0); PG8_LDB(B1, 0, 1); PG8_SCHED; PG8_LDA(At, 0, 0); PG8_STAGE(PG8_SA(1, 1), a1 + hstep, voffA);
            PG8_WAIT_V(8); PG8_WAIT_L(0); PG8_BAR; PG8_MMA(0, 0, At, B0); PG8_MMA(0, 1, At, B1); PG8_BAR; PG8_SCHED;
            PG8_LDA(At, 0, 1); PG8_STAGE(PG8_SB(0, 0), b2, voffB); PG8_STAGE(PG8_SB(0, 1), b2 + hstep, voffB); PG8_STAGE(PG8_SA(0, 0), a2, voffA);
            PG8_WAIT_V(8); PG8_WAIT_L(0); PG8_BAR; PG8_MMA(1, 0, At, B0); PG8_MMA(1, 1, At, B1); PG8_BAR; PG8_SCHED;
            PG8_LDB(B0, 1, 0); PG8_LDB(B1, 1, 1); PG8_SCHED; PG8_LDA(At, 1, 0); PG8_STAGE(PG8_SA(0, 1), a2 + hstep, voffA);
            PG8_WAIT_V(8); PG8_WAIT_L(0); PG8_BAR; PG8_MMA(0, 0, At, B0); PG8_MMA(0, 1, At, B1); PG8_BAR; PG8_SCHED;
            PG8_LDA(At, 1, 1); PG8_STAGE(PG8_SB(1, 0), b3, voffB); PG8_STAGE(PG8_SB(1, 1), b3 + hstep, voffB); PG8_STAGE(PG8_SA(1, 0), a3, voffA);
            PG8_WAIT_V(8); PG8_WAIT_L(0); PG8_BAR; PG8_MMA(1, 0, At, B0); PG8_MMA(1, 1, At, B1); PG8_BAR; PG8_SCHED;
            } else {
            PG8_LDB(B0, 0, 0); PG8_SCHED; PG8_LDA(At, 0, 0); PG8_STAGE(PG8_SA(1, 1), a1 + hstep, voffA);
            PG8_WAIT_L(8); PG8_BAR; PG8_WAIT_L(0); PG8_MMA(0, 0, At, B0); PG8_BAR; PG8_SCHED;
            PG8_LDB(B1, 0, 1); PG8_STAGE(PG8_SB(0, 0), b2, voffB);
            PG8_BAR; PG8_WAIT_L(0); PG8_MMA(0, 1, At, B1); PG8_BAR;
            PG8_LDA(At, 0, 1); PG8_STAGE(PG8_SA(0, 0), a2, voffA);
            PG8_BAR; PG8_WAIT_L(0); PG8_MMA(1, 0, At, B0); PG8_BAR; PG8_SCHED;
            PG8_STAGE(PG8_SB(0, 1), b2 + hstep, voffB);
            PG8_WAIT_V(6); PG8_BAR; PG8_MMA(1, 1, At, B1); PG8_BAR;
            PG8_LDB(B0, 1, 0); PG8_SCHED; PG8_LDA(At, 1, 0); PG8_STAGE(PG8_SA(0, 1), a2 + hstep, voffA);
            PG8_WAIT_L(8); PG8_BAR; PG8_WAIT_L(0); PG8_MMA(0, 0, At, B0); PG8_BAR; PG8_SCHED;
            PG8_LDB(B1, 1, 1); PG8_STAGE(PG8_SB(1, 0), b3, voffB);
            PG8_BAR; PG8_WAIT_L(0); PG8_MMA(0, 1, At, B1); PG8_BAR;
            PG8_LDA(At, 1, 1); PG8_STAGE(PG8_SA(1, 0), a3, voffA);
            PG8_BAR; PG8_WAIT_L(0); PG8_MMA(1, 0, At, B0); PG8_BAR; PG8_SCHED;
            PG8_STAGE(PG8_SB(1, 1), b3 + hstep, voffB);
            PG8_WAIT_V(6); PG8_BAR; PG8_MMA(1, 1, At, B1); PG8_BAR;
            }
        }
        if constexpr (F8) asm volatile("s_nop 15\n\ts_nop 15" ::: "memory");
        if constexpr (ALIGN_EPI) { if (wr == 0) PG8_BAR; }
        if constexpr (!Epi::AFTER_DRAIN) { E(acc, cur, wr, wc, fr, fq); S.done(cur); }
        if (!has_next) break;
#pragma unroll
        for (int a = 0; a < 2; ++a)
#pragma unroll
            for (int b = 0; b < 2; ++b)
#pragma unroll
                for (int m = 0; m < 4; ++m)
#pragma unroll
                    for (int n = 0; n < 2; ++n) { acc[a][b][m][n] = (f32x4){0.f, 0.f, 0.f, 0.f}; }
        cur = nxt; cA = nA; cB = nB; ++ui;
        if constexpr (ALIGN_EPI) { if (wr == 1) PG8_BAR; }
    }
    PG8_WAIT_V(0);
    if constexpr (!ALIGN_EPI) { if (wr == 0) PG8_BAR; }
    PG8_BAR;
    if constexpr (Epi::AFTER_DRAIN) { E.fused(acc, cur, wr, wc, fr, fq, lds, wid, lane); S.done(cur); }
#undef PG8_SA
#undef PG8_SB
#undef PG8_STAGE
#undef PG8_LD2
#undef PG8_LDA
#undef PG8_LDB
#undef PG8_MMA
#undef PG8_CAT8
#undef PG8_WAIT_V
#undef PG8_WAIT_L
#undef PG8_BAR
#undef PG8_SCHED
}
}
namespace att {
#ifdef PROBE_ZERO_TYPE
#define PROBE_ZF(T) ((T)==PROBE_ZERO_TYPE?0.f:1.f)
#else
#define PROBE_ZF(T) 1.f
#endif
typedef unsigned short bf16_t;
using bf16x8=__attribute__((ext_vector_type(8)))short;
using s16x4=__attribute__((ext_vector_type(4)))short;
using f32x16=__attribute__((ext_vector_type(16)))float;
using f32x4=__attribute__((ext_vector_type(4)))float;
using u32x4=__attribute__((ext_vector_type(4)))unsigned;
constexpr int SEQ=8192,D=64,DM=1024;
constexpr int NW=8,QBLK=32,QB=QBLK*NW,KVBLK=64;
__device__ __forceinline__ int crow(int r,int hi){return (r&3)+8*(r>>2)+4*hi;}
#define SBAR() __builtin_amdgcn_sched_barrier(0)
__device__ __forceinline__ void cmask(f32x16&p0,f32x16&p1,int jb,int qrel,int hi){
  const float NEG=-INFINITY; int kb=64*jb+4*hi;
  #pragma unroll
  for(int r=0;r<16;++r){int kv=kb+(r&3)+8*(r>>2); if(kv>qrel)p0[r]=NEG; if(kv+32>qrel)p1[r]=NEG;}
}
constexpr int SLOTB=8192;
constexpr int RS=6, RD=4;
constexpr int LDS_K=0, LDS_V=RS*SLOTB, LDS_WS=2*RS*SLOTB, LDS_FK=LDS_WS+NW*64*4, LDS_BYTES=LDS_FK+32768+256;
constexpr int LDS_OST=0;
constexpr int LDS_MR=LDS_FK, LDS_FLG=LDS_FK+32768;
__device__ __forceinline__ void glds16(const void*gsrc,unsigned lds_dst){unsigned keep;
  asm volatile("s_mov_b32 %0, m0\n\ts_mov_b32 m0, %2\n\ts_nop 0\n\tglobal_load_lds_dwordx4 %1, off\n\ts_mov_b32 m0, %0":"=&s"(keep):"v"(gsrc),"s"(lds_dst):"memory");}
__device__ __forceinline__ void glds4(const void*gsrc,unsigned lds_dst){unsigned keep;
  asm volatile("s_mov_b32 %0, m0\n\ts_mov_b32 m0, %2\n\ts_nop 0\n\tglobal_load_lds_dword %1, off\n\ts_mov_b32 m0, %0":"=&s"(keep):"v"(gsrc),"s"(lds_dst):"memory");}
__device__ __forceinline__ float max3f(float a,float b,float c){float r;asm("v_max3_f32 %0, %1, %2, %3":"=v"(r):"v"(a),"v"(b),"v"(c));return r;}
__device__ __forceinline__ float max2f(float a,float b){float r;asm("v_max_f32_e32 %0, %1, %2":"=v"(r):"v"(a),"v"(b));return r;}
typedef float f32x2_t __attribute__((ext_vector_type(2))); typedef __bf16 bf16x2_t __attribute__((ext_vector_type(2)));
__device__ __forceinline__ unsigned cvtpk_s(float lo,float hi){f32x2_t v={lo,hi};bf16x2_t b=__builtin_convertvector(v,bf16x2_t);return __builtin_bit_cast(unsigned,b);}
__device__ __forceinline__ void xhalf_pair(float v,float&lo,float&hi_){unsigned a=__builtin_bit_cast(unsigned,v),b=a;
  asm volatile("s_nop 1\n\tv_permlane32_swap_b32 %0, %1\n\ts_nop 1":"+v"(a),"+v"(b)); lo=__builtin_bit_cast(float,a); hi_=__builtin_bit_cast(float,b);}
__device__ __forceinline__ float xhalf_sum(float v){float lo,h;xhalf_pair(v,lo,h);return lo+h;}
__device__ __forceinline__ float xhalf_max(float v){float lo,h;xhalf_pair(v,lo,h);return __builtin_fmaxf(lo,h);}
#define WAIT_ALL_BAR() asm volatile("s_waitcnt vmcnt(0) lgkmcnt(0)\n\ts_barrier":::"memory")

__device__ __forceinline__ void qkt(f32x16&p0,f32x16&p1,const char*Kslot,const bf16x8*qr,const f32x16&cinit,const f32x16&cinit1,int r32,int hi){
  const char*kb=Kslot+hi*1024+r32*16;
  #pragma unroll
  for(int d0=0;d0<4;++d0){
    const bf16x8 b0=*reinterpret_cast<const bf16x8*>(kb+d0*2048);
    const bf16x8 b1=*reinterpret_cast<const bf16x8*>(kb+d0*2048+512);
    if(d0==0){p0=__builtin_amdgcn_mfma_f32_32x32x16_bf16(b0,qr[0],cinit,0,0,0);p1=__builtin_amdgcn_mfma_f32_32x32x16_bf16(b1,qr[0],cinit1,0,0,0);}
    else{p0=__builtin_amdgcn_mfma_f32_32x32x16_bf16(b0,qr[d0],p0,0,0,0);p1=__builtin_amdgcn_mfma_f32_32x32x16_bf16(b1,qr[d0],p1,0,0,0);}}
}
__device__ __forceinline__ float rowmax(const f32x16&p0,const f32x16&p1){
  float a=max3f(p0[0],p0[1],p1[0]),b=max3f(p0[2],p0[3],p1[1]);a=max3f(a,p1[2],p1[3]);
  #pragma unroll
  for(int r=4;r<16;r+=4){a=max3f(a,p0[r],p0[r+1]);b=max3f(b,p0[r+2],p0[r+3]);a=max3f(a,p1[r],p1[r+1]);b=max3f(b,p1[r+2],p1[r+3]);}
  const float m=max2f(a,b);
  return xhalf_max(m);
}
__device__ __forceinline__ void pv(f32x16*o,f32x16&ol,int vb,bf16x8 pa0,bf16x8 pa1,bf16x8 pa2,bf16x8 pa3){
  #pragma unroll
  for(int d0=0;d0<2;++d0){s16x4 lo[4],hi[4];
    #pragma unroll
    for(int ks=0;ks<4;++ks){
      asm volatile("ds_read_b64_tr_b16 %0,%1 offset:%c2":"=&v"(lo[ks]):"v"(vb),"i"(d0*4096+ks*1024):"memory");
      asm volatile("ds_read_b64_tr_b16 %0,%1 offset:%c2":"=&v"(hi[ks]):"v"(vb),"i"(d0*4096+ks*1024+512):"memory");}
    if(d0==0){ const bf16x8 ones={(short)0x3f80,(short)0x3f80,(short)0x3f80,(short)0x3f80,(short)0x3f80,(short)0x3f80,(short)0x3f80,(short)0x3f80};
      ol=__builtin_amdgcn_mfma_f32_32x32x16_bf16(pa0,ones,ol,0,0,0); ol=__builtin_amdgcn_mfma_f32_32x32x16_bf16(pa1,ones,ol,0,0,0);
      ol=__builtin_amdgcn_mfma_f32_32x32x16_bf16(pa2,ones,ol,0,0,0); ol=__builtin_amdgcn_mfma_f32_32x32x16_bf16(pa3,ones,ol,0,0,0); }
    asm volatile("s_waitcnt lgkmcnt(0)":::"memory");SBAR();
    #define PK(k) (bf16x8){lo[k][0],lo[k][1],lo[k][2],lo[k][3],hi[k][0],hi[k][1],hi[k][2],hi[k][3]}
    o[d0]=__builtin_amdgcn_mfma_f32_32x32x16_bf16(pa0,PK(0),o[d0],0,0,0);
    o[d0]=__builtin_amdgcn_mfma_f32_32x32x16_bf16(pa1,PK(1),o[d0],0,0,0);
    o[d0]=__builtin_amdgcn_mfma_f32_32x32x16_bf16(pa2,PK(2),o[d0],0,0,0);
    o[d0]=__builtin_amdgcn_mfma_f32_32x32x16_bf16(pa3,PK(3),o[d0],0,0,0);
    #undef PK
  }
}

template<int TYPE> __device__ __forceinline__ void attn_unit(int b,int h16,int qb,const bf16_t*Q,const bf16_t*__restrict__ K,const bf16_t*__restrict__ V,unsigned char*O,
                                                              const float*__restrict__ F2,const unsigned long long*__restrict__ mask,char*shm,const float qkmax2,const int wave_in,
                                                              const int piece=0,const int np=1,const int per=0,float*part=nullptr,unsigned*pctr=nullptr,const int viscap=1<<20){
  const int lane=mk_lane(),r32=lane&31,hi=lane>>5; const int wid=__builtin_amdgcn_readfirstlane(wave_in); const int tid=wid*64+lane;
  const long rowbase=(long)b*SEQ; const int q0=qb*QB;
  const bf16_t*Qw=Q+(rowbase+q0+wid*QBLK)*DM+h16*D;
  const bf16_t*Kh=K+rowbase*DM+h16*D,*Vh=V+rowbase*DM+h16*D;
  const unsigned lds0=(unsigned)(uintptr_t)shm;
  float*wsf=(float*)(shm+LDS_WS)+wid*64;
  float*fk=(float*)(shm+LDS_FK);
  const bf16_t*ksrc=Kh+(long)lane*DM+wid*8;
  const bf16_t*vsrc=Vh+(long)(16*(wid&3)+(lane>>2))*DM+(wid>>2)*32+(lane&3)*8;
  const unsigned kdst=lds0+LDS_K+wid*1024, vdst=lds0+LDS_V+wid*1024;
  #define DMA_K(t,slot) glds16(ksrc+(long)(t)*KVBLK*DM,(unsigned)__builtin_amdgcn_readfirstlane(kdst+(slot)))
  #define DMA_V(t,slot) glds16(vsrc+(long)(t)*KVBLK*DM,(unsigned)__builtin_amdgcn_readfirstlane(vdst+(slot)))
  const int vb0=(int)(lds0+LDS_V)+((lane>>4)&1)*32+(lane&3)*8+(4*hi+((lane&15)>>2))*64;
  const int NT=(q0+QB)/KVBLK;
  const int tq=q0+wid*QBLK+r32;
  int t_begin=0;
  float Fq=0.f, sl2=0.f;
  if(TYPE==0){ const float*f2h=F2+((size_t)b*8+(h16-8))*SEQ; Fq=f2h[tq];
    { const float f0=f2h[q0]; const int j0=lane, j1=lane+64;
      const float e0=(j0<NT-4)?f2h[j0*KVBLK+KVBLK-1]:0.f, e1=(j1<NT-4)?f2h[j1*KVBLK+KVBLK-1]:0.f;
      const bool v0=(j0>=NT-4)||!(f0-e0+2.f*qkmax2 < -40.f), v1=(j1>=NT-4)||!(f0-e1+2.f*qkmax2 < -40.f);
      const unsigned long long b0=__ballot(v0), b1=__ballot(v1);
      t_begin=b0?(int)__builtin_ctzll(b0):64+(int)__builtin_ctzll(b1); if(t_begin>NT-4)t_begin=NT-4;
      if(t_begin<NT-viscap)t_begin=NT-viscap; }
    for(int i=t_begin*KVBLK+tid;i<NT*KVBLK;i+=NW*64)fk[i]=f2h[i];
    asm volatile("":"+v"(Fq));
    asm volatile("s_waitcnt vmcnt(0) lgkmcnt(0)\n\ts_barrier":::"memory"); }
  else { sl2=__builtin_amdgcn_exp2f(-(float)(h16+1))*1.4426950408889634f; }
  const int i_lo=(TYPE==1&&np>1)?piece*per:0, i_hi=(TYPE==1&&np>1&&piece<np-1)?((piece+1)*per<NT?(piece+1)*per:NT):NT;
  #define TILE_OF(i_) (NT-1-i_lo-(i_))
  const int nvis=(TYPE==0)?NT-t_begin:i_hi-i_lo;
  const unsigned*mrow=(const unsigned*)(mask+((size_t)rowbase+tq)*128);
  const unsigned mdst=lds0+LDS_MR+wid*256;
  typedef __attribute__((address_space(3))) const unsigned* lds_cup;
  lds_cup mring=(lds_cup)(__attribute__((address_space(3))) char*)(shm+LDS_MR);
  #define ISSUE(i_,st_) do{ const int t_=TILE_OF(i_); DMA_K(t_,(st_)*SLOTB); DMA_V(t_,(st_)*SLOTB); \
      if(TYPE==1){ glds4(mrow+2*t_,(unsigned)__builtin_amdgcn_readfirstlane(mdst+(st_)*4096)); glds4(mrow+2*t_+1,(unsigned)__builtin_amdgcn_readfirstlane(mdst+(st_)*4096+2048)); } }while(0)
  #pragma unroll
  for(int i=0;i<RD;++i) if(i<nvis) ISSUE(i,i);
  bf16x8 qr[4];
  #pragma unroll
  for(int d0=0;d0<4;++d0)qr[d0]=*reinterpret_cast<const bf16x8*>(&Qw[(long)r32*DM+d0*16+hi*8]);
  asm volatile("":"+v"(qr[0]),"+v"(qr[1]),"+v"(qr[2]),"+v"(qr[3]));
  float m_run=-INFINITY;f32x16 o[2];o[0]=f32x16{};o[1]=f32x16{}; f32x16 ol=f32x16{}; float mref=0.f; bool seen=false;
  const f32x16 zero16=f32x16{};
  typedef __attribute__((address_space(3))) volatile float* lds_vfp;
  lds_vfp wmin=(lds_vfp)(__attribute__((address_space(3))) char*)(shm+LDS_FLG);
  float kr[16];
  #pragma unroll
  for(int r=0;r<16;++r)kr[r]=sl2*(float)((r&3)+8*(r>>2));
  int stage=0; int ndone=0; bool pmine=false;
  const bool grpB=wid>=4;
  u32x4 pw0=u32x4{},pw1=u32x4{},pw2=u32x4{},pw3=u32x4{};
  for(int i=0;i<nvis;++i){
    if(nvis-1-i>=RD-1){ if(TYPE==1) asm volatile("s_waitcnt vmcnt(12)":::"memory"); else asm volatile("s_waitcnt vmcnt(6)":::"memory"); }
    else asm volatile("s_waitcnt vmcnt(0)":::"memory");
    asm volatile("s_waitcnt lgkmcnt(0)\n\ts_barrier":::"memory");
    if(i>0 && (i&1)==0){
      float bmin=wmin[0];
      #pragma unroll
      for(int w_=1;w_<NW;++w_)bmin=__builtin_fminf(bmin,wmin[w_]);
      if(TYPE==1){ const int dist=q0-(TILE_OF(i)*KVBLK+KVBLK-1); if(dist>0 && qkmax2-sl2*(float)dist-bmin < -40.f) break; }
      else { if(TILE_OF(i)<NT-4 && qkmax2+(fk[q0]-fk[TILE_OF(i)*KVBLK+KVBLK-1])-bmin < -40.f) break; }
    }
    { const int in_=i+RD; if(in_<nvis){ const int sp_=(stage<2)?stage+RS-2:stage-2; ISSUE(in_,sp_); } }
    const int t=TILE_OF(i);
    const int slot=stage*SLOTB;
    const bool mine=(t*KVBLK<=q0+wid*QBLK+QBLK-1);
    if(grpB && i>0 && pmine){ const int sp_=((stage==0)?RS-1:stage-1)*SLOTB; pv(o,ol,vb0+sp_,__builtin_bit_cast(bf16x8,pw0),__builtin_bit_cast(bf16x8,pw1),__builtin_bit_cast(bf16x8,pw2),__builtin_bit_cast(bf16x8,pw3)); }
    if(mine){
    f32x16 p0,p1;
    {
      f32x16 c0,c1;
      if(TYPE==1){
        const float Bm=__builtin_fmaf(sl2,(float)(t*KVBLK+4*hi-tq),-mref), Bm1=__builtin_fmaf(sl2,32.f,Bm);
        #pragma unroll
        for(int r=0;r<16;++r){ asm("v_add_f32_e32 %0, %1, %2":"=v"(c0[r]):"v"(kr[r]),"v"(Bm)); asm("v_add_f32_e32 %0, %1, %2":"=v"(c1[r]):"v"(kr[r]),"v"(Bm1)); }
      } else {
        const float Bq=Fq-mref;
        #pragma unroll
        for(int j=0;j<4;++j){ const f32x4 a_=*(const f32x4*)(fk+t*KVBLK+8*j+4*hi), c_=*(const f32x4*)(fk+t*KVBLK+32+8*j+4*hi);
          #pragma unroll
          for(int i2=0;i2<4;++i2){c0[4*j+i2]=Bq-a_[i2];c1[4*j+i2]=Bq-c_[i2];} }
      }
      qkt(p0,p1,shm+LDS_K+slot,qr,c0,c1,r32,hi);
      if(TYPE==1){
        const unsigned lo=mring[stage*1024+wid*64+lane]>>(4*hi), hh=mring[stage*1024+512+wid*64+lane]>>(4*hi);
        #pragma unroll
        for(int r=0;r<16;++r){ const int c=(r&3)+8*(r>>2);
          const unsigned m0=(unsigned)__builtin_amdgcn_sbfe((int)lo,c,1), m1=(unsigned)__builtin_amdgcn_sbfe((int)hh,c,1);
          p0[r]=__uint_as_float((__float_as_uint(p0[r])&m0)|(0xff800000u&~m0)); p1[r]=__uint_as_float((__float_as_uint(p1[r])&m1)|(0xff800000u&~m1)); }
      } else { if(t>=NT-4)cmask(p0,p1,t-(NT-4),wid*QBLK+r32,hi); }
    }
    {
      const float rm=rowmax(p0,p1);
      const bool fin=rm>-INFINITY, adj=seen?(rm>8.f):fin;
      if(__any(adj)){
        const float dl=adj?rm:0.f, alpha=(adj&&seen)?__builtin_amdgcn_exp2f(-dl):1.f;
        mref+=dl;
        #pragma unroll
        for(int r=0;r<16;++r){p0[r]-=dl;p1[r]-=dl;}
        if(__any(alpha!=1.f)){
          if(hi==0)wsf[r32]=alpha;
          asm volatile("s_waitcnt lgkmcnt(0)":::"memory");
          #pragma unroll
          for(int r=0;r<16;++r){ const float al=wsf[crow(r,hi)]; o[0][r]*=al; o[1][r]*=al; ol[r]*=al; }
        }
      }
      seen=seen||fin;
      #pragma unroll
      for(int r=0;r<16;++r){p0[r]=__builtin_amdgcn_exp2f(p0[r]);p1[r]=__builtin_amdgcn_exp2f(p1[r]);}
      m_run=seen?mref:-INFINITY;
    }
    #define PKW(P,B) cvtpk_s(P[B],P[B+1])
    pw0=(u32x4){PKW(p0,0),PKW(p0,2),PKW(p0,4),PKW(p0,6)};pw1=(u32x4){PKW(p0,8),PKW(p0,10),PKW(p0,12),PKW(p0,14)};
    pw2=(u32x4){PKW(p1,0),PKW(p1,2),PKW(p1,4),PKW(p1,6)};pw3=(u32x4){PKW(p1,8),PKW(p1,10),PKW(p1,12),PKW(p1,14)};
    #undef PKW
    SBAR();
    if(!grpB) pv(o,ol,vb0+slot,__builtin_bit_cast(bf16x8,pw0),__builtin_bit_cast(bf16x8,pw1),__builtin_bit_cast(bf16x8,pw2),__builtin_bit_cast(bf16x8,pw3));
    }
    pmine=mine;
    if((i&1)==1){ float mn=m_run;
      #pragma unroll
      for(int o_=1;o_<32;o_<<=1)mn=__builtin_fminf(mn,__shfl_xor(mn,o_));
      if(lane==0)wmin[wid]=mn; }
    stage=(stage+1==RS)?0:stage+1; ++ndone;
  }
  if(grpB && ndone>0 && pmine){ const int sp_=((stage==0)?RS-1:stage-1)*SLOTB; pv(o,ol,vb0+sp_,__builtin_bit_cast(bf16x8,pw0),__builtin_bit_cast(bf16x8,pw1),__builtin_bit_cast(bf16x8,pw2),__builtin_bit_cast(bf16x8,pw3)); }
  asm volatile("s_waitcnt vmcnt(0) lgkmcnt(0)\n\ts_barrier":::"memory");
  #undef ISSUE
  #undef TILE_OF
  if(TYPE==1 && np>1){
    float*pp=part+(size_t)piece*(49*512)+tid;
    #pragma unroll
    for(int r=0;r<16;++r){pp[r*512]=o[0][r];pp[(16+r)*512]=o[1][r];pp[(32+r)*512]=ol[r];}
    pp[48*512]=seen?mref:-INFINITY;
    asm volatile("s_waitcnt vmcnt(0)":::"memory");
    __syncthreads();
    typedef __attribute__((address_space(3))) volatile unsigned* lds_vup;
    lds_vup pflag=(lds_vup)(__attribute__((address_space(3))) char*)(shm+LDS_FLG+64);
    if(tid==0){
      __builtin_amdgcn_fence(__ATOMIC_RELEASE,"agent"); asm volatile("s_waitcnt vmcnt(0)":::"memory");
      const unsigned old_=__hip_atomic_fetch_add(pctr,1u,__ATOMIC_RELAXED,__HIP_MEMORY_SCOPE_AGENT);
      if(old_==(unsigned)(np-1)){ __builtin_amdgcn_fence(__ATOMIC_ACQUIRE,"agent"); asm volatile("s_waitcnt vmcnt(0)":::"memory"); }
      *pflag=old_; }
    __syncthreads();
    const unsigned arrived=*pflag;
    if(arrived!=(unsigned)(np-1)){ asm volatile("s_waitcnt vmcnt(0) lgkmcnt(0)\n\ts_barrier":::"memory"); return; }
    float M=-INFINITY;
    #pragma unroll 1
    for(int k=0;k<np;++k) M=__builtin_fmaxf(M,part[(size_t)k*(49*512)+48*512+tid]);
    if(M==-INFINITY)M=0.f;
    #pragma unroll
    for(int r=0;r<16;++r){o[0][r]=0.f;o[1][r]=0.f;ol[r]=0.f;}
    #pragma unroll 1
    for(int k=0;k<np;++k){ const float*pk=part+(size_t)k*(49*512)+tid;
      const float mk=pk[48*512], sk=(mk==-INFINITY)?0.f:__builtin_amdgcn_exp2f(mk-M);
      #pragma unroll
      for(int r=0;r<16;++r){o[0][r]=__builtin_fmaf(sk,pk[r*512],o[0][r]);o[1][r]=__builtin_fmaf(sk,pk[(16+r)*512],o[1][r]);ol[r]=__builtin_fmaf(sk,pk[(32+r)*512],ol[r]);} }
  }
  float rli[16];
  #pragma unroll
  for(int r=0;r<16;++r)rli[r]=__builtin_amdgcn_rcpf(ol[r]);
  unsigned char*Ow=O+(rowbase+q0+wid*QBLK)*DM+h16*D;
  { unsigned char*stg=(unsigned char*)(shm+LDS_OST)+wid*2048;
    #pragma unroll
    for(int r=0;r<16;++r){const int orow=crow(r,hi);
      #pragma unroll
      for(int d0=0;d0<2;++d0){ const unsigned pk=(unsigned)__builtin_amdgcn_cvt_pk_fp8_f32(o[d0][r]*rli[r]*PROBE_ZF(TYPE),0.f,0,false); stg[orow*64+d0*32+r32]=(unsigned char)(pk&0xffu);} }
    asm volatile("s_waitcnt lgkmcnt(0)":::"memory");
    { const int row=lane>>1,hf=lane&1; const u32x4 v0=*(const u32x4*)(stg+row*64+hf*32), v1=*(const u32x4*)(stg+row*64+hf*32+16);
      *(u32x4*)(Ow+(long)row*DM+hf*32)=v0; *(u32x4*)(Ow+(long)row*DM+hf*32+16)=v1; } }
  asm volatile("s_waitcnt lgkmcnt(0)\n\ts_barrier":::"memory");
  #undef DMA_K
  #undef DMA_V
}
#undef SBAR
#undef WAIT_ALL_BAR
}
constexpr int NWAVES = 8;
constexpr int N_PHASES = 14;
constexpr int N_LAUNCHES = MK_N_LAUNCHES;
static_assert(N_LAUNCHES == 1 || N_LAUNCHES == N_PHASES, "MK_N_LAUNCHES is 1 or 14");
constexpr int BATCH = 2, SEQ = 8192, D_MODEL = 1024, D_FF = 2816, IN_WIDTH = 5712, TOPK = 256;
constexpr int M = BATCH * SEQ;
constexpr int NA_COLS = 15 * 256;
constexpr size_t MiB = 1u << 20;
constexpr size_t WS_CTL = 0, CTL_ZERO_BYTES = 1 * MiB;
constexpr size_t WS_MOD = 1 * MiB, WS_GAINS = 1 * MiB + 131072, WS_AORDER = 1 * MiB + 262144;
constexpr int CW_AQUEUE = 2048, CW_CQUEUE = 3072, CW_PCTR = 3200;
constexpr int CW_DUMMY_ = 0;
constexpr size_t WS_WGU = 2 * MiB, WS_WD = 13 * MiB, WS_WINA = 19 * MiB, WS_WINB = 27 * MiB, WS_WBR = 31 * MiB, WS_WOUT = 35 * MiB;
constexpr size_t WS_H = 38 * MiB;
constexpr size_t WS_BIG = 70 * MiB;
constexpr size_t WS_Q16 = 70 * MiB, WS_K16 = 102 * MiB, WS_V16 = 134 * MiB;
constexpr size_t WS_QI = 166 * MiB, WS_KI = 182 * MiB, WS_WI = 184 * MiB, WS_LF = 185 * MiB, WS_F2 = 186 * MiB, WS_MASK = 188 * MiB, WS_H8B = 204 * MiB, WS_O8 = 220 * MiB, WS_END = 236 * MiB;
static_assert(WS_WGU + (size_t)2 * D_FF * D_MODEL * 2 <= WS_WD && WS_WD + (size_t)D_FF * D_MODEL * 2 <= WS_WINA && WS_WINA + (size_t)NA_COLS * D_MODEL * 2 <= WS_WINB, "ws map");
static_assert(WS_BIG + (size_t)M * D_FF * 2 <= WS_QI && WS_MASK + (size_t)M * SEQ / 8 <= WS_H8B, "ws map");
constexpr int CW_BAR = 4096;
constexpr int RING_BYTES = 131072, LDSCTL_OFF = 147456, MISC_OFF = LDSCTL_OFF + 320, LDS_BYTES = 148480;
typedef unsigned u32x4g __attribute__((ext_vector_type(4)));
typedef float f32x2g __attribute__((ext_vector_type(2)));
#define GAS __attribute__((address_space(1)))
#define LAS __attribute__((address_space(3)))
typedef unsigned short bf16;
typedef unsigned v4u __attribute__((ext_vector_type(4)));
typedef float f32x4 __attribute__((ext_vector_type(4)));
typedef short bf16x8 __attribute__((ext_vector_type(8)));
typedef GAS unsigned gu32;
typedef GAS unsigned long long gu64;
#define RLX_AGENT __ATOMIC_RELAXED, __HIP_MEMORY_SCOPE_AGENT
#define LDS_WAIT() asm volatile("s_waitcnt lgkmcnt(0)" ::: "memory")
#define VM_WAIT() asm volatile("s_waitcnt vmcnt(0)" ::: "memory")
__device__ __forceinline__ unsigned long long rt() { return __builtin_amdgcn_s_memrealtime(); }
__device__ __forceinline__ unsigned f2bf(float f) { unsigned u = __builtin_bit_cast(unsigned, f); return (u + 0x7fffu + ((u >> 16) & 1u)) >> 16; }
__device__ __forceinline__ unsigned pk2(float lo, float hi) { return f2bf(lo) | (f2bf(hi) << 16); }

#define XB_TMO      128
#define XB_XCNT(j)  (256  + 64 * (j))
#define XB_XSUB(j)  (1280 + 64 * (j))
#define XB_XGEN(j)  (2304 + 64 * (j))
#define XB_TOP      3328
#define XB_TOPGEN   3392
#define XCD_BAR_WORDS 3456
#define XB_SPIN_CAP (1u << 18)

__device__ __forceinline__ unsigned xb_ld(unsigned* p)              { return __hip_atomic_load(p, __ATOMIC_RELAXED, __HIP_MEMORY_SCOPE_AGENT); }
__device__ __forceinline__ unsigned xb_add(unsigned* p, unsigned v) { return __hip_atomic_fetch_add(p, v, __ATOMIC_RELAXED, __HIP_MEMORY_SCOPE_AGENT); }
__device__ __forceinline__ unsigned xb_xcc_id() { return (unsigned)__builtin_amdgcn_s_getreg((3 << 11) | 20) & 0xFu; }
#define XB_SPIN(cond, bar) do { unsigned _sp = 0; while (cond) { __builtin_amdgcn_s_sleep(1); \
    if ((++_sp & 255u) == 0u) { if (xb_ld(&(bar)[XB_TMO])) break; if (_sp > XB_SPIN_CAP) { atomicAdd(&(bar)[XB_TMO], 1u); break; } } } } while (0)

struct XcdBarrier {
    int wave;
    unsigned* bar; unsigned x;
    volatile LAS unsigned* st;
};

__device__ __forceinline__ XcdBarrier xcd_barrier_post(unsigned* bar, volatile LAS unsigned* st, int wave) {
    XcdBarrier b; b.wave = wave; b.bar = bar; b.x = xb_xcc_id(); b.st = st;
    if (wave == 0 && mk_lane() == 0) (void)xb_add(&bar[XB_XCNT(b.x)], 1u);
    return b;
}
__device__ __forceinline__ void xcd_barrier_complete(unsigned* bar, unsigned x, unsigned& nloc, unsigned& nx) {
    const unsigned G = gridDim.x * gridDim.y * gridDim.z;
    unsigned sum, cnt, mine, sp = 0u;
    for (;;) {
        sum = 0u; cnt = 0u; mine = 0u;
#pragma unroll
        for (unsigned j = 0; j < 16; ++j) { const unsigned c = xb_ld(&bar[XB_XCNT(j)]); sum += c; cnt += (c > 0u) ? 1u : 0u; mine = (j == x) ? c : mine; }
        if (sum == G) break;
        __builtin_amdgcn_s_sleep(1);
        if ((++sp & 255u) == 0u) { if (xb_ld(&bar[XB_TMO])) break; if (sp > XB_SPIN_CAP) { atomicAdd(&bar[XB_TMO], 1u); break; } }
    }
    nloc = mine > 0u ? mine : 1u; nx = cnt > 0u ? cnt : 1u;
}

__device__ __forceinline__ void xcd_barrier(const XcdBarrier& b) {
    asm volatile("s_waitcnt vmcnt(0)" ::: "memory");
    __syncthreads();
    if (b.wave == 0 && mk_lane() == 0) {
        unsigned* bar = b.bar;
        __builtin_amdgcn_s_waitcnt(0);
        unsigned nloc = b.st[0], nx = b.st[1];
        if (nloc == 0u) { xcd_barrier_complete(bar, b.x, nloc, nx); b.st[0] = nloc; b.st[1] = nx; }
        const unsigned old = xb_add(&bar[XB_XSUB(b.x)], 1u);
        const unsigned gen = old / nloc;
        if (old + 1u == (gen + 1u) * nloc) {
            __builtin_amdgcn_fence(__ATOMIC_RELEASE, "agent");
            asm volatile("s_waitcnt vmcnt(0)" ::: "memory");
            const unsigned og = xb_add(&bar[XB_TOP], 1u);
            const unsigned tg = og / nx;
            if (og + 1u == (tg + 1u) * nx) xb_add(&bar[XB_TOPGEN], 1u);
            else XB_SPIN(xb_ld(&bar[XB_TOPGEN]) == tg, bar);
            __builtin_amdgcn_fence(__ATOMIC_ACQUIRE, "agent");
            xb_add(&bar[XB_XGEN(b.x)], 1u);
            asm volatile("s_waitcnt vmcnt(0)" ::: "memory");
        } else {
            XB_SPIN(xb_ld(&bar[XB_XGEN(b.x)]) == gen, bar);
            __builtin_amdgcn_fence(__ATOMIC_ACQUIRE, "agent");
            asm volatile("s_waitcnt vmcnt(0)" ::: "memory");
        }
    }
    __syncthreads();
}
struct Frame {
    LAS unsigned char* lds;
    volatile LAS unsigned* MISC;
    gu32* ctl;
    int tid, lane, wave;
    int vcu, G;
    float* out;
    unsigned char* ws;
};
__device__ __forceinline__ float wave_sum(float v) {
#pragma unroll
    for (int o = 1; o < 64; o <<= 1) v += __shfl_xor(v, o);
    return v;
}

enum { J_GU = 0, J_D = 1, J_INA = 2, J_INB = 3, J_BR = 4, J_OUT = 5 };
struct SrcDesc { const float* W; int N; int n0; int k0; };
__device__ __forceinline__ SrcDesc wsrc(int job, int g, int kb, const float* w0, const float* w1) {
    SrcDesc s; s.W = w0; s.k0 = 64 * kb; const int v0 = 32 * g, pn = v0 >> 8, j = v0 & 255;
    switch (job) {
    case J_GU:  s.W = (j < 128) ? w0 : w1; s.N = D_FF; s.n0 = 128 * pn + (j & 127); break;
    case J_D:   s.N = D_MODEL; s.n0 = v0; break;
    case J_INA: { s.N = IN_WIDTH; const int sec = pn >> 1;
        if (sec == 0 || sec == 1 || sec == 3 || sec == 4) s.n0 = 512 * sec + ((pn & 1) * 4 + ((j & 127) >> 5)) * 64 + 32 * (j >> 7);
        else if (sec == 2 || sec == 5 || sec == 6) s.n0 = 512 * sec + 256 * (pn & 1) + j;
        else { if (j < 96) s.n0 = 3584 + j; else s.W = nullptr; } } break;
    case J_INB: s.N = IN_WIDTH; s.n0 = 3664 + v0; break;
    case J_BR:  { s.N = D_MODEL; s.n0 = 128 * pn + (j & 127);
        if (j < 128) { if (kb >= 8) s.W = nullptr; } else { if (kb < 8) s.W = nullptr; else { s.W = w1; s.k0 = 64 * kb - 512; } } } break;
    default:    s.N = D_MODEL; s.n0 = v0; break;
    }
    return s;
}
__device__ __forceinline__ void transpose_item(const SrcDesc s, bf16* WT, int Kd, int g, int kb, LAS float* scr, int lane) {
    const int c = lane & 7;
    if (s.W == nullptr) {
#pragma unroll
        for (int jj = 0; jj < 4; ++jj) { const int n = (lane >> 3) + 8 * jj; *(GAS v4u*)(WT + (size_t)(32 * g + n) * Kd + 64 * kb + 8 * c) = (v4u){0u, 0u, 0u, 0u}; }
        return;
    }
#pragma unroll 8
    for (int i = 0; i < 32; ++i) { const int kk = 2 * i + (lane >> 5); scr[kk * 33 + (lane & 31)] = s.W[(size_t)(s.k0 + kk) * s.N + s.n0 + (lane & 31)]; }
    LDS_WAIT(); asm volatile("" ::: "memory");
#pragma unroll
    for (int jj = 0; jj < 4; ++jj) { const int n = (lane >> 3) + 8 * jj; const LAS float* p = scr + (8 * c) * 33 + n;
        v4u o; o.x = pk2(p[0 * 33], p[1 * 33]); o.y = pk2(p[2 * 33], p[3 * 33]); o.z = pk2(p[4 * 33], p[5 * 33]); o.w = pk2(p[6 * 33], p[7 * 33]);
        *(GAS v4u*)(WT + (size_t)(32 * g + n) * Kd + 64 * kb + 8 * c) = o; }
    LDS_WAIT(); asm volatile("" ::: "memory");
}
__device__ __forceinline__ int transpose_job(Frame& F, int job, const float* w0, const float* w1, bf16* WT, int rows, int Kd, int base) {
    LAS float* scr = (LAS float*)(F.lds + F.wave * 16384);
    const int nkb = Kd / 64, nitem = (rows / 32) * nkb, gw = F.vcu * NWAVES + F.wave, NGW = F.G * NWAVES;
    int first = (gw - base % NGW + NGW) % NGW;
    for (int it = first; it < nitem; it += NGW) { const int g = it / nkb, kb = it % nkb; transpose_item(wsrc(job, g, kb, w0, w1), WT, Kd, g, kb, scr, F.lane); }
    return base + nitem;
}
template <bool F8> __device__ __forceinline__ void transpose_item64(const SrcDesc sA, const SrcDesc sB, void* WTv, int Kd, int g2, int kb, LAS float* scr, int lane, float wsc) {
    const int nq = (lane & 15) * 4, kr = lane >> 4;
    const SrcDesc s = (nq < 32) ? sA : sB;
    f32x4 v[16];
    if (s.W != nullptr) {
        const float* p = s.W + (size_t)(s.k0 + kr) * s.N + s.n0 + (nq & 31);
#pragma unroll
        for (int i = 0; i < 16; ++i) v[i] = *(const f32x4*)(p + (size_t)(4 * i) * s.N);
    } else {
#pragma unroll
        for (int i = 0; i < 16; ++i) v[i] = (f32x4){0.f, 0.f, 0.f, 0.f};
    }
#pragma unroll
    for (int i = 0; i < 16; ++i) { const int k = 4 * i + kr; scr[(nq + 0) * 65 + k] = v[i].x; scr[(nq + 1) * 65 + k] = v[i].y; scr[(nq + 2) * 65 + k] = v[i].z; scr[(nq + 3) * 65 + k] = v[i].w; }
    LDS_WAIT(); asm volatile("" ::: "memory");
    if constexpr (F8) {
        unsigned char* WT = (unsigned char*)WTv;
#pragma unroll
        for (int j = 0; j < 4; ++j) { const int n = (lane >> 2) + 16 * j, c = lane & 3; const LAS float* q = scr + n * 65 + 16 * c;
            v4u o; o.x = pg8::pk4_fp8(q[0] * wsc, q[1] * wsc, q[2] * wsc, q[3] * wsc); o.y = pg8::pk4_fp8(q[4] * wsc, q[5] * wsc, q[6] * wsc, q[7] * wsc);
            o.z = pg8::pk4_fp8(q[8] * wsc, q[9] * wsc, q[10] * wsc, q[11] * wsc); o.w = pg8::pk4_fp8(q[12] * wsc, q[13] * wsc, q[14] * wsc, q[15] * wsc);
            *(GAS v4u*)(WT + (size_t)(64 * g2 + n) * Kd + 64 * kb + 16 * c) = o; }
    } else {
        bf16* WT = (bf16*)WTv;
#pragma unroll
        for (int j = 0; j < 8; ++j) { const int n = (lane >> 3) + 8 * j, c = lane & 7; const LAS float* q = scr + n * 65 + 8 * c;
            v4u o; o.x = pk2(q[0], q[1]); o.y = pk2(q[2], q[3]); o.z = pk2(q[4], q[5]); o.w = pk2(q[6], q[7]);
            *(GAS v4u*)(WT + (size_t)(64 * g2 + n) * Kd + 64 * kb + 8 * c) = o; }
    }
    LDS_WAIT(); asm volatile("" ::: "memory");
}
template <bool F8> __device__ __forceinline__ int transpose_job64(Frame& F, int job, const float* w0, const float* w1, void* WT, int rows, int Kd, int base, float wsc, const int g2off = 0) {
    LAS float* scr = (LAS float*)(F.lds + F.wave * 16896);
    const int nkb = Kd / 64, nitem = (rows / 64) * nkb, gw = F.vcu * NWAVES + F.wave, NGW = F.G * NWAVES;
    int first = (gw - base % NGW + NGW) % NGW;
    for (int it = first; it < nitem; it += NGW) { const int g2 = it / nkb, kb = it % nkb;
        transpose_item64<F8>(wsrc(job, 2 * (g2 + g2off), kb, w0, w1), wsrc(job, 2 * (g2 + g2off) + 1, kb, w0, w1), WT, Kd, g2, kb, scr, F.lane, wsc); }
    return base + nitem;
}

__device__ __forceinline__ void ffn_copies_queue(Frame& F, gu32* counter, const float* wg, const float* wu, const float* wd, void* Wgu_, void* Wd_) {
    LAS float* scr = (LAS float*)(F.lds + F.wave * 16896);
    constexpr int N_GU = (2 * D_FF / 64) * (D_MODEL / 64), N_D = (D_MODEL / 64) * (D_FF / 64);
    for (;;) {
        int it0 = 0; if (F.lane == 0) it0 = (int)__hip_atomic_fetch_add((unsigned*)counter, 4u, __ATOMIC_RELAXED, __HIP_MEMORY_SCOPE_AGENT);
        it0 = __builtin_amdgcn_readfirstlane(it0);
        if (it0 >= N_GU + N_D) break;
      for (int it = it0; it < it0 + 4 && it < N_GU + N_D; ++it) {
        if (it < N_GU) { const int nkb = D_MODEL / 64, g2 = it / nkb, kb = it % nkb;
            transpose_item64<true>(wsrc(J_GU, 2 * g2, kb, wg, wu), wsrc(J_GU, 2 * g2 + 1, kb, wg, wu), Wgu_, D_MODEL, g2, kb, scr, F.lane, 32.f); }
        else { const int i2 = it - N_GU, nkb = D_FF / 64, g2 = i2 / nkb, kb = i2 % nkb;
            transpose_item64<true>(wsrc(J_D, 2 * g2, kb, wd, nullptr), wsrc(J_D, 2 * g2 + 1, kb, wd, nullptr), Wd_, D_FF, g2, kb, scr, F.lane, 64.f); }
      }
    }
}

__device__ __forceinline__ void dsa_plan(int h, int qb, int& np, int& per) {
    const float sl2 = exp2f(-(float)(h + 1)) * 1.4426950408889634f; const int cap = 5 + (int)((180.f + 68.f / sl2) * (1.f / 64.f));
    const int full = 4 * (qb + 1), L = full < cap ? full : cap;
    np = L > 64 ? 2 : 1; per = (L + np - 1) / np;
}
constexpr int AQ_CAP = 1024;
__device__ __forceinline__ void build_attn_queues(Frame& F, const float* b_forget, const float* qn_fox, const float* kn_fox) {
    LAS float* Lh = (LAS float*)(F.lds);
    LAS float* cs = (LAS float*)(F.lds + 64);
    LAS float* tot = (LAS float*)(F.lds + 64 + 2048);
    LAS int* hist = (LAS int*)(F.lds + 4096);
    LAS int* cnt = (LAS int*)(F.lds + 4096 + 8 * 132 * 4);
    unsigned* ord = (unsigned*)(F.ws + WS_AORDER);
    const int t = F.tid;
    for (int i = t; i < 8 * 132 + 8; i += NWAVES * 64) hist[i] = 0;
    if (F.wave == 0) { float mq = fabsf(qn_fox[F.lane]), mk = fabsf(kn_fox[F.lane]);
#pragma unroll
        for (int o = 1; o < 64; o <<= 1) { mq = fmaxf(mq, __shfl_xor(mq, o)); mk = fmaxf(mk, __shfl_xor(mk, o)); }
        const float qk2 = 64.f * 0.125f * 1.4426950408889634f * mq * mk;
        if (F.lane < 8) { float l = (40.f + 2.f * qk2) / (1.4426950408889634f * 1.65f * __expf(-b_forget[F.lane]) * 64.f); Lh[F.lane] = l < 1.f ? 1.f : (l > 128.f ? 128.f : l); } }
    __syncthreads();
    int len[3]; unsigned id[3]; float cost[3]; float mine = 0.f;
#pragma unroll
    for (int i = 0; i < 3; ++i) { const int s = 3 * t + i, b = s >= 768 ? 1 : 0, e = s - 768 * b; len[i] = 0; id[i] = 0u; cost[i] = 0.f;
        if (e < 512) { const int h = 7 - (e >> 6), qb = 31 - ((e >> 1) & 31), pc = e & 1; int np, per; dsa_plan(h, qb, np, per);
            if (pc < np) { const float sl2 = exp2f(-(float)(h + 1)) * 1.4426950408889634f; const int cap = 5 + (int)((180.f + 68.f / sl2) * (1.f / 64.f)); const int full = 4 * (qb + 1), L = full < cap ? full : cap;
                len[i] = np == 1 ? L : (pc == 0 ? per : L - per); cost[i] = (float)len[i] + 4.f; id[i] = 512u | (unsigned)(b << 8 | h << 5 | qb | pc << 10 | np << 12); } }
        else { const int h = (e - 512) >> 5, qb = 31 - (e & 31); const int full = 4 * (qb + 1), L0 = 4 + (int)Lh[h], L = full < L0 ? full : L0;
            len[i] = L; cost[i] = 0.8f * (float)L + 4.f; id[i] = (unsigned)(b << 8 | h << 5 | qb | 1 << 12); }
        mine += cost[i]; }
    float inc = mine;
#pragma unroll
    for (int o = 1; o < 64; o <<= 1) { const float v = __shfl_up(inc, o); if (F.lane >= o) inc += v; }
    if (F.lane == 63) cs[F.wave] = inc;
    __syncthreads();
    float wbase = 0.f, tot0 = 0.f, tot1 = 0.f;
#pragma unroll
    for (int w = 0; w < 8; ++w) { const float v = cs[w]; if (w < F.wave) wbase += v; if (w < 4) tot0 += v; else tot1 += v; }
    float run = wbase + inc - mine; int bin[3];
#pragma unroll
    for (int i = 0; i < 3; ++i) { const int s = 3 * t + i, b = s >= 768 ? 1 : 0; const float start = run - (b ? tot0 : 0.f); run += cost[i];
        int q = (int)(start * 4.f / (b ? tot1 : tot0)); q = q < 0 ? 0 : (q > 3 ? 3 : q); bin[i] = 4 * b + q;
        if (len[i] > 0) __hip_atomic_fetch_add(hist + bin[i] * 132 + len[i], 1, __ATOMIC_RELAXED, __HIP_MEMORY_SCOPE_WORKGROUP); }
    __syncthreads();
    {
        const int w = F.wave, l0 = 128 - 2 * F.lane, l1 = l0 - 1; const int c0 = hist[w * 132 + l0], c1 = hist[w * 132 + l1]; int incl = c0 + c1;
#pragma unroll
        for (int o = 1; o < 64; o <<= 1) { const int v = __shfl_up(incl, o); if (F.lane >= o) incl += v; }
        const int excl = incl - c0 - c1; hist[w * 132 + l0] = excl; hist[w * 132 + l1] = excl + c0;
        if (F.lane == 63) ord[8 * AQ_CAP + w] = (unsigned)(incl < AQ_CAP ? incl : AQ_CAP); }
    __syncthreads();
#pragma unroll
    for (int i = 0; i < 3; ++i) if (len[i] > 0) { const int pos = __hip_atomic_fetch_add(hist + bin[i] * 132 + len[i], 1, __ATOMIC_RELAXED, __HIP_MEMORY_SCOPE_WORKGROUP); if (pos < AQ_CAP) ord[bin[i] * AQ_CAP + pos] = id[i]; }
    __syncthreads();
}

__device__ __forceinline__ void mod_gemv(Frame& F, int item, const float* cin, const float* W, const float* bias) {
    float* mod = (float*)(F.ws + WS_MOD);
    LAS float* sc = (LAS float*)(F.lds);
    LAS float* red = (LAS float*)(F.lds + 8192);
    for (int i = F.tid; i < 2048; i += NWAVES * 64) { const float v = cin[i]; sc[i] = v / (1.f + __expf(-v)); }
    __syncthreads();
    const int col = 128 * item + 2 * F.lane, kbeg = 128 * F.wave;
    float a00 = 0.f, a01 = 0.f, a10 = 0.f, a11 = 0.f;
#pragma unroll 16
    for (int k = 0; k < 128; ++k) { const f32x2g w = *(const f32x2g*)(W + (size_t)(kbeg + k) * 9216 + col); const float s0 = sc[kbeg + k], s1 = sc[1024 + kbeg + k];
        a00 += s0 * w.x; a01 += s0 * w.y; a10 += s1 * w.x; a11 += s1 * w.y; }
    red[F.wave * 256 + 2 * F.lane] = a00; red[F.wave * 256 + 2 * F.lane + 1] = a01; red[F.wave * 256 + 128 + 2 * F.lane] = a10; red[F.wave * 256 + 128 + 2 * F.lane + 1] = a11;
    __syncthreads();
    if (F.tid < 256) { const int bb = F.tid >> 7, cc = F.tid & 127; float s = 0.f;
#pragma unroll
        for (int w = 0; w < 8; ++w) s += red[w * 256 + bb * 128 + cc];
        mod[bb * 9216 + 128 * item + cc] = s + bias[128 * item + cc]; }
    __syncthreads();
}
template <bool IN16 = false> __device__ __forceinline__ void norm_phase(Frame& F, const void* xin, const float* g, int nmod, bf16* H, unsigned char* H8 = nullptr) {
    const float* mod = (const float*)(F.ws + WS_MOD);
    const int gw = F.vcu * NWAVES + F.wave, NGW = F.G * NWAVES;
    for (int m = gw; m < M; m += NGW) {
        const int b = m >> 13;
        f32x4 v[4]; float s = 0.f;
        if constexpr (IN16) { const GAS unsigned long long* xr = (const GAS unsigned long long*)((const bf16*)xin + (size_t)m * D_MODEL) + F.lane;
#pragma unroll
            for (int j = 0; j < 4; ++j) { const unsigned long long r2 = xr[64 * j]; const unsigned r0 = (unsigned)r2, r1 = (unsigned)(r2 >> 32);
                v[j].x = __builtin_bit_cast(float, r0 << 16); v[j].y = __builtin_bit_cast(float, r0 & 0xffff0000u); v[j].z = __builtin_bit_cast(float, r1 << 16); v[j].w = __builtin_bit_cast(float, r1 & 0xffff0000u); } }
        else { const GAS f32x4* xr = (const GAS f32x4*)((const float*)xin + (size_t)m * D_MODEL) + F.lane;
#pragma unroll
            for (int j = 0; j < 4; ++j) v[j] = xr[64 * j]; }
#pragma unroll
        for (int j = 0; j < 4; ++j) s += (v[j].x * v[j].x + v[j].y * v[j].y) + (v[j].z * v[j].z + v[j].w * v[j].w);
        const float rstd = 1.f / sqrtf(wave_sum(s) * (1.f / D_MODEL) + 1e-6f);
        GAS unsigned long long* o8 = (GAS unsigned long long*)(H + (size_t)m * D_MODEL) + F.lane;
#pragma unroll
        for (int j = 0; j < 4; ++j) { const int c = 4 * F.lane + 256 * j;
            const f32x4 gg = *(const f32x4*)(g + c), shv = *(const f32x4*)(mod + b * 9216 + nmod * 1024 + c), scv = *(const f32x4*)(mod + b * 9216 + (nmod + 1) * 1024 + c);
            const f32x4 y = v[j] * rstd * gg * (scv + 1.f) + shv;
            o8[64 * j] = (unsigned long long)pk2(y.x, y.y) | ((unsigned long long)pk2(y.z, y.w) << 32);
            if (H8) ((GAS unsigned*)(H8 + (size_t)m * D_MODEL) + F.lane)[64 * j] = pg8::pk4_fp8(y.x, y.y, y.z, y.w); }
    }
}

__device__ __forceinline__ void transpose_item8(const SrcDesc s, unsigned char* WT, int Kd, int g, int kb, LAS float* scr, int lane, float wsc) {
#pragma unroll 8
    for (int i = 0; i < 32; ++i) { const int kk = 2 * i + (lane >> 5); scr[kk * 33 + (lane & 31)] = s.W[(size_t)(s.k0 + kk) * s.N + s.n0 + (lane & 31)]; }
    LDS_WAIT(); asm volatile("" ::: "memory");
    const int n = lane >> 1, h = lane & 1; const LAS float* p = scr + (32 * h) * 33 + n;
    v4u o0, o1;
#define T8W(i_) pg8::pk4_fp8(p[(4 * (i_) + 0) * 33] * wsc, p[(4 * (i_) + 1) * 33] * wsc, p[(4 * (i_) + 2) * 33] * wsc, p[(4 * (i_) + 3) * 33] * wsc)
    o0.x = T8W(0); o0.y = T8W(1); o0.z = T8W(2); o0.w = T8W(3); o1.x = T8W(4); o1.y = T8W(5); o1.z = T8W(6); o1.w = T8W(7);
#undef T8W
    unsigned char* d = WT + (size_t)(32 * g + n) * Kd + 64 * kb + 32 * h;
    *(GAS v4u*)d = o0; *(GAS v4u*)(d + 16) = o1;
    LDS_WAIT(); asm volatile("" ::: "memory");
}
__device__ __forceinline__ int transpose_job8(Frame& F, int job, const float* w0, const float* w1, unsigned char* WT, int rows, int Kd, int base, float wsc) {
    LAS float* scr = (LAS float*)(F.lds + F.wave * 16384);
    const int nkb = Kd / 64, nitem = (rows / 32) * nkb, gw = F.vcu * NWAVES + F.wave, NGW = F.G * NWAVES;
    int first = (gw - base % NGW + NGW) % NGW;
    for (int it = first; it < nitem; it += NGW) { const int g = it / nkb, kb = it % nkb; transpose_item8(wsrc(job, g, kb, w0, w1), WT, Kd, g, kb, scr, F.lane, wsc); }
    return base + nitem;
}
template <bool IN16 = false> __device__ __forceinline__ void norm_phase8(Frame& F, const void* xin, const float* g, int nmod, unsigned char* H8) {
    const float* mod = (const float*)(F.ws + WS_MOD);
    const int gw = F.vcu * NWAVES + F.wave, NGW = F.G * NWAVES;
    for (int m = gw; m < M; m += NGW) {
        const int b = m >> 13;
        f32x4 v[4]; float s = 0.f;
        if constexpr (IN16) { const GAS unsigned long long* xr = (const GAS unsigned long long*)((const bf16*)xin + (size_t)m * D_MODEL) + F.lane;
#pragma unroll
            for (int j = 0; j < 4; ++j) { const unsigned long long r2 = xr[64 * j]; const unsigned r0 = (unsigned)r2, r1 = (unsigned)(r2 >> 32);
                v[j].x = __builtin_bit_cast(float, r0 << 16); v[j].y = __builtin_bit_cast(float, r0 & 0xffff0000u); v[j].z = __builtin_bit_cast(float, r1 << 16); v[j].w = __builtin_bit_cast(float, r1 & 0xffff0000u); } }
        else { const GAS f32x4* xr = (const GAS f32x4*)((const float*)xin + (size_t)m * D_MODEL) + F.lane;
#pragma unroll
            for (int j = 0; j < 4; ++j) v[j] = xr[64 * j]; }
#pragma unroll
        for (int j = 0; j < 4; ++j) s += (v[j].x * v[j].x + v[j].y * v[j].y) + (v[j].z * v[j].z + v[j].w * v[j].w);
        const float rstd = 1.f / sqrtf(wave_sum(s) * (1.f / D_MODEL) + 1e-6f);
        GAS unsigned* o4 = (GAS unsigned*)(H8 + (size_t)m * D_MODEL) + F.lane;
#pragma unroll
        for (int j = 0; j < 4; ++j) { const int c = 4 * F.lane + 256 * j;
            const f32x4 gg = *(const f32x4*)(g + c), shv = *(const f32x4*)(mod + b * 9216 + nmod * 1024 + c), scv = *(const f32x4*)(mod + b * 9216 + (nmod + 1) * 1024 + c);
            const f32x4 y = v[j] * rstd * gg * (scv + 1.f) + shv;
            o4[64 * j] = pg8::pk4_fp8(y.x, y.y, y.z, y.w); }
    }
}

__device__ __forceinline__ unsigned sortable_key(float s) { unsigned u = __builtin_bit_cast(unsigned, s); if (u == 0x80000000u) u = 0u; return (u & 0x80000000u) ? ~u : (u | 0x80000000u); }
__device__ __forceinline__ void fscan_row(const float* lf, float* f2, int lane) {
    float carry = 0.f;
    for (int it = 0; it < SEQ / 256; ++it) {
        const f32x4 v = *(const f32x4*)(lf + it * 256 + lane * 4);
        const float p0 = v.x, p1 = p0 + v.y, p2 = p1 + v.z, p3 = p2 + v.w;
        float s = p3;
#pragma unroll
        for (int o = 1; o < 64; o <<= 1) { const float t = __shfl_up(s, o); if (lane >= o) s += t; }
        const float ex = s - p3 + carry;
        f32x4 r; r.x = (ex + p0) * 1.4426950408889634f; r.y = (ex + p1) * 1.4426950408889634f; r.z = (ex + p2) * 1.4426950408889634f; r.w = (ex + p3) * 1.4426950408889634f;
        *(f32x4*)(f2 + it * 256 + lane * 4) = r;
        carry += __shfl(s, 63);
    }
}
__device__ __forceinline__ void idx_unit(Frame& F, int b, int t4, const bf16* QI, const bf16* KI, const float* WI, unsigned long long* MASK, int rot, const int mode = 3) {
    typedef short bf16x8v __attribute__((ext_vector_type(8))); typedef float f32x16v __attribute__((ext_vector_type(16)));
    LAS unsigned* sc = (LAS unsigned*)(F.lds);
    LAS unsigned* hist = (LAS unsigned*)(F.lds + 131072);
    int lane = mk_lane(); asm volatile("" : "+v"(lane));
    const int r32 = lane & 31, hi = lane >> 5, wid = F.wave;
    const int t0 = 4 * t4, ntile = (t0 + 4 + 31) >> 5, n = ntile * 32;
    const size_t rb = (size_t)b * SEQ;
    bf16x8v qa[4];
    { const bf16* qp = QI + (rb + t0 + (r32 >> 3)) * 512 + (r32 & 7) * 64 + hi * 8;
#pragma unroll
      for (int ks = 0; ks < 4; ++ks) qa[ks] = *(const bf16x8v*)(qp + ks * 16); }
    float wv[16];
#pragma unroll
    for (int r = 0; r < 16; ++r) wv[r] = WI[(rb + t0 + (r >> 2)) * 8 + (r & 3) + 4 * hi];
    for (int i = F.tid; i < 4096; i += NWAVES * 64) hist[i] = 0u;
#define IDX_LOADK(dst, tile_) do { const bf16* kp_ = KI + ((rb >> 5) + (tile_)) * 2048 + (hi * 32 + r32) * 8; _Pragma("unroll") for (int ks = 0; ks < 4; ++ks) dst[ks] = *(const bf16x8v*)(kp_ + ks * 512); } while (0)
#define IDX_SCORE(kf, tile_) do { const int key = (tile_) * 32 + r32; f32x16v acc = {}; \
        _Pragma("unroll") for (int ks = 0; ks < 4; ++ks) acc = __builtin_amdgcn_mfma_f32_32x32x16_bf16(qa[ks], kf[ks], acc, 0, 0, 0); \
        unsigned u[4]; \
        _Pragma("unroll") for (int q_ = 0; q_ < 4; ++q_) { \
            float s = wv[4 * q_] * fmaxf(acc[4 * q_], 0.f); \
            s += wv[4 * q_ + 1] * fmaxf(acc[4 * q_ + 1], 0.f); s += wv[4 * q_ + 2] * fmaxf(acc[4 * q_ + 2], 0.f); s += wv[4 * q_ + 3] * fmaxf(acc[4 * q_ + 3], 0.f); \
            s = att::xhalf_sum(s); \
            u[q_] = (key <= t0 + q_) ? sortable_key(s) : 0u; } \
        if (hi == 0) { sc[key] = u[0]; sc[8192 + key] = u[1]; } else { sc[16384 + key] = u[2]; sc[24576 + key] = u[3]; } } while (0)
    {
        const int np = (ntile + 1) >> 1;
        const int cnt = ((mode & 1) && wid < np) ? ((np - wid + NWAVES - 1) / NWAVES) : 0;
        bf16x8v ka[4], kc[4], na[4], nc[4];
        int p = (wid + rot) % np;
        if (cnt > 0) { IDX_LOADK(ka, 2 * p); const int t1 = (2 * p + 1 < ntile) ? 2 * p + 1 : ntile - 1; IDX_LOADK(kc, t1); }
        for (int i = 0; i < cnt; ++i) {
            int pn = p;
            if (i + 1 < cnt) { pn = p + NWAVES; if (pn >= np) pn = pn % np; }
            { IDX_LOADK(na, 2 * pn); const int t1 = (2 * pn + 1 < ntile) ? 2 * pn + 1 : ntile - 1; IDX_LOADK(nc, t1); }
            IDX_SCORE(ka, 2 * p);
            if (2 * p + 1 < ntile) IDX_SCORE(kc, 2 * p + 1);
#pragma unroll
            for (int ks = 0; ks < 4; ++ks) { ka[ks] = na[ks]; kc[ks] = nc[ks]; }
            p = pn;
        }
    }
#undef IDX_LOADK
#undef IDX_SCORE
    __syncthreads();
    if (!(mode & 2)) { __syncthreads(); return; }
    const int q = wid >> 1, part = wid & 1;
    LAS unsigned* scq = sc + q * 8192;
    const int kk = (t0 + q + 1 < TOPK) ? (t0 + q + 1) : TOPK;
    const int nw = (n + 63) >> 6, nj = (nw - part + 1) >> 1;
    unsigned key[64];
#pragma unroll
    for (int g = 0; g < 8; ++g) {
        if (8 * g < nj) {
#pragma unroll
            for (int jj = 0; jj < 8; ++jj) { const int e = (2 * (8 * g + jj) + part) * 64 + lane; key[8 * g + jj] = (e < n) ? scq[e] : 0u; }
        } else {
#pragma unroll
            for (int jj = 0; jj < 8; ++jj) key[8 * g + jj] = 0u;
        }
    }
    const int sub = lane & 3;
    unsigned prefix = 0u, himask = 0u; int need = kk, n_eq = 0; bool done = false;
#pragma unroll 1
    for (int lvl = 0; lvl < 4; ++lvl) {
        const int shift = 24 - 8 * lvl;
        LAS unsigned* Hq = hist + (lvl & 1) * 2048 + q * 512;
        if (!done) {
#pragma unroll
            for (int g = 0; g < 8; ++g) {
                if (8 * g < nj) {
#pragma unroll
                    for (int jj = 0; jj < 8; ++jj) { const unsigned uu = key[8 * g + jj];
                        if (uu != 0u && (uu & himask) == prefix) { const unsigned d = (uu >> shift) & 255u;
                            __hip_atomic_fetch_add(Hq + ((d >> 1) << 2) + sub, (d & 1u) ? 65536u : 1u, __ATOMIC_RELAXED, __HIP_MEMORY_SCOPE_WORKGROUP); } }
                }
            }
        }
        __syncthreads();
        if (!done) {
            const u32x4g w0 = *(const LAS u32x4g*)(Hq + 8 * lane), w1 = *(const LAS u32x4g*)(Hq + 8 * lane + 4);
            const unsigned h0 = (w0.x & 0xffffu) + (w0.y & 0xffffu) + (w0.z & 0xffffu) + (w0.w & 0xffffu), h1 = (w0.x >> 16) + (w0.y >> 16) + (w0.z >> 16) + (w0.w >> 16);
            const unsigned h2 = (w1.x & 0xffffu) + (w1.y & 0xffffu) + (w1.z & 0xffffu) + (w1.w & 0xffffu), h3 = (w1.x >> 16) + (w1.y >> 16) + (w1.z >> 16) + (w1.w >> 16);
            const int lsum = (int)(h0 + h1 + h2 + h3);
            int incl = lsum;
#pragma unroll
            for (int o = 1; o < 64; o <<= 1) { const int t = __shfl_down(incl, o); if (lane + o < 64) incl += t; }
            const int S = incl - lsum;
            const bool has = (S < need) && (need <= incl);
            const int c3 = S + (int)h3, c2 = c3 + (int)h2, c1 = c2 + (int)h1;
            int bin, above, eqc;
            if (need <= c3) { bin = 3; above = S; eqc = (int)h3; } else if (need <= c2) { bin = 2; above = c3; eqc = (int)h2; } else if (need <= c1) { bin = 1; above = c2; eqc = (int)h1; } else { bin = 0; above = c1; eqc = (int)h0; }
            const unsigned long long bal = __ballot(has);
            const int src = (bal == 0ull) ? 0 : (__ffsll((long long)bal) - 1);
            bin = __shfl(4 * lane + bin, src); above = __shfl(above, src); n_eq = __shfl(eqc, src);
            prefix |= (unsigned)bin << shift; himask |= 255u << shift; need -= above;
            done = (need == n_eq);
        }
        { LAS unsigned* Hn = hist + ((lvl + 1) & 1) * 2048; Hn[F.tid] = 0u; Hn[F.tid + 512] = 0u; Hn[F.tid + 1024] = 0u; Hn[F.tid + 1536] = 0u; }
        __syncthreads();
    }
    const unsigned P = prefix;
    int idxs = 0x7fffffff;
    if (need < n_eq) {
        int running = 0;
        for (int c0 = 0; c0 < n; c0 += 64) {
            const int e = c0 + lane; const bool eq = (e < n) && (scq[e] == P);
            const unsigned long long bal = __ballot(eq); const int cnt2 = __popcll(bal);
            if (running + cnt2 >= need) {
                const int rank = __popcll(bal & ((1ull << lane) - 1ull)) + 1;
                const unsigned long long hit = __ballot(eq && (rank == need - running));
                idxs = c0 + (__ffsll((long long)hit) - 1); break; }
            running += cnt2;
        }
    }
    LAS unsigned long long* wrow = (LAS unsigned long long*)(hist) + wid * 64;
    wrow[lane] = 0ull;
#pragma unroll
    for (int g = 0; g < 8; ++g) {
        if (8 * g < nj) {
#pragma unroll
            for (int jj = 0; jj < 8; ++jj) { const int j = 8 * g + jj, e = (2 * j + part) * 64 + lane; const unsigned uu = key[j];
                const bool bsel = (uu > P) || (uu == P && e <= idxs && uu != 0u);
                const unsigned long long bal = __ballot(bsel);
                if (lane == 0) wrow[j] = bal; }
        }
    }
    MASK[(rb + t0 + q) * 128 + 2 * lane + part] = wrow[lane];
    __syncthreads();
}

constexpr int IDXC = 1024;
__device__ __forceinline__ int wave_total6(int c) { int t = 0;
#pragma unroll
    for (int bt = 0; bt < 6; ++bt) t += __popcll(__ballot((c >> bt) & 1)) << bt;
    return t; }
__device__ __forceinline__ int count_ge16(const unsigned (&e)[16], unsigned cand) {
    unsigned long long m0, m1, m2, m3, m4, m5, m6, m7;
#define CGE_(mm, j) asm("v_cmp_ge_u32_e64 %0, %1, %2" : "=s"(mm) : "v"(e[j]), "s"(cand))
    CGE_(m0, 0); CGE_(m1, 1); CGE_(m2, 2); CGE_(m3, 3); CGE_(m4, 4); CGE_(m5, 5); CGE_(m6, 6); CGE_(m7, 7);
    int c = ((__builtin_popcountll(m0) + __builtin_popcountll(m1)) + (__builtin_popcountll(m2) + __builtin_popcountll(m3))) + ((__builtin_popcountll(m4) + __builtin_popcountll(m5)) + (__builtin_popcountll(m6) + __builtin_popcountll(m7)));
    CGE_(m0, 8); CGE_(m1, 9); CGE_(m2, 10); CGE_(m3, 11); CGE_(m4, 12); CGE_(m5, 13); CGE_(m6, 14); CGE_(m7, 15);
#undef CGE_
    c += ((__builtin_popcountll(m0) + __builtin_popcountll(m1)) + (__builtin_popcountll(m2) + __builtin_popcountll(m3))) + ((__builtin_popcountll(m4) + __builtin_popcountll(m5)) + (__builtin_popcountll(m6) + __builtin_popcountll(m7)));
    return c;
}
__device__ __forceinline__ unsigned kth_largest16(const unsigned (&e)[16], int m, int total, int& cge_out, const int minbit = 0) {
    unsigned P = 0u; int cge = total;
#pragma unroll 1
    for (int bit = 31; bit >= minbit && cge != m; --bit) {
        const unsigned cand = P | (1u << bit);
        const int c = count_ge16(e, cand);
        if (c >= m) { P = cand; cge = c; }
    }
    cge_out = cge; return P;
}
__device__ __forceinline__ void xhalf_swap2(float& a, float& b) { asm volatile("s_nop 1\n\tv_permlane32_swap_b32 %0, %1\n\ts_nop 1" : "+v"(a), "+v"(b)); }
__device__ __forceinline__ float unsortable_key(unsigned u) { return __builtin_bit_cast(float, (u & 0x80000000u) ? (u & 0x7fffffffu) : ~u); }
typedef short i16_bf16x8v __attribute__((ext_vector_type(8)));
__device__ __forceinline__ void idx_load_q(i16_bf16x8v (&qa)[4][4], int b, int t16, const bf16* QI) {
    int lane = mk_lane(); const int r32 = lane & 31, hi = lane >> 5;
#pragma unroll
    for (int g = 0; g < 4; ++g) {
        const bf16* qp = QI + ((size_t)b * SEQ + 16 * t16 + 4 * g + (r32 >> 3)) * 512 + (r32 & 7) * 64 + hi * 8;
#pragma unroll
        for (int ks = 0; ks < 4; ++ks) qa[g][ks] = *(const i16_bf16x8v*)(qp + ks * 16);
    }
}
__device__ __forceinline__ void idx_unit16(Frame& F, int b, int t16, const bf16* QI, const bf16* KI, const float* WI, unsigned long long* MASK, int rot, i16_bf16x8v (&qa)[4][4], const int nb, const int nt16, const int mode = 3) {
    typedef short bf16x8v __attribute__((ext_vector_type(8))); typedef float f32x16v __attribute__((ext_vector_type(16)));
    LAS unsigned long long* be = (LAS unsigned long long*)(F.lds);
    LAS int* cnw = (LAS int*)(F.lds + 131072);
    LAS float* tau = (LAS float*)(F.lds + 131072 + 512);
    LAS int* flg = (LAS int*)(F.lds + 131072 + 576);
    LAS float* wl = (LAS float*)(F.lds + 132096);
    LAS unsigned* rows = (LAS unsigned*)(F.lds + 133120) + F.wave * 256;
    LAS unsigned long long* dump = (LAS unsigned long long*)(F.lds + 141312) + F.wave * 64;
    int lane = F.lane; asm volatile("" : "+v"(lane));
    const int tidv = F.wave * 64 + lane; const int r32 = lane & 31, hi = lane >> 5, wid = F.wave;
    const int t0 = 16 * t16, ntile = (t0 + 16 + 31) >> 5, npair = (ntile + 1) >> 1, nblk = (npair + 7) >> 3;
    const size_t rb = (size_t)b * SEQ;
    if (tidv < 16) { tau[tidv] = -INFINITY; flg[tidv] = 0; }
    if (tidv < 128) wl[tidv] = WI[(rb + t0) * 8 + tidv];
    __syncthreads();
    int cw[16];
#pragma unroll
    for (int i = 0; i < 16; ++i) cw[i] = 0;
#define I16_LOADK(dst, tile_) do { const bf16* kp_ = KI + ((rb >> 5) + (tile_)) * 2048 + (hi * 32 + r32) * 8; _Pragma("unroll") for (int ks = 0; ks < 4; ++ks) dst[ks] = *(const bf16x8v*)(kp_ + ks * 512); } while (0)
#define I16_TILE2(kfa, kfb, pair_, causal_) do { const int key = (pair_) * 64 + lane; LAS unsigned long long* dmp_ = dump + lane; \
        f32x4 w4n[4]; _Pragma("unroll") for (int q_ = 0; q_ < 4; ++q_) w4n[q_] = *(const LAS f32x4*)(wl + q_ * 8 + 4 * hi); \
        _Pragma("unroll") for (int g = 0; g < 4; ++g) { f32x16v acca = {}, accb = {}; \
            _Pragma("unroll") for (int ks = 0; ks < 4; ++ks) acca = __builtin_amdgcn_mfma_f32_32x32x16_bf16(qa[g][ks], kfa[ks], acca, 0, 0, 0); \
            _Pragma("unroll") for (int ks = 0; ks < 4; ++ks) accb = __builtin_amdgcn_mfma_f32_32x32x16_bf16(qa[g][ks], kfb[ks], accb, 0, 0, 0); \
            f32x4 w4c[4]; _Pragma("unroll") for (int q_ = 0; q_ < 4; ++q_) w4c[q_] = w4n[q_]; const f32x4 tq4 = *(const LAS f32x4*)(tau + 4 * g); \
            if (g < 3) { _Pragma("unroll") for (int q_ = 0; q_ < 4; ++q_) w4n[q_] = *(const LAS f32x4*)(wl + (4 * (g + 1) + q_) * 8 + 4 * hi); } \
            float ss_[4]; \
            _Pragma("unroll") for (int q_ = 0; q_ < 4; ++q_) { const int qq = 4 * g + q_; const f32x4 w4 = w4c[q_]; \
                  \
                  \
                float la = w4.x * acca[4 * q_], ma = w4.x * __builtin_fabsf(acca[4 * q_]); \
                la = __builtin_fmaf(w4.y, acca[4 * q_ + 1], la); ma = __builtin_fmaf(w4.y, __builtin_fabsf(acca[4 * q_ + 1]), ma); \
                la = __builtin_fmaf(w4.z, acca[4 * q_ + 2], la); ma = __builtin_fmaf(w4.z, __builtin_fabsf(acca[4 * q_ + 2]), ma); \
                la = __builtin_fmaf(w4.w, acca[4 * q_ + 3], la); ma = __builtin_fmaf(w4.w, __builtin_fabsf(acca[4 * q_ + 3]), ma); \
                float lb = w4.x * accb[4 * q_], mb = w4.x * __builtin_fabsf(accb[4 * q_]); \
                lb = __builtin_fmaf(w4.y, accb[4 * q_ + 1], lb); mb = __builtin_fmaf(w4.y, __builtin_fabsf(accb[4 * q_ + 1]), mb); \
                lb = __builtin_fmaf(w4.z, accb[4 * q_ + 2], lb); mb = __builtin_fmaf(w4.z, __builtin_fabsf(accb[4 * q_ + 2]), mb); \
                lb = __builtin_fmaf(w4.w, accb[4 * q_ + 3], lb); mb = __builtin_fmaf(w4.w, __builtin_fabsf(accb[4 * q_ + 3]), mb); \
                float sa = la + ma, sb = lb + mb; xhalf_swap2(sa, sb); \
                ss_[q_] = sa + sb; } \
            _Pragma("unroll") for (int q_ = 0; q_ < 4; ++q_) { const int qq = 4 * g + q_; const float s = ss_[q_];                                    \
                const float tq_ = q_ == 0 ? tq4.x : q_ == 1 ? tq4.y : q_ == 2 ? tq4.z : tq4.w; const bool pass = s >= tq_;                                                    \
                const unsigned long long bal = __builtin_amdgcn_ballot_w64(pass); \
                int pos_ = cw[qq] + (int)__builtin_amdgcn_mbcnt_hi((unsigned)(bal >> 32), __builtin_amdgcn_mbcnt_lo((unsigned)bal, 0u)); \
                pos_ = pos_ < 127 ? pos_ : 127;                                    \
                LAS unsigned long long* dst_ = pass ? (be + (qq * 8 + wid) * 128 + pos_) : dmp_; \
                *dst_ = (unsigned long long)__builtin_bit_cast(unsigned, s) | ((unsigned long long)(unsigned)key << 32); \
                cw[qq] += __popcll(bal); } } } while (0)
#define I16_PASS(sample_) do { bf16x8v ka[4], kb2[4], na[4], nb2[4]; int bb = -1, nb_ = -1; \
        for (int x = 0; x < nblk; ++x) { const int c_ = (sample_) ? x : ((x + rot) % nblk); if ((((c_ & 7) == 0) == (sample_)) && 8 * c_ + wid < npair) { bb = c_; nb_ = x; break; } } \
        if (bb >= 0) { const int p_ = 8 * bb + wid; I16_LOADK(ka, 2 * p_); I16_LOADK(kb2, (2 * p_ + 1 < ntile) ? 2 * p_ + 1 : ntile - 1); } \
        while (bb >= 0) { int nx = -1, nxi = -1; \
            for (int x = nb_ + 1; x < nblk; ++x) { const int c_ = (sample_) ? x : ((x + rot) % nblk); if ((((c_ & 7) == 0) == (sample_)) && 8 * c_ + wid < npair) { nx = c_; nxi = x; break; } } \
            { const int p_ = 8 * (nx >= 0 ? nx : bb) + wid; I16_LOADK(na, 2 * p_); I16_LOADK(nb2, (2 * p_ + 1 < ntile) ? 2 * p_ + 1 : ntile - 1); } \
            I16_TILE2(ka, kb2, 8 * bb + wid, true); \
            _Pragma("unroll") for (int ks = 0; ks < 4; ++ks) { ka[ks] = na[ks]; kb2[ks] = nb2[ks]; } \
            bb = nx; nb_ = nxi; } } while (0)
#define I16_PUBLISH() do { _Pragma("unroll") for (int i = 0; i < 16; ++i) { if (lane == 0) { cnw[i * 8 + wid] = cw[i] < 128 ? cw[i] : 128; if (cw[i] > 128) flg[i] = 1; } } } while (0)
#define I16_LOAD_LIST(qq_, e_, ix_, total_) do { total_ = 0; const u32x4g c0_ = *(const LAS u32x4g*)(cnw + (qq_) * 8), c1_ = *(const LAS u32x4g*)(cnw + (qq_) * 8 + 4); \
          \
        _Pragma("unroll") for (int j = 0; j < 16; ++j) { const int sg = j >> 1, p = (j & 1) * 64 + lane; \
            const int cs = (int)(sg == 0 ? c0_.x : sg == 1 ? c0_.y : sg == 2 ? c0_.z : sg == 3 ? c0_.w : sg == 4 ? c1_.x : sg == 5 ? c1_.y : sg == 6 ? c1_.z : c1_.w); \
            const unsigned long long en_ = be[((qq_) * 8 + sg) * 128 + p]; unsigned r_ = (unsigned)en_, x_ = (unsigned)(en_ >> 32); asm volatile("" : "+v"(r_), "+v"(x_));     \
            const bool ok_ = (p < cs) && ((int)x_ <= t0 + (qq_)); total_ += __popcll(__ballot(ok_)); e_[j] = ok_ ? sortable_key(__builtin_bit_cast(float, r_)) : 0u; ix_[j] = ok_ ? (unsigned short)x_ : (unsigned short)0xffff; } \
        } while (0)
    I16_PASS(true);
    I16_PUBLISH();
    __syncthreads();
    if (mode == 4) return;
#ifndef PROBE_TAU_REP
#define PROBE_TAU_REP 1
#endif
#pragma unroll 1
    for (int w2 = 0; w2 < 2 * PROBE_TAU_REP; ++w2) {
        const int qq = 2 * wid + (w2 & 1), nc = t0 + qq + 1, kk = nc < TOPK ? nc : TOPK;
        if (nc > IDXC) {
            unsigned e[16]; unsigned short ix[16]; int ns;
            I16_LOAD_LIST(qq, e, ix, ns);
            const float mu = (float)kk * (float)ns / (float)nc; const int m = __builtin_amdgcn_readfirstlane((int)(mu + 5.f * sqrtf(mu) + 9.f));
            if (m < ns) { int cge; const unsigned P = kth_largest16(e, m, ns, cge, 15); if (lane == 0) tau[qq] = unsortable_key(P); }
        }
    }
    __syncthreads();
    if (mode == 8) return;
#pragma unroll
    for (int i = 0; i < 16; ++i) { const float tv = tau[i];
        if (tv != -INFINITY) { const int cs = cw[i] < 128 ? cw[i] : 128; LAS unsigned long long* sk = be + (i * 8 + wid) * 128;
            const unsigned long long e0 = sk[lane], e1 = sk[lane + 64];
            const bool k0 = (lane < cs) && (__builtin_bit_cast(float, (unsigned)e0) >= tv), k1 = (lane + 64 < cs) && (__builtin_bit_cast(float, (unsigned)e1) >= tv); const unsigned long long b0 = __ballot(k0), b1 = __ballot(k1);
            const int p0 = (int)__builtin_amdgcn_mbcnt_hi((unsigned)(b0 >> 32), __builtin_amdgcn_mbcnt_lo((unsigned)b0, 0u)), n0 = __popcll(b0);
            const int p1 = n0 + (int)__builtin_amdgcn_mbcnt_hi((unsigned)(b1 >> 32), __builtin_amdgcn_mbcnt_lo((unsigned)b1, 0u));
            if (k0) sk[p0] = e0; if (k1) sk[p1] = e1;
            cw[i] = n0 + __popcll(b1); } }
    I16_PASS(false);
    I16_PUBLISH();
    if (nt16 >= 0) idx_load_q(qa, nb, nt16, QI);
    __syncthreads();
    if (!(mode & 2)) return;
#undef I16_PASS
#undef I16_TILE2
#undef I16_LOADK
#undef I16_PUBLISH
#pragma unroll 1
    for (int w2 = 0; w2 < 2; ++w2) {
        const int qq = 2 * wid + w2, nc = t0 + qq + 1, kk = nc < TOPK ? nc : TOPK;
        unsigned e[16]; unsigned short ix[16]; int c;
        I16_LOAD_LIST(qq, e, ix, c);
#ifdef PROBE_FORCE_FALLBACK
        if ((t16 % 5) == 1 && (qq & 4)) { if (lane == 0) flg[qq] = 1; continue; }
#endif
        if (c < kk || flg[qq]) { if (lane == 0) flg[qq] = 1; continue; }
        int cge; const unsigned P = kth_largest16(e, kk, c, cge);
        int ilim = 0xffff;
        if (cge > kk) {
            int cgt = 0;
#pragma unroll
            for (int j = 0; j < 16; ++j) cgt += (e[j] > P) ? 1 : 0;
            cgt = wave_total6(cgt);
            const int need = kk - cgt; int I = 0;
#pragma unroll 1
            for (int bit = 12; bit >= 0; --bit) { const int cand = I | (1 << bit); int c2 = 0;
#pragma unroll
                for (int j = 0; j < 16; ++j) c2 += (e[j] == P && (int)ix[j] < cand) ? 1 : 0;
                c2 = wave_total6(c2);
                if (c2 < need) I = cand; }
            ilim = I;
        }
        rows[lane] = 0u; rows[lane + 64] = 0u; rows[lane + 128] = 0u; rows[lane + 192] = 0u;
#pragma unroll
        for (int j = 0; j < 16; ++j) {
            const bool sel = (e[j] != 0u) & ((e[j] > P) | ((e[j] == P) & ((int)ix[j] <= ilim)));
            const unsigned kx = ix[j];
            __hip_atomic_fetch_or(rows + ((kx >> 5) & 255u), sel ? (1u << (kx & 31u)) : 0u, __ATOMIC_RELAXED, __HIP_MEMORY_SCOPE_WORKGROUP); }
        const u32x4g rv = *(const LAS u32x4g*)(rows + 4 * lane);
        *(u32x4g*)((unsigned*)(MASK + (rb + t0 + qq) * 128) + 4 * lane) = rv;
    }
#undef I16_LOAD_LIST
    __syncthreads();
    { int fl = (flg[0] | flg[1] | flg[2] | flg[3]) | ((flg[4] | flg[5] | flg[6] | flg[7]) << 1) | ((flg[8] | flg[9] | flg[10] | flg[11]) << 2) | ((flg[12] | flg[13] | flg[14] | flg[15]) << 3);
      fl = __builtin_amdgcn_readfirstlane(fl);
      __syncthreads();
#ifndef PROBE_NO_FALLBACK
#pragma unroll 1
      for (int g = 0; g < 4; ++g) if ((fl >> g) & 1) idx_unit(F, b, 4 * t16 + g, QI, KI, WI, MASK, rot);
#endif
      if (fl != 0 && nt16 >= 0) idx_load_q(qa, nb, nt16, QI);
    }
}

struct Args { const float* in[22]; float* out; unsigned char* ws; int ph_lo, ph_hi, li, pad; };
__global__ void __launch_bounds__(NWAVES * 64, 2) fwd_mega(Args args) {
    extern __shared__ __attribute__((aligned(16))) unsigned char lds[];
    Frame F;
    F.lds = (LAS unsigned char*)lds;
    F.MISC = (volatile LAS unsigned*)(F.lds + MISC_OFF);
    F.wave = __builtin_amdgcn_readfirstlane((int)threadIdx.x >> 6); F.lane = mk_lane(); F.tid = F.wave * 64 + F.lane;
#define REFRESH_IDS() do { F.lane = mk_lane(); F.tid = F.wave * 64 + F.lane; } while (0)
    F.G = gridDim.x; { const int bx = blockIdx.x; F.vcu = (F.G % 8 == 0) ? (bx % 8) * (F.G / 8) + bx / 8 : bx; }
    unsigned char* ws = args.ws; F.ws = ws; F.out = args.out;
    F.ctl = (gu32*)(ws + WS_CTL);
    for (int u = F.tid; u < (LDS_BYTES - LDSCTL_OFF) / 4; u += NWAVES * 64) ((LAS unsigned*)(F.lds + LDSCTL_OFF))[u] = 0u;
    __syncthreads();
    XcdBarrier bar; bar.wave = F.wave; bar.bar = (unsigned*)(F.ctl + CW_BAR); bar.x = 0; bar.st = nullptr;
    if (N_LAUNCHES == 1) bar = xcd_barrier_post((unsigned*)(F.ctl + CW_BAR), F.MISC + 8, F.wave);
#ifdef PROBE_DOUBLE_BAR
#define GRID_BAR() do { if (N_LAUNCHES == 1) { xcd_barrier(bar); xcd_barrier(bar); } } while (0)
#else
#define GRID_BAR() do { if (N_LAUNCHES == 1) xcd_barrier(bar); } while (0)
#endif
    const int lo = args.ph_lo, hi = args.ph_hi;
#define IN(k) (lo <= (k) && (k) < hi)
#ifdef PROBE_REPEAT
#define PREP(k) int nrep_##k = ((PROBE_REPEAT == (k)) ? 2 : 1); asm volatile("" : "+s"(nrep_##k)); _Pragma("unroll 1") for (int rep_ = 0; rep_ < nrep_##k; ++rep_)
#else
#define PREP(k) for (int rep_ = 0; rep_ < 1; ++rep_)
#endif
#define BOTH(k) (IN(k) && IN((k) + 1))

    bf16* Wgu = (bf16*)(ws + WS_WGU); bf16* Wd = (bf16*)(ws + WS_WD); bf16* WinA = (bf16*)(ws + WS_WINA); bf16* WinB = (bf16*)(ws + WS_WINB);
    bf16* Wbr = (bf16*)(ws + WS_WBR); bf16* Wout = (bf16*)(ws + WS_WOUT);
    bf16* H = (bf16*)(ws + WS_H); bf16* A = (bf16*)(ws + WS_BIG);
    bf16* Q16 = (bf16*)(ws + WS_Q16); bf16* K16 = (bf16*)(ws + WS_K16); bf16* V16 = (bf16*)(ws + WS_V16); bf16* SG = K16;
    bf16* QI = (bf16*)(ws + WS_QI); bf16* KI = (bf16*)(ws + WS_KI); float* WI = (float*)(ws + WS_WI); float* LF = (float*)(ws + WS_LF); float* F2 = (float*)(ws + WS_F2);
    unsigned long long* MASK = (unsigned long long*)(ws + WS_MASK);
    const float* mod = (const float*)(ws + WS_MOD);
    bf16* X1B = (bf16*)F.out;
    bf16* X2B = (bf16*)(ws + WS_V16);

    if (IN(0)) { REFRESH_IDS();
#if defined(PROBE_REPEAT) && PROBE_REPEAT == 100
      for (int rep_ = 0; rep_ < 2; ++rep_) {
#else
      {
#endif
#ifdef PROBE_P0_NOGEMV
        if (rep_ == 1) {
#else
        {
#endif
        if ((int)blockIdx.x < 72) mod_gemv(F, (int)blockIdx.x, args.in[1], args.in[2], args.in[3]);
        }
        if ((int)blockIdx.x == 80 && F.tid < 264) { float* gd = (float*)(ws + WS_GAINS); const int t = F.tid;
            if (t == 0) { float mq = 0.f, mk = 0.f; for (int d = 0; d < 64; ++d) { mq = fmaxf(mq, fabsf(args.in[13][d])); mk = fmaxf(mk, fabsf(args.in[14][d])); } gd[264] = 64.f * 0.125f * 1.4426950408889634f * mq * mk; }
            if (t == 1) { float mq = 0.f, mk = 0.f; for (int d = 0; d < 64; ++d) { mq = fmaxf(mq, fabsf(args.in[11][d])); mk = fmaxf(mk, fabsf(args.in[12][d])); } gd[265] = 64.f * 0.125f * 1.4426950408889634f * mq * mk; }
            gd[t] = (t < 64) ? args.in[11][t] : (t < 128) ? args.in[12][t - 64] : (t < 192) ? args.in[13][t - 128] : (t < 256) ? args.in[14][t - 192] : args.in[10][t - 256]; }
#ifdef PROBE_P0_NOBUILD
        if ((int)blockIdx.x == 81 && rep_ == 1) build_attn_queues(F, args.in[10], args.in[13], args.in[14]);
#else
        if ((int)blockIdx.x == 81) build_attn_queues(F, args.in[10], args.in[13], args.in[14]);
#endif
        int base = 0;
        base = transpose_job64<true>(F, J_GU, args.in[5], args.in[6], Wgu, 2 * D_FF, D_MODEL, base, 32.f);
        base = transpose_job64<true>(F, J_D, args.in[7], nullptr, Wd, D_MODEL, D_FF, base, 64.f);
        base = transpose_job64<true>(F, J_INA, args.in[9], nullptr, ws + WS_WINA + 2 * MiB, 3072, D_MODEL, base, 32.f);
        base = transpose_job64<false>(F, J_INA, args.in[9], nullptr, WinA, 768, D_MODEL, base, 1.f, 48);
        base = transpose_job64<true>(F, J_INB, args.in[9], nullptr, WinB, 2048, D_MODEL, base, 32.f);
        base = transpose_job64<true>(F, J_BR, args.in[15], args.in[16], Wbr, 2048, D_MODEL, base, 32.f);
        base = transpose_job64<true>(F, J_OUT, args.in[17], nullptr, Wout, D_MODEL, D_MODEL, base, 32.f);
#ifdef PROBE_REPEAT
        __syncthreads();
#endif
      }
        if (BOTH(0)) GRID_BAR();
    }
    if (IN(1)) { REFRESH_IDS(); norm_phase8(F, args.in[0], args.in[4], 0, (unsigned char*)H); if (BOTH(1)) GRID_BAR(); }
    if (IN(2)) { REFRESH_IDS();
        pg8::Gemm g{H, Wgu, M, 2 * D_FF, D_MODEL / 2}; pg8::StaticOrder S; S.init(M, 2 * D_FF, F.G, (int)blockIdx.x);
        pg8::EpiSwiglu8 E{(unsigned char*)A, D_FF, 1.0f / 32.0f};
        pg8::gemm_phase<pg8::EpiSwiglu8, pg8::StaticOrder, true, true, true>(F.lds, g, S, E, F.wave);
#if defined(PROBE_REPEAT) && PROBE_REPEAT == 2
        __syncthreads(); pg8::gemm_phase<pg8::EpiSwiglu8, pg8::StaticOrder, true, true, true>(F.lds, g, S, E, F.wave);
#endif
        if (BOTH(2)) GRID_BAR();
    }
    if (IN(3)) { REFRESH_IDS();
        pg8::Gemm g{A, Wd, M, D_MODEL, D_FF / 2}; pg8::StaticOrder S; S.init(M, D_MODEL, F.G, (int)blockIdx.x);
        pg8::EpiResidT<false, true> E{args.in[0], X1B, mod + 2 * 1024, 0.5f / 64.0f};
        pg8::gemm_phase<pg8::EpiResidT<false, true>, pg8::StaticOrder, true, true, true>(F.lds, g, S, E, F.wave);
        if (BOTH(3)) GRID_BAR();
    }
    if (IN(4)) { REFRESH_IDS();
#if defined(PROBE_REPEAT) && PROBE_REPEAT == 104
      for (int rep_ = 0; rep_ < 2; ++rep_) {
#else
      {
#endif
        norm_phase<true>(F, X1B, args.in[8], 3, H, ws + WS_H8B);
      }
        if (BOTH(4)) GRID_BAR();
    }
    if (IN(5)) { REFRESH_IDS();
      PREP(5) {
        { pg8::Gemm g{H, WinA, M, 768, D_MODEL}; pg8::StaticOrder S; S.init(M, 768, F.G, (int)blockIdx.x);
          pg8::EpiInA E{Q16, QI, KI, WI, LF, (const float*)(ws + WS_GAINS), 12, 1.0f};
          pg8::gemm_phase<pg8::EpiInA, pg8::StaticOrder, true, true>(F.lds, g, S, E, F.wave); }
        { pg8::Gemm g{(const bf16*)(ws + WS_H8B), (const bf16*)(ws + WS_WINA + 2 * MiB), M, 3072, D_MODEL / 2}; pg8::StaticOrder S; S.init(M, 3072, F.G, (int)blockIdx.x);
          pg8::EpiInA E{Q16, QI, KI, WI, LF, (const float*)(ws + WS_GAINS), 0, 1.0f / 32.0f};
          pg8::gemm_phase<pg8::EpiInA, pg8::StaticOrder, true, true, true>(F.lds, g, S, E, F.wave); }
        __syncthreads(); }
        if (BOTH(5)) GRID_BAR();
    }
    if (IN(6)) { REFRESH_IDS();
        if ((int)blockIdx.x < 16 && F.wave == 0) fscan_row(LF + (size_t)blockIdx.x * SEQ, F2 + (size_t)blockIdx.x * SEQ, F.lane);
#ifdef PROBE_TWICE_P6
#pragma unroll 1
        for (int rep_ = 0; rep_ < 2; ++rep_) { int md = rep_ ? 3 : PROBE_TWICE_P6; asm volatile("" : "+s"(md));
#else
        { const int md = 3;
#endif
        i16_bf16x8v qa[4][4];
        { const int idx0 = F.vcu; if (idx0 < 1024) { const int j0 = 1023 - idx0; idx_load_q(qa, j0 & 1, j0 >> 1, QI); } }
#pragma unroll 1
        for (int i = 0; i * F.G < 1024; ++i) {
            const int idx = i * F.G + ((i & 1) ? (F.G - 1 - F.vcu) : F.vcu);
            if (idx >= 1024) continue;
            const int j = 1023 - idx;
            const int idxn = (i + 1) * F.G + (((i + 1) & 1) ? (F.G - 1 - F.vcu) : F.vcu), jn = 1023 - idxn;
            idx_unit16(F, j & 1, j >> 1, QI, KI, WI, MASK, F.vcu * 7 + i * 3, qa, jn & 1, idxn < 1024 ? (jn >> 1) : -1, md);
        }
        }
        if (BOTH(6)) GRID_BAR();
    }
    if (IN(7)) { REFRESH_IDS();
        const unsigned* ord = (const unsigned*)(ws + WS_AORDER); const float qmf = ((const float*)(ws + WS_GAINS))[264], qmd = ((const float*)(ws + WS_GAINS))[265];
        const int xg = (int)(blockIdx.x & 7);
      PREP(7) {
        int xs = 0;
        for (;;) {
            const int xq = (xg + xs) & 7;
            if (F.tid == 0) F.MISC[16] = __hip_atomic_fetch_add((unsigned*)(F.ctl + CW_AQUEUE + 64 * xq + 32 * rep_), 1u, __ATOMIC_RELAXED, __HIP_MEMORY_SCOPE_AGENT);
            __syncthreads();
            const unsigned qi = F.MISC[16];
            __syncthreads();
            if (qi >= ord[8 * AQ_CAP + xq]) { if (++xs == 8) break; continue; }
            const unsigned id = ord[xq * AQ_CAP + qi]; const int ty = (int)(id >> 9) & 1, b = (int)(id >> 8) & 1, h = (int)(id >> 5) & 7, qb = (int)(id & 31), pc = (int)(id >> 10) & 3, np = (int)(id >> 12) & 7;
#ifdef PROBE_SKIPTY
            if (rep_ == 0 && ty == PROBE_SKIPTY) continue;
#endif
            if (ty) { int np2, per; dsa_plan(h, qb, np2, per);
                      float* part = (float*)(ws + WS_H) + (size_t)((b * 2 + (h & 1)) * 16 + (qb & 15)) * (2 * 49 * 512);
                      att::attn_unit<1>(b, h, qb, Q16, K16, V16, ws + WS_O8, F2, MASK, (char*)lds, qmd, F.wave, pc, np, per, part, (unsigned*)(F.ctl + CW_PCTR + (b * 2 + (h & 1)) * 16 + (qb & 15) + 64 * rep_)); }
            else    att::attn_unit<0>(b, 8 + h, qb, Q16, K16, V16, ws + WS_O8, F2, MASK, (char*)lds, qmf, F.wave);
        }
      }
        REFRESH_IDS();
        ffn_copies_queue(F, F.ctl + CW_CQUEUE, args.in[19], args.in[20], args.in[21], Wgu, Wd);
        if (BOTH(7)) GRID_BAR();
    }
    if (IN(8)) { REFRESH_IDS();
        pg8::Gemm g{(const bf16*)(ws + WS_H8B), WinB, M, 2048, D_MODEL / 2}; pg8::StaticOrder S; S.init(M, 2048, F.G, (int)blockIdx.x);
        pg8::EpiGate E{SG, 1.0f / 32.0f};
        PREP(8) { pg8::gemm_phase<pg8::EpiGate, pg8::StaticOrder, true, true, true>(F.lds, g, S, E, F.wave); __syncthreads(); }
        if (BOTH(8)) GRID_BAR();
    }
    if (IN(9)) { REFRESH_IDS();
        pg8::Gemm g{(const bf16*)(ws + WS_O8), Wbr, M, 2048, D_MODEL / 2}; pg8::StaticOrder S; S.init(M, 2048, F.G, (int)blockIdx.x);
        pg8::EpiMerge E{SG, (unsigned char*)H, 1.0f / 32.0f};
        PREP(9) { pg8::gemm_phase<pg8::EpiMerge, pg8::StaticOrder, true, true, true>(F.lds, g, S, E, F.wave); __syncthreads(); }
        if (BOTH(9)) GRID_BAR();
    }
    if (IN(10)) { REFRESH_IDS();
        pg8::Gemm g{H, Wout, M, D_MODEL, D_MODEL / 2}; pg8::StaticOrder S; S.init(M, D_MODEL, F.G, (int)blockIdx.x);
        pg8::EpiResidT<true, true> E{X1B, X2B, mod + 5 * 1024, 1.0f / 32.0f};
        pg8::gemm_phase<pg8::EpiResidT<true, true>, pg8::StaticOrder, true, true, true>(F.lds, g, S, E, F.wave);
        if (BOTH(10)) GRID_BAR();
    }
    if (IN(11)) { REFRESH_IDS(); norm_phase8<true>(F, X2B, args.in[18], 6, (unsigned char*)H); if (BOTH(11)) GRID_BAR(); }
    if (IN(12)) { REFRESH_IDS();
        pg8::Gemm g{H, Wgu, M, 2 * D_FF, D_MODEL / 2}; pg8::StaticOrder S; S.init(M, 2 * D_FF, F.G, (int)blockIdx.x);
        pg8::EpiSwiglu8 E{(unsigned char*)A, D_FF, 1.0f / 32.0f};
        pg8::gemm_phase<pg8::EpiSwiglu8, pg8::StaticOrder, true, true, true>(F.lds, g, S, E, F.wave);
        if (BOTH(12)) GRID_BAR();
    }
    if (IN(13)) { REFRESH_IDS();
        pg8::Gemm g{A, Wd, M, D_MODEL, D_FF / 2}; pg8::StaticOrder S; S.init(M, D_MODEL, F.G, (int)blockIdx.x);
        pg8::EpiResidT<true, false> E{X2B, F.out, mod + 8 * 1024, 0.5f / 64.0f};
        pg8::gemm_phase<pg8::EpiResidT<true, false>, pg8::StaticOrder, true, true, true>(F.lds, g, S, E, F.wave);
    }
#undef IN
#undef BOTH
#undef GRID_BAR
}


#ifdef DBG_CHECK_MASK
__global__ void __launch_bounds__(512) dbg_check_mask(const unsigned char* ws, unsigned* counter) {
    __shared__ float s[8192];
    __shared__ float qv[512]; __shared__ float wv[8];
    const bf16* QI = (const bf16*)(ws + WS_QI); const bf16* KI = (const bf16*)(ws + WS_KI); const float* WI = (const float*)(ws + WS_WI);
    const unsigned long long* MASK = (const unsigned long long*)(ws + WS_MASK);
    const int b = blockIdx.x & 1, t = (int)(((unsigned)(blockIdx.x >> 1) * 2654435761u) % (unsigned)SEQ);
    if (t >= SEQ) return;
    const size_t rb = (size_t)b * SEQ;
    for (int i = threadIdx.x; i < 512; i += 512) qv[i] = __builtin_bit_cast(float, (unsigned)QI[(rb + t) * 512 + i] << 16);
    if (threadIdx.x < 8) wv[threadIdx.x] = WI[(rb + t) * 8 + threadIdx.x];
    __syncthreads();
    const int n = t + 1;
    for (int e = threadIdx.x; e < n; e += 512) {
        float sc = 0.f;
        _Pragma("unroll 1") for (int i = 0; i < 8; ++i) { float x = 0.f; _Pragma("unroll 4") for (int d = 0; d < 64; ++d) x += qv[i * 64 + d] * __builtin_bit_cast(float, (unsigned)KI[((rb + e) >> 5) * 2048 + ((d >> 3) * 32 + ((rb + e) & 31)) * 8 + (d & 7)] << 16); sc += wv[i] * fmaxf(x, 0.f); }
        s[e] = sc + 0.f;
    }
    __syncthreads();
    const int kk = n < 256 ? n : 256;
    unsigned bad = 0;
    for (int e = threadIdx.x; e < SEQ; e += 512) {
        bool sel = false;
        if (e < n) { const float se = s[e]; int rank = 0; _Pragma("unroll 4") for (int j = 0; j < n; ++j) { const float sj = s[j]; rank += (sj > se || (sj == se && j < e)) ? 1 : 0; } sel = rank < kk; }
        const bool got = (MASK[(rb + t) * 128 + (e >> 6)] >> (e & 63)) & 1ull;
        if (sel != got) ++bad;
    }
    if (bad) atomicAdd(counter, bad);
}
__global__ void dbg_report(float* out, const unsigned* counter) {
    const unsigned m = *counter; if (m == 0) return;
    int lg = 0; unsigned v = m; while (v > 1) { v >>= 1; ++lg; }
    out[0] += 100.f * (float)(1 + lg);
}
#endif

#ifdef DBG_CHECK_ATT
__device__ __forceinline__ float dbg_bf(unsigned short v) { return __builtin_bit_cast(float, (unsigned)v << 16); }
__device__ __forceinline__ void dbg_sample(int s, int& b, int& t, int& h) { b = s & 1; h = (s >> 1) & 15; t = (int)(((unsigned)(s >> 5) * 2654435761u + (unsigned)(s & 31) * 40503u) % (unsigned)SEQ); }
__global__ void dbg_save_q(const unsigned char* ws, float* save) {
    int b, t, h; dbg_sample(blockIdx.x, b, t, h);
    const bf16* Q16 = (const bf16*)(ws + WS_Q16);
    if (threadIdx.x < 64) save[blockIdx.x * 64 + threadIdx.x] = dbg_bf(Q16[((size_t)b * SEQ + t) * 1024 + h * 64 + threadIdx.x]);
}
__global__ void __launch_bounds__(256) dbg_check_att(const unsigned char* ws, const float* save, unsigned* counter) {
    __shared__ float lg[8192]; __shared__ int sel[512]; __shared__ int nsel; __shared__ float q[64]; __shared__ float red[2]; __shared__ float rm[256];
    int b, t, h; dbg_sample(blockIdx.x, b, t, h);
    const bf16* O16 = (const bf16*)(ws + WS_Q16); const bf16* K16 = (const bf16*)(ws + WS_K16); const bf16* V16 = (const bf16*)(ws + WS_V16);
    const unsigned long long* MASK = (const unsigned long long*)(ws + WS_MASK); const float* F2 = (const float*)(ws + WS_F2);
    const size_t rb = (size_t)b * SEQ;
    if (threadIdx.x < 64) q[threadIdx.x] = save[blockIdx.x * 64 + threadIdx.x];
    __syncthreads();
    const int n = t + 1;
    if (h < 8) {
        const float sl2 = exp2f(-(float)(h + 1)) * 1.4426950408889634f;
        for (int s = threadIdx.x; s < n; s += 256) { float x = -INFINITY;
            if ((MASK[(rb + t) * 128 + (s >> 6)] >> (s & 63)) & 1ull) { x = 0.f; _Pragma("unroll 4") for (int d = 0; d < 64; ++d) x += q[d] * dbg_bf(K16[(rb + s) * 1024 + h * 64 + d]); x += sl2 * (float)(s - t); }
            lg[s] = x; }
    } else {
        const float* f2 = F2 + ((size_t)b * 8 + (h - 8)) * SEQ; const float fq = f2[t];
        for (int s = threadIdx.x; s < n; s += 256) { float x = 0.f; _Pragma("unroll 4") for (int d = 0; d < 64; ++d) x += q[d] * dbg_bf(K16[(rb + s) * 1024 + h * 64 + d]); lg[s] = x + fq - f2[s]; }
    }
    __syncthreads();
    { float m = -INFINITY; for (int s = threadIdx.x; s < n; s += 256) m = fmaxf(m, lg[s]); rm[threadIdx.x] = m; }
    __syncthreads();
    if (threadIdx.x == 0) { float m = -INFINITY; for (int i = 0; i < 256; ++i) m = fmaxf(m, rm[i]); red[0] = m; }
    __syncthreads();
    { float l = 0.f; for (int s = threadIdx.x; s < n; s += 256) { const float p = exp2f(lg[s] - red[0]); lg[s] = p; l += p; } rm[threadIdx.x] = l; }
    __syncthreads();
    if (threadIdx.x == 0) { float l = 0.f; for (int i = 0; i < 256; ++i) l += rm[i]; red[1] = l; }
    __syncthreads();
    if (threadIdx.x < 64) { const int d = threadIdx.x; float o = 0.f;
        for (int s = 0; s < n; ++s) { const float p = lg[s]; if (p != 0.f) o += p * dbg_bf(V16[(rb + s) * 1024 + h * 64 + d]); }
        o /= red[1];
        const float got = dbg_bf(O16[(rb + t) * 1024 + h * 64 + d]);
        if (!(fabsf(got - o) <= 0.03f + 0.03f * fabsf(o))) atomicAdd(counter + (h < 8 ? 0 : 1), 1u); }
    (void)sel; (void)nsel;
}
__global__ void __launch_bounds__(256) dbg_check_proj(const unsigned char* ws, const float* w_in, unsigned* counter) {
    const bf16* H = (const bf16*)(ws + WS_H); const bf16* QI = (const bf16*)(ws + WS_QI); const bf16* KI = (const bf16*)(ws + WS_KI); const float* WI = (const float*)(ws + WS_WI);
    const int m = (blockIdx.x * 131 + 17) & (M - 1);
    __shared__ float hrow[1024];
    for (int i = threadIdx.x; i < 1024; i += 256) hrow[i] = dbg_bf(H[(size_t)m * 1024 + i]);
    __syncthreads();
    for (int c = threadIdx.x; c < 584; c += 256) {
        const int col = 3072 + c; float z = 0.f;
        _Pragma("unroll 4") for (int k2 = 0; k2 < 1024; ++k2) z += hrow[k2] * w_in[(size_t)k2 * IN_WIDTH + col];
        float got, ref;
        if (c < 512) { ref = z * 0.125f; got = dbg_bf(QI[(size_t)m * 512 + c]); }
        else if (c < 576) { ref = z; got = dbg_bf(KI[(size_t)m * 64 + (c - 512)]); }
        else { ref = z * 0.35355339059327373f; got = WI[(size_t)m * 8 + (c - 576)]; }
        const float tol = (c < 512 ? 0.125f : 1.f) * 0.04f + 0.02f * fabsf(ref);
        if (!(fabsf(got - ref) <= tol)) atomicAdd(counter + 2, 1u);
    }
}

__global__ void __launch_bounds__(256) dbg_check_qkv(const unsigned char* ws, const float* w_in, unsigned* counter) {
    const bf16* H = (const bf16*)(ws + WS_H); const bf16* QKV = (const bf16*)(ws + WS_Q16); const float* gains = (const float*)(ws + WS_GAINS);
    const int m = (blockIdx.x * 257 + 5) & (M - 1);
    __shared__ float hrow[1024]; __shared__ float zs[3072];
    for (int i = threadIdx.x; i < 1024; i += 256) hrow[i] = dbg_bf(H[(size_t)m * 1024 + i]);
    __syncthreads();
    for (int c = threadIdx.x; c < 3072; c += 256) { float z = 0.f; _Pragma("unroll 4") for (int k2 = 0; k2 < 1024; ++k2) z += hrow[k2] * w_in[(size_t)k2 * IN_WIDTH + c]; zs[c] = z; }
    __syncthreads();
    for (int c = threadIdx.x; c < 3072; c += 256) {
        const int sec = c >> 9, head = (c >> 6) & 7, d = c & 63;
        float ref = zs[c], scale = 1.f;
        if (sec != 2 && sec != 5) { float ss = 0.f; for (int j = 0; j < 64; ++j) { const float v = zs[(c & ~63) + j]; ss += v * v; }
            const float rstd = 1.f / sqrtf(ss / 64.f + 1e-6f); const int gi = sec - (sec >= 3 ? 1 : 0);
            ref = ref * rstd * gains[64 * gi + d]; if (sec == 0 || sec == 3) { ref *= 0.125f * 1.4426950408889634f; scale = 0.18f; } }
        const int which = (sec == 0 || sec == 3) ? 0 : (sec == 1 || sec == 4) ? 1 : 2;
        const float got = dbg_bf(QKV[(size_t)which * 16777216 + (size_t)m * 1024 + (sec >= 3 ? 512 : 0) + head * 64 + d]);
        if (!(fabsf(got - ref) <= 0.04f * scale + 0.03f * fabsf(ref))) atomicAdd(counter + 3, 1u);
    }
}
__global__ void __launch_bounds__(256) dbg_check_gate(const unsigned char* ws, const float* w_in, unsigned* counter) {
    const bf16* H = (const bf16*)(ws + WS_H); const bf16* SG = (const bf16*)(ws + WS_K16);
    const int m = (blockIdx.x * 263 + 11) & (M - 1);
    __shared__ float hrow[1024];
    for (int i = threadIdx.x; i < 1024; i += 256) hrow[i] = dbg_bf(H[(size_t)m * 1024 + i]);
    __syncthreads();
    for (int c = threadIdx.x; c < 2048; c += 256) { float z = 0.f; _Pragma("unroll 4") for (int k2 = 0; k2 < 1024; ++k2) z += hrow[k2] * w_in[(size_t)k2 * IN_WIDTH + 3664 + c];
        const float ref = 1.f / (1.f + expf(-z)), got = dbg_bf(SG[(size_t)m * 2048 + c]);
        if (!(fabsf(got - ref) <= 0.02f)) { atomicAdd(counter + 4, 1u); if (atomicAdd(counter + 32 + blockIdx.x, 1u) == 0u) atomicAdd(counter + 8, 1u); atomicOr(counter + 9, 1u << (c >> 8)); } }
}
__global__ void __launch_bounds__(256) dbg_check_merge(const unsigned char* ws, const float* wbd, const float* wbf, unsigned* counter) {
    const bf16* Hm = (const bf16*)(ws + WS_H); const bf16* SG = (const bf16*)(ws + WS_K16); const bf16* O16 = (const bf16*)(ws + WS_Q16);
    const int m = (blockIdx.x * 269 + 3) & (M - 1);
    __shared__ float orow[1024];
    for (int i = threadIdx.x; i < 1024; i += 256) orow[i] = dbg_bf(O16[(size_t)m * 1024 + i]);
    __syncthreads();
    for (int c = threadIdx.x; c < 1024; c += 256) { float yd = 0.f, yf = 0.f;
        _Pragma("unroll 4") for (int k2 = 0; k2 < 512; ++k2) { yd += orow[k2] * wbd[(size_t)k2 * 1024 + c]; yf += orow[512 + k2] * wbf[(size_t)k2 * 1024 + c]; }
        const float ref = dbg_bf(SG[(size_t)m * 2048 + c]) * yd + dbg_bf(SG[(size_t)m * 2048 + 1024 + c]) * yf, got = dbg_bf(Hm[(size_t)m * 1024 + c]);
        if (!(fabsf(got - ref) <= 0.03f + 0.03f * fabsf(ref))) atomicAdd(counter + 5, 1u); }
}
__global__ void dbg_save_out(const float* out, float* save) { const int m = (blockIdx.x * 271 + 7) & (M - 1); for (int i = threadIdx.x; i < 1024; i += 256) save[blockIdx.x * 1024 + i] = out[(size_t)m * 1024 + i]; }
__global__ void __launch_bounds__(256) dbg_check_out(const unsigned char* ws, const float* out, const float* save, const float* w_out, unsigned* counter) {
    const bf16* Hm = (const bf16*)(ws + WS_H); const float* mod = (const float*)(ws + WS_MOD);
    const int m = (blockIdx.x * 271 + 7) & (M - 1), b = m >> 13;
    __shared__ float hrow[1024];
    for (int i = threadIdx.x; i < 1024; i += 256) hrow[i] = dbg_bf(Hm[(size_t)m * 1024 + i]);
    __syncthreads();
    for (int c = threadIdx.x; c < 1024; c += 256) { float z = 0.f; _Pragma("unroll 4") for (int k2 = 0; k2 < 1024; ++k2) z += hrow[k2] * w_out[(size_t)k2 * 1024 + c];
        const float ref = save[blockIdx.x * 1024 + c] + mod[b * 9216 + 5 * 1024 + c] * z, got = out[(size_t)m * 1024 + c];
        if (!(fabsf(got - ref) <= 0.02f + 0.01f * fabsf(ref))) atomicAdd(counter + 6, 1u); }
}

__global__ void __launch_bounds__(256) dbg_check_ffn_a(const unsigned char* ws, const float* wg, const float* wu, unsigned* counter) {
    const bf16* H = (const bf16*)(ws + WS_H); const bf16* A = (const bf16*)(ws + WS_BIG);
    const int m = (blockIdx.x * 277 + 13) & (M - 1);
    __shared__ float hrow[1024];
    for (int i = threadIdx.x; i < 1024; i += 256) hrow[i] = dbg_bf(H[(size_t)m * 1024 + i]);
    __syncthreads();
    for (int c = threadIdx.x; c < D_FF; c += 256) { float zg = 0.f, zu = 0.f;
        _Pragma("unroll 4") for (int k2 = 0; k2 < 1024; ++k2) { zg += hrow[k2] * wg[(size_t)k2 * D_FF + c]; zu += hrow[k2] * wu[(size_t)k2 * D_FF + c]; }
        const float ref = zg / (1.f + expf(-zg)) * zu, got = dbg_bf(A[(size_t)m * D_FF + c]);
        if (!(fabsf(got - ref) <= 0.04f + 0.03f * fabsf(ref))) { atomicAdd(counter + 10, 1u); if (atomicAdd(counter + 320 + blockIdx.x, 1u) == 0u) atomicAdd(counter + 11, 1u); } }
}
__global__ void dbg_report2(float* out, const unsigned* counter) {
    if (counter[10]) { int d1 = 0; unsigned v = counter[11]; while (v) { v >>= 1; ++d1; } if (d1 > 9) d1 = 9;
        int d2 = 0; v = counter[10]; while (v > 1) { v >>= 1; ++d2; } d2 = d2 / 2; if (d2 > 9) d2 = 9;
        out[9] += (float)(d1 * 10 + d2) * 1e12f; }
    if (counter[4]) { int d1 = 0; unsigned v = counter[8]; while (v) { v >>= 1; ++d1; } if (d1 > 9) d1 = 9;
        int d2 = 0; v = counter[4]; while (v > 1) { v >>= 1; ++d2; } d2 = d2 / 2; if (d2 > 9) d2 = 9;
        out[7] += (float)(d1 * 10 + d2) * 1e9f; out[8] += (float)counter[9] * 1e7f; }
    const float code[7] = {1e2f, 1e3f, 1e4f, 1e8f, 1e7f, 1e6f, 1e5f};
    for (int j = 0; j < 7; ++j) { const unsigned m = counter[j]; if (m == 0) continue;
        int lgv = 0; unsigned v = m; while (v > 1) { v >>= 1; ++lgv; } if (lgv > 8) lgv = 8;
        out[j] += code[j] * (float)(1 + lgv); }
}
#endif
extern "C" void kernel_launch(void* const* d_in, const int* in_sizes, int n_in, void* d_out, int out_size, void* d_ws, size_t ws_size, hipStream_t stream) {
    static int grid = 0;
    if (grid == 0) {
        if (n_in != 22 || in_sizes[0] != M * D_MODEL || out_size != M * D_MODEL || ws_size < WS_END) {
            fprintf(stderr, "kernel_launch: unexpected shapes: n_in %d in0 %d out %d ws %zu (need %zu)\n", n_in, n_in > 0 ? in_sizes[0] : -1, out_size, ws_size, (size_t)WS_END); grid = -1; return; }
        int dev = 0, cus = 0, per_cu = 0;
        if (hipGetDevice(&dev) != hipSuccess || hipDeviceGetAttribute(&cus, hipDeviceAttributeMultiprocessorCount, dev) != hipSuccess) { grid = -1; return; }
        if (hipFuncSetAttribute((const void*)fwd_mega, hipFuncAttributeMaxDynamicSharedMemorySize, LDS_BYTES) != hipSuccess) { fprintf(stderr, "kernel_launch: hipFuncSetAttribute failed\n"); grid = -1; return; }
        if (hipOccupancyMaxActiveBlocksPerMultiprocessor(&per_cu, (const void*)fwd_mega, NWAVES * 64, LDS_BYTES) != hipSuccess || per_cu < 1) {
            fprintf(stderr, "kernel_launch: occupancy query reports %d blocks per CU; nothing launched\n", per_cu); (void)hipGetLastError(); grid = -1; return; }
        (void)hipGetLastError();
        if (cus != 256) { fprintf(stderr, "kernel_launch: built for a 256-CU device, found %d CUs; nothing launched\n", cus); grid = -1; return; }
        grid = cus;
        if (grid != 256) fprintf(stderr, "kernel_launch: note: %d CUs\n", grid);
    }
    if (grid < 0) return;
    if (hipMemsetAsync((char*)d_ws + WS_CTL, 0, CTL_ZERO_BYTES, stream) != hipSuccess) return;
    Args a{};
    for (int i = 0; i < 22; ++i) a.in[i] = (const float*)d_in[i];
    a.out = (float*)d_out; a.ws = (unsigned char*)d_ws;
    for (int li = 0; li < N_LAUNCHES; ++li) {
#ifdef PROBE_SKIP_LO
        if (li >= PROBE_SKIP_LO && li <= PROBE_SKIP_HI) continue;
#endif
        a.ph_lo = (N_LAUNCHES == 1) ? 0 : li; a.ph_hi = (N_LAUNCHES == 1) ? N_PHASES : li + 1; a.li = li;
        hipLaunchKernelGGL(fwd_mega, dim3(grid), dim3(NWAVES * 64), LDS_BYTES, stream, a);
        const hipError_t le = hipPeekAtLastError();
        if (le != hipSuccess) { fprintf(stderr, "kernel_launch: launch %d failed: %s\n", li, hipGetErrorName(le)); break; }
#ifdef DBG_CHECK_ATT
        if (li == 6) { hipLaunchKernelGGL(dbg_save_q, dim3(4096), dim3(64), 0, stream, (const unsigned char*)d_ws, (float*)((char*)d_ws + 210 * MiB));
                       hipLaunchKernelGGL(dbg_check_proj, dim3(128), dim3(256), 0, stream, (const unsigned char*)d_ws, (const float*)d_in[9], (unsigned*)d_ws + 16); }
        if (li == 2) hipLaunchKernelGGL(dbg_check_ffn_a, dim3(256), dim3(256), 0, stream, (const unsigned char*)d_ws, (const float*)d_in[5], (const float*)d_in[6], (unsigned*)d_ws + 16);
        if (li == 6) hipLaunchKernelGGL(dbg_check_qkv, dim3(256), dim3(256), 0, stream, (const unsigned char*)d_ws, (const float*)d_in[9], (unsigned*)d_ws + 16);
        if (li == 8) hipLaunchKernelGGL(dbg_check_gate, dim3(256), dim3(256), 0, stream, (const unsigned char*)d_ws, (const float*)d_in[9], (unsigned*)d_ws + 16);
        if (li == 9) { hipLaunchKernelGGL(dbg_check_merge, dim3(256), dim3(256), 0, stream, (const unsigned char*)d_ws, (const float*)d_in[15], (const float*)d_in[16], (unsigned*)d_ws + 16);
                       hipLaunchKernelGGL(dbg_save_out, dim3(256), dim3(256), 0, stream, (const float*)d_out, (float*)((char*)d_ws + 212 * MiB)); }
        if (li == 10) hipLaunchKernelGGL(dbg_check_out, dim3(256), dim3(256), 0, stream, (const unsigned char*)d_ws, (const float*)d_out, (const float*)((char*)d_ws + 212 * MiB), (const float*)d_in[17], (unsigned*)d_ws + 16);
        if (li == 7) hipLaunchKernelGGL(dbg_check_att, dim3(4096), dim3(256), 0, stream, (const unsigned char*)d_ws, (const float*)((char*)d_ws + 210 * MiB), (unsigned*)d_ws + 16);
#endif
#ifdef DBG_CHECK_MASK
        if (li == 6) hipLaunchKernelGGL(dbg_check_mask, dim3(1024), dim3(512), 0, stream, (const unsigned char*)d_ws, (unsigned*)d_ws + 8);
#endif
    }
#ifdef DBG_CHECK_ATT
    hipLaunchKernelGGL(dbg_report2, dim3(1), dim3(1), 0, stream, (float*)d_out, (const unsigned*)d_ws + 16);
#endif
#ifdef DBG_CHECK_MASK
    hipLaunchKernelGGL(dbg_report, dim3(1), dim3(1), 0, stream, (float*)d_out, (const unsigned*)d_ws + 8);
#endif
}
```

```cpp
#include <hip/hip_runtime.h>
#include <cstdio>
#include <cstdint>
#include <cmath>
#ifndef MK_N_LAUNCHES
#define MK_N_LAUNCHES 1
#endif
__device__ __forceinline__ int mk_lane() { int l; asm volatile("v_mbcnt_lo_u32_b32 %0, -1, 0\n\tv_mbcnt_hi_u32_b32 %0, -1, %0" : "=v"(l)); return l; }
namespace pg8 {
#define PG8_LAS __attribute__((address_space(3)))
typedef unsigned short bf16_t;
typedef short bf16x8 __attribute__((ext_vector_type(8)));
typedef float f32x4 __attribute__((ext_vector_type(4)));
typedef unsigned u32x4 __attribute__((ext_vector_type(4)));
typedef int v4i_t __attribute__((ext_vector_type(4)));
typedef int v8i_t __attribute__((ext_vector_type(8)));
typedef unsigned u32x2 __attribute__((ext_vector_type(2)));
constexpr int BM = 256, BK = 64, HALF = 128, HTB = HALF * BK * 2  , STAGE_BYTES = 8 * HTB, NXCD = 8, WGM = 8;

__host__ __device__ __forceinline__ int lds_byte(int r, int c) { const int st = (r >> 4) * 2 + (c >> 5), rr = r & 15, cc = c & 31, ob = rr * 64 + cc * 2; return st * 1024 + (ob ^ (((ob >> 9) & 1) << 5)); }
__host__ __device__ __forceinline__ void stage_rc(int b, int& R, int& C) { const int st = b / 1024, sb = b % 1024, swz = sb ^ (((sb >> 9) & 1) << 5); R = (st >> 1) * 16 + swz / 64; C = (st & 1) * 32 + (swz % 64) / 2; }
__host__ __device__ __forceinline__ int perm32(int rho) { const int n = rho >> 4, i = rho & 15; return 8 * (i >> 2) + 4 * n + (i & 3); }

struct Unit { int pm, pn; };
struct Gemm { const bf16_t* A; const bf16_t* Bt; int M, N, K; };

struct StaticOrder {
    int nM, nN, nwg, G, c;
    __host__ __device__ void init(int M, int N, int G_, int c_) { nM = M / BM; nN = N / BM; nwg = nM * nN; G = G_; c = c_; }
    __host__ __device__ bool next(int i, Unit& u) const {
        const long L = (long)i * G + c; if (L >= nwg) return false;
        int wgid = (int)L; { const int q = nwg / NXCD, r = nwg % NXCD, xcd = wgid % NXCD, off = wgid / NXCD; wgid = (xcd < r ? xcd * (q + 1) : r * (q + 1) + (xcd - r) * q) + off; }
        const int nig = WGM * nN, gid = wgid / nig, fm = gid * WGM, gsz = (nM - fm) < WGM ? (nM - fm) : WGM;
        u.pm = fm + ((wgid % nig) % gsz); u.pn = (wgid % nig) / gsz; return true;
    }
    __device__ __forceinline__ void a_ready(const Unit&) const {}
    __device__ __forceinline__ void done(const Unit&) const {}
};

typedef float f32x2c_t __attribute__((ext_vector_type(2))); typedef __bf16 bf16x2c_t __attribute__((ext_vector_type(2)));
__device__ __forceinline__ unsigned cvt_pk_bf16(float lo, float hi) { f32x2c_t v = {lo, hi}; bf16x2c_t b = __builtin_convertvector(v, bf16x2c_t); return __builtin_bit_cast(unsigned, b); }
typedef float f32x2 __attribute__((ext_vector_type(2)));
__device__ __forceinline__ float sigmoidf_fast(float v) { return __builtin_amdgcn_rcpf(1.f + __builtin_amdgcn_exp2f(-1.4426950408889634f * v)); }
__device__ __forceinline__ float bf_lo(unsigned w) { return __builtin_bit_cast(float, w << 16); }
__device__ __forceinline__ float bf_hi(unsigned w) { return __builtin_bit_cast(float, w & 0xffff0000u); }
__device__ __forceinline__ unsigned pk4_fp8(float a, float b, float c, float d) { unsigned w = 0u; w = __builtin_amdgcn_cvt_pk_fp8_f32(a, b, w, false); w = __builtin_amdgcn_cvt_pk_fp8_f32(c, d, w, true); return w; }

struct EpiSwiglu {
    static constexpr bool PERM = true, AFTER_DRAIN = false;
    bf16_t* O; int ldc;
    __device__ __forceinline__ void operator()(const f32x4 (&acc)[2][2][4][2], const Unit& u, int wr, int wc, int fr, int fq) const {
        const int row0 = u.pm * BM + wr * 64 + fr, col0 = u.pn * HALF + wc * 32 + 8 * fq;
#pragma unroll
        for (int ai = 0; ai < 2; ++ai)
#pragma unroll
            for (int m = 0; m < 4; ++m) { bf16_t* rowp = O + (size_t)(row0 + ai * HALF + m * 16) * ldc + col0;
                f32x4 v[2];
#pragma unroll
                for (int n = 0; n < 2; ++n) { const f32x4 g = acc[ai][0][m][n], up = acc[ai][1][m][n];
#pragma unroll
                    for (int e = 0; e < 4; ++e) v[n][e] = g[e] * sigmoidf_fast(g[e]) * up[e]; }
                u32x4 w; w.x = cvt_pk_bf16(v[0][0], v[0][1]); w.y = cvt_pk_bf16(v[0][2], v[0][3]); w.z = cvt_pk_bf16(v[1][0], v[1][1]); w.w = cvt_pk_bf16(v[1][2], v[1][3]);
                *(u32x4*)rowp = w; }
    }
};


struct EpiSwiglu8 {
    static constexpr bool PERM = true, AFTER_DRAIN = false;
    unsigned char* O; int ldc; float wscale;
    __device__ __forceinline__ void operator()(const f32x4 (&acc)[2][2][4][2], const Unit& u, int wr, int wc, int fr, int fq) const {
        asm volatile("" : "+v"(fr), "+v"(fq));
        const int row0 = u.pm * BM + wr * 64 + fr, col0 = u.pn * HALF + wc * 32 + 8 * fq;
#pragma unroll
        for (int ai = 0; ai < 2; ++ai)
#pragma unroll
            for (int m = 0; m < 4; ++m) { asm volatile("" ::: "memory"); unsigned char* rowp = O + (size_t)(row0 + ai * HALF + m * 16) * ldc + col0;
                f32x4 v[2];
#pragma unroll
                for (int n = 0; n < 2; ++n) { const f32x4 g = acc[ai][0][m][n] * wscale, up = acc[ai][1][m][n] * wscale;
#pragma unroll
                    for (int e = 0; e < 4; ++e) v[n][e] = g[e] * sigmoidf_fast(g[e]) * up[e]; }
                u32x2 w; w.x = pk4_fp8(v[0][0], v[0][1], v[0][2], v[0][3]); w.y = pk4_fp8(v[1][0], v[1][1], v[1][2], v[1][3]);
                *(u32x2*)rowp = w; }
    }
};

template <bool IN16, bool OUT16> struct EpiResidT {
    static constexpr bool PERM = false, AFTER_DRAIN = false;
    const void* base; void* out; const float* gate; float coef;
    __device__ __forceinline__ void operator()(const f32x4 (&acc)[2][2][4][2], const Unit& u, int wr, int wc, int fr, int fq) const {
        asm volatile("" : "+v"(fr), "+v"(fq));
        const int row0 = u.pm * BM + wr * 64 + fr, col0 = u.pn * BM + wc * 32 + 4 * fq;
        const float* gp = gate + (size_t)(u.pm / 32) * 9216 + col0;
        f32x4 gv[2][2];
#pragma unroll
        for (int bj = 0; bj < 2; ++bj)
#pragma unroll
            for (int n = 0; n < 2; ++n) gv[bj][n] = *(const f32x4*)(gp + bj * HALF + n * 16) * coef;
#pragma unroll
        for (int ai = 0; ai < 2; ++ai)
#pragma unroll
            for (int m = 0; m < 4; ++m) { asm volatile("" ::: "memory"); const size_t off = (size_t)(row0 + ai * HALF + m * 16) * 1024 + col0;
#pragma unroll
                for (int bj = 0; bj < 2; ++bj)
#pragma unroll
                    for (int n = 0; n < 2; ++n) { const size_t o2 = off + bj * HALF + n * 16; f32x4 bs;
                        if constexpr (IN16) { const u32x2 r = *(const u32x2*)((const bf16_t*)base + o2);
                            bs.x = __builtin_bit_cast(float, r.x << 16); bs.y = __builtin_bit_cast(float, r.x & 0xffff0000u); bs.z = __builtin_bit_cast(float, r.y << 16); bs.w = __builtin_bit_cast(float, r.y & 0xffff0000u); }
                        else bs = *(const f32x4*)((const float*)base + o2);
                        const f32x4 y = bs + gv[bj][n] * acc[ai][bj][m][n];
                        if constexpr (OUT16) { u32x2 w; w.x = cvt_pk_bf16(y.x, y.y); w.y = cvt_pk_bf16(y.z, y.w); *(u32x2*)((bf16_t*)out + o2) = w; }
                        else {
#ifdef PROBE_ROUND16
                            const unsigned w0 = cvt_pk_bf16(y.x, y.y), w1 = cvt_pk_bf16(y.z, y.w); f32x4 yr; yr.x = __builtin_bit_cast(float, w0 << 16); yr.y = __builtin_bit_cast(float, w0 & 0xffff0000u); yr.z = __builtin_bit_cast(float, w1 << 16); yr.w = __builtin_bit_cast(float, w1 & 0xffff0000u);
                            *(f32x4*)((float*)out + o2) = yr;
#else
                            *(f32x4*)((float*)out + o2) = y;
#endif
                        } } }
    }
};

struct EpiGate {
    static constexpr bool PERM = true, AFTER_DRAIN = false;
    bf16_t* O; float wscale;
    __device__ __forceinline__ void operator()(const f32x4 (&acc)[2][2][4][2], const Unit& u, int wr, int wc, int fr, int fq) const {
        const int row0 = u.pm * BM + wr * 64 + fr, col0 = u.pn * BM + wc * 32 + 8 * fq;
#pragma unroll
        for (int ai = 0; ai < 2; ++ai)
#pragma unroll
            for (int m = 0; m < 4; ++m) { bf16_t* rowp = O + (size_t)(row0 + ai * HALF + m * 16) * 2048 + col0;
#pragma unroll
                for (int bj = 0; bj < 2; ++bj) { f32x4 v0 = acc[ai][bj][m][0], v1 = acc[ai][bj][m][1];
#pragma unroll
                    for (int e = 0; e < 4; ++e) { v0[e] = sigmoidf_fast(v0[e] * wscale); v1[e] = sigmoidf_fast(v1[e] * wscale); }
                    u32x4 w; w.x = cvt_pk_bf16(v0[0], v0[1]); w.y = cvt_pk_bf16(v0[2], v0[3]); w.z = cvt_pk_bf16(v1[0], v1[1]); w.w = cvt_pk_bf16(v1[2], v1[3]);
                    *(u32x4*)(rowp + bj * HALF) = w; } }
    }
};

struct EpiMerge {
    static constexpr bool PERM = true, AFTER_DRAIN = false;
    const bf16_t* SG; unsigned char* O; float wscale;
    __device__ __forceinline__ void operator()(const f32x4 (&acc)[2][2][4][2], const Unit& u, int wr, int wc, int fr, int fq) const {
        const int row0 = u.pm * BM + wr * 64 + fr, col0 = u.pn * HALF + wc * 32 + 8 * fq;
#pragma unroll
        for (int ai = 0; ai < 2; ++ai)
#pragma unroll
            for (int m = 0; m < 4; ++m) { const size_t r = (size_t)(row0 + ai * HALF + m * 16);
                const u32x4 ga = *(const u32x4*)(SG + r * 2048 + col0), gb = *(const u32x4*)(SG + r * 2048 + 1024 + col0);
                const f32x4 a0 = acc[ai][0][m][0], a1 = acc[ai][0][m][1], b0 = acc[ai][1][m][0], b1 = acc[ai][1][m][1];
                const float ws_ = wscale; u32x2 w;
                w.x = pk4_fp8((bf_lo(ga.x) * a0[0] + bf_lo(gb.x) * b0[0]) * ws_, (bf_hi(ga.x) * a0[1] + bf_hi(gb.x) * b0[1]) * ws_, (bf_lo(ga.y) * a0[2] + bf_lo(gb.y) * b0[2]) * ws_, (bf_hi(ga.y) * a0[3] + bf_hi(gb.y) * b0[3]) * ws_);
                w.y = pk4_fp8((bf_lo(ga.z) * a1[0] + bf_lo(gb.z) * b1[0]) * ws_, (bf_hi(ga.z) * a1[1] + bf_hi(gb.z) * b1[1]) * ws_, (bf_lo(ga.w) * a1[2] + bf_lo(gb.w) * b1[2]) * ws_, (bf_hi(ga.w) * a1[3] + bf_hi(gb.w) * b1[3]) * ws_);
                *(u32x2*)(O + r * 1024 + col0) = w; }
    }
};

struct EpiInA {
    static constexpr bool PERM = true, AFTER_DRAIN = false;
    bf16_t *QKV; bf16_t *QI, *KI; float *WI, *LF;
    const float *gains;
    int pn0; float wscale;
    __device__ __forceinline__ void operator()(const f32x4 (&acc0)[2][2][4][2], const Unit& u, int wr, int wc, int fr, int fq) const {
        const int row0 = u.pm * BM + wr * 64 + fr, pn = u.pn + pn0;
        const float ws_ = wscale;
#define acc(AI, BJ, MM, NN) (acc0[AI][BJ][MM][NN] * ws_)
        const int sec = pn >> 1;
        if (sec == 0 || sec == 1 || sec == 3 || sec == 4) {
            const bool isq = (sec == 0 || sec == 3), isfox = (sec >= 3);
            const float* gain = gains + 64 * (sec - (isfox ? 1 : 0));
            bf16_t* dst = QKV + (isq ? (size_t)0 : (size_t)16777216) + (isfox ? 512 : 0) + ((pn & 1) * 4 + wc) * 64 + 8 * fq;
            const float post = isq ? 0.125f * 1.4426950408889634f : 1.0f;
            f32x4 gv[2][2];
#pragma unroll
            for (int bj = 0; bj < 2; ++bj)
#pragma unroll
                for (int n = 0; n < 2; ++n) gv[bj][n] = *(const f32x4*)(gain + 32 * bj + 8 * fq + 4 * n) * post;
#pragma unroll
            for (int ai = 0; ai < 2; ++ai)
#pragma unroll
                for (int m = 0; m < 4; ++m) {
                    float ss = 0.f;
#pragma unroll
                    for (int bj = 0; bj < 2; ++bj)
#pragma unroll
                        for (int n = 0; n < 2; ++n) { const f32x4 x = acc(ai, bj, m, n); ss += (x[0] * x[0] + x[1] * x[1]) + (x[2] * x[2] + x[3] * x[3]); }
                    ss += __shfl_xor(ss, 16); ss += __shfl_xor(ss, 32);
                    const float rstd = __builtin_amdgcn_rsqf(ss * (1.0f / 64.0f) + 1e-6f);
                    bf16_t* rowp = dst + (size_t)(row0 + ai * HALF + m * 16) * 1024;
#pragma unroll
                    for (int bj = 0; bj < 2; ++bj) { const f32x4 v0 = acc(ai, bj, m, 0) * rstd * gv[bj][0], v1 = acc(ai, bj, m, 1) * rstd * gv[bj][1];
                        u32x4 w; w.x = cvt_pk_bf16(v0[0], v0[1]); w.y = cvt_pk_bf16(v0[2], v0[3]); w.z = cvt_pk_bf16(v1[0], v1[1]); w.w = cvt_pk_bf16(v1[2], v1[3]);
                        *(u32x4*)(rowp + 32 * bj) = w; } }
        } else if (sec == 2 || sec == 5 || sec == 6) {
            bf16_t* dst; int ld; float sc = 1.f;
            if (sec == 6) { dst = QI + (pn & 1) * 256; ld = 512; sc = 0.125f; } else { dst = QKV + (size_t)33554432 + (sec == 5 ? 512 : 0) + (pn & 1) * 256; ld = 1024; }
            dst += wc * 32 + 8 * fq;
#pragma unroll
            for (int ai = 0; ai < 2; ++ai)
#pragma unroll
                for (int m = 0; m < 4; ++m) { bf16_t* rowp = dst + (size_t)(row0 + ai * HALF + m * 16) * ld;
#pragma unroll
                    for (int bj = 0; bj < 2; ++bj) { const f32x4 v0 = acc(ai, bj, m, 0) * sc, v1 = acc(ai, bj, m, 1) * sc;
                        u32x4 w; w.x = cvt_pk_bf16(v0[0], v0[1]); w.y = cvt_pk_bf16(v0[2], v0[3]); w.z = cvt_pk_bf16(v1[0], v1[1]); w.w = cvt_pk_bf16(v1[2], v1[3]);
                        *(u32x4*)(rowp + bj * HALF) = w; } }
        } else {
            if (wc < 2) {
#pragma unroll
                for (int ai = 0; ai < 2; ++ai)
#pragma unroll
                    for (int m = 0; m < 4; ++m) { const f32x4 v0 = acc(ai, 0, m, 0), v1 = acc(ai, 0, m, 1);
                        u32x4 w; w.x = cvt_pk_bf16(v0[0], v0[1]); w.y = cvt_pk_bf16(v0[2], v0[3]); w.z = cvt_pk_bf16(v1[0], v1[1]); w.w = cvt_pk_bf16(v1[2], v1[3]);
                        const int row = row0 + ai * HALF + m * 16;
                        *(u32x4*)(KI + (size_t)(row >> 5) * 2048 + ((4 * wc + fq) * 32 + (row & 31)) * 8) = w; }
            } else if (wc == 2 && fq == 0) {
#pragma unroll
                for (int ai = 0; ai < 2; ++ai)
#pragma unroll
                    for (int m = 0; m < 4; ++m) { float* p = WI + (size_t)(row0 + ai * HALF + m * 16) * 8;
                        *(f32x4*)p = acc(ai, 0, m, 0) * 0.35355339059327373f; *(f32x4*)(p + 4) = acc(ai, 0, m, 1) * 0.35355339059327373f; }
            } else if (wc == 2 && fq == 1) {
                const f32x4 bf0 = *(const f32x4*)(gains + 256), bf1 = *(const f32x4*)(gains + 260);
#pragma unroll
                for (int ai = 0; ai < 2; ++ai)
#pragma unroll
                    for (int m = 0; m < 4; ++m) { const int row = row0 + ai * HALF + m * 16; float* p = LF + (size_t)(row >> 13) * 65536 + (row & 8191);
#pragma unroll
                        for (int n = 0; n < 2; ++n)
#pragma unroll
                            for (int e = 0; e < 4; ++e) { const float x = acc(ai, 0, m, n)[e] + (n ? bf1[e] : bf0[e]);
                                const float ls = fminf(x, 0.f) - __logf(1.f + __expf(-fabsf(x)));
                                p[(size_t)(4 * n + e) * 8192] = ls; } }
            }
        }
#undef acc
    }
};
template <class Epi, class Sched, bool ALIGN_EPI = false, bool SP2 = false, bool F8 = false>
__device__ __forceinline__ void gemm_phase(PG8_LAS unsigned char* lds, const Gemm g, const Sched& S, const Epi& E, const int wave_in) {
    const int lane = mk_lane(), wid = __builtin_amdgcn_readfirstlane(wave_in), tid = wid * 64 + lane, wr = wid >> 2, wc = wid & 3, fr = lane & 15, fq = lane >> 4;
    const int K = g.K, nt = K / BK;
    unsigned voffA[2], voffB[2];
#pragma unroll
    for (int i = 0; i < 2; ++i) { int R, C; stage_rc(tid * 16 + i * 8192, R, C); const int Rb = Epi::PERM ? ((R & ~31) + perm32(R & 31)) : R;
        voffA[i] = (unsigned)(R * K + C) * 2u; voffB[i] = (unsigned)(Rb * K + C) * 2u; }
    const size_t kstep = (size_t)(BK * 2);
    const size_t hstep = (size_t)HALF * K * 2;
    const size_t tstep = 2 * hstep;
    const unsigned ldsw = (unsigned)wid * 1024u;
    const int aoff = lds_byte(wr * 64 + fr, fq * 8), boff = lds_byte(wc * 32 + fr, fq * 8);
    const int aoff8 = lds_byte(wr * 64 + fr, fq * 16), boff8 = lds_byte(wc * 32 + fr, fq * 16);
#define PG8_SA(b, h) (((b) * 2 + (h)) * HTB)
#define PG8_SB(b, h) ((4 + (b) * 2 + (h)) * HTB)
#define PG8_STAGE(bufoff, gbase, voff) do { _Pragma("unroll") for (int _i = 0; _i < 2; ++_i) \
        __builtin_amdgcn_global_load_lds((const unsigned*)((const char*)(gbase) + (voff)[_i]), (PG8_LAS unsigned*)(lds + (bufoff) + ldsw + _i * 8192), 16, 0, 0); } while (0)
#define PG8_LD2(base_) __builtin_shufflevector(*(const PG8_LAS v4i_t*)(base_), *(const PG8_LAS v4i_t*)((base_) + 1024), 0, 1, 2, 3, 4, 5, 6, 7)
#define PG8_LDA(dst, b, h) do { if constexpr (F8) { _Pragma("unroll") for (int m = 0; m < 4; ++m) dst##8[m] = PG8_LD2(lds + PG8_SA(b, h) + aoff + m * 2048); } \
        else { _Pragma("unroll") for (int m = 0; m < 4; ++m) _Pragma("unroll") for (int k = 0; k < 2; ++k) dst[m][k] = *(const PG8_LAS bf16x8*)(lds + PG8_SA(b, h) + aoff + m * 2048 + k * 1024); } } while (0)
#define PG8_LDB(dst, b, h) do { if constexpr (F8) { _Pragma("unroll") for (int n = 0; n < 2; ++n) dst##8[n] = PG8_LD2(lds + PG8_SB(b, h) + boff + n * 2048); } \
        else { _Pragma("unroll") for (int n = 0; n < 2; ++n) _Pragma("unroll") for (int k = 0; k < 2; ++k) dst[n][k] = *(const PG8_LAS bf16x8*)(lds + PG8_SB(b, h) + boff + n * 2048 + k * 1024); } } while (0)
#define PG8_CAT8(x0, x1) __builtin_shufflevector(__builtin_bit_cast(v4i_t, x0), __builtin_bit_cast(v4i_t, x1), 0, 1, 2, 3, 4, 5, 6, 7)
#define PG8_MMA(ai, bj, At, Bt) do { __builtin_amdgcn_s_setprio(1); \
        if constexpr (F8) { _Pragma("unroll") for (int m = 0; m < 4; ++m) _Pragma("unroll") for (int n = 0; n < 2; ++n) \
            asm volatile("v_mfma_scale_f32_16x16x128_f8f6f4 %0, %1, %2, %0, %3, %3 op_sel_hi:[0,0,0]" : "+v"(acc[ai][bj][m][n]) : "v"(Bt##8[n]), "v"(At##8[m]), "v"(sc1)); } \
        else { _Pragma("unroll") for (int m = 0; m < 4; ++m) _Pragma("unroll") for (int n = 0; n < 2; ++n) _Pragma("unroll") for (int k = 0; k < 2; ++k) \
            acc[ai][bj][m][n] = __builtin_amdgcn_mfma_f32_16x16x32_bf16(Bt[n][k], At[m][k], acc[ai][bj][m][n], 0, 0, 0); } \
        __builtin_amdgcn_s_setprio(0); } while (0)
#define PG8_WAIT_V(n) asm volatile("s_waitcnt vmcnt(" #n ")" ::: "memory")
#define PG8_WAIT_L(n) asm volatile("s_waitcnt lgkmcnt(" #n ")" ::: "memory")
#define PG8_BAR __builtin_amdgcn_s_barrier()
#define PG8_SCHED __builtin_amdgcn_sched_barrier(0)
    Unit cur, nxt; int ui = 0;
    if (!S.next(0, cur)) return;
    f32x4 acc[2][2][4][2];
#pragma unroll
    for (int a = 0; a < 2; ++a)
#pragma unroll
        for (int b = 0; b < 2; ++b)
#pragma unroll
            for (int m = 0; m < 4; ++m)
#pragma unroll
                for (int n = 0; n < 2; ++n) { acc[a][b][m][n] = (f32x4){0.f, 0.f, 0.f, 0.f}; }
    bf16x8 At[4][2], B0[2][2], B1[2][2]; v8i_t At8[4], B08[2], B18[2];
    int sc1 = 0x7F7F7F7F; asm volatile("" : "+v"(sc1));
    const char* cA = (const char*)g.A + (size_t)cur.pm * tstep; const char* cB = (const char*)g.Bt + (size_t)cur.pn * tstep;
    S.a_ready(cur);
    if constexpr (SP2) {
        PG8_STAGE(PG8_SB(0, 0), cB, voffB); PG8_STAGE(PG8_SB(0, 1), cB + hstep, voffB); PG8_STAGE(PG8_SA(0, 0), cA, voffA); PG8_STAGE(PG8_SA(0, 1), cA + hstep, voffA);
        if (wr == 1) PG8_BAR;
        PG8_WAIT_V(2); PG8_BAR;
        PG8_STAGE(PG8_SB(1, 0), cB + kstep, voffB); PG8_STAGE(PG8_SA(1, 0), cA + kstep, voffA); PG8_STAGE(PG8_SB(1, 1), cB + hstep + kstep, voffB);
        PG8_WAIT_V(6); PG8_BAR;
    } else {
        PG8_STAGE(PG8_SB(0, 0), cB, voffB); PG8_STAGE(PG8_SA(0, 0), cA, voffA); PG8_STAGE(PG8_SB(0, 1), cB + hstep, voffB); PG8_STAGE(PG8_SA(0, 1), cA + hstep, voffA);
        if (wr == 1) PG8_BAR;
        PG8_WAIT_V(4); PG8_BAR;
        PG8_STAGE(PG8_SB(1, 0), cB + kstep, voffB); PG8_STAGE(PG8_SA(1, 0), cA + kstep, voffA); PG8_STAGE(PG8_SB(1, 1), cB + hstep + kstep, voffB);
        PG8_WAIT_V(6); PG8_BAR;
    }
    for (;;) {
        const bool has_next = S.next(ui + 1, nxt);
        const char* nA = has_next ? (const char*)g.A + (size_t)nxt.pm * tstep : cA; const char* nB = has_next ? (const char*)g.Bt + (size_t)nxt.pn * tstep : cB;
#pragma unroll 1
        for (int t = 0; t < nt; t += 2) {
            const bool last = (t == nt - 2);
            const char* a1 = cA + (size_t)(t + 1) * kstep;
            const char* a2 = last ? nA : cA + (size_t)(t + 2) * kstep; const char* b2 = last ? nB : cB + (size_t)(t + 2) * kstep;
            const char* a3 = a2 + kstep; const char* b3 = b2 + kstep;
            if (last && has_next) S.a_ready(nxt);
            if constexpr (SP2) {
            PG8_LDB(B0, 0, 0); PG8_LDB(B1, 0, 1); PG8_SCHED; PG8_LDA(At, 0, 0); PG8_STAGE(PG8_SA(1, 1), a1 + hstep, voffA);
            PG8_WAIT_V(8); PG8_WAIT_L(0); PG8_BAR; PG8_MMA(0, 0, At, B0); PG8_MMA(0, 1, At, B1); PG8_BAR; PG8_SCHED;
            PG8_LDA(At, 0, 1); PG8_STAGE(PG8_SB(0, 0), b2, voffB); PG8_STAGE(PG8_SB(0, 1), b2 + hstep, voffB); PG8_STAGE(PG8_SA(0, 0), a2, voffA);
            PG8_WAIT_V(8); PG8_WAIT_L(0); PG8_BAR; PG8_MMA(1, 0, At, B0); PG8_MMA(1, 1, At, B1); PG8_BAR; PG8_SCHED;
            PG8_LDB(B0, 1, 0); PG8_LDB(B1, 1, 1); PG8_SCHED; PG8_LDA(At, 1, 0); PG8_STAGE(PG8_SA(0, 1), a2 + hstep, voffA);
            PG8_WAIT_V(8); PG8_WAIT_L(0); PG8_BAR; PG8_MMA(0, 0, At, B0); PG8_MMA(0, 1, At, B1); PG8_BAR; PG8_SCHED;
            PG8_LDA(At, 1, 1); PG8_STAGE(PG8_SB(1, 0), b3, voffB); PG8_STAGE(PG8_SB(1, 1), b3 + hstep, voffB); PG8_STAGE(PG8_SA(1, 0), a3, voffA);
            PG8_WAIT_V(8); PG8_WAIT_L(0); PG8_BAR; PG8_MMA(1, 0, At, B0); PG8_MMA(1, 1, At, B1); PG8_BAR; PG8_SCHED;
            } else {
            PG8_LDB(B0, 0, 0); PG8_SCHED; PG8_LDA(At, 0, 0); PG8_STAGE(PG8_SA(1, 1), a1 + hstep, voffA);
            PG8_WAIT_L(8); PG8_BAR; PG8_WAIT_L(0); PG8_MMA(0, 0, At, B0); PG8_BAR; PG8_SCHED;
            PG8_LDB(B1, 0, 1); PG8_STAGE(PG8_SB(0, 0), b2, voffB);
            PG8_BAR; PG8_WAIT_L(0); PG8_MMA(0, 1, At, B1); PG8_BAR;
            PG8_LDA(At, 0, 1); PG8_STAGE(PG8_SA(0, 0), a2, voffA);
            PG8_BAR; PG8_WAIT_L(0); PG8_MMA(1, 0, At, B0); PG8_BAR; PG8_SCHED;
            PG8_STAGE(PG8_SB(0, 1), b2 + hstep, voffB);
            PG8_WAIT_V(6); PG8_BAR; PG8_MMA(1, 1, At, B1); PG8_BAR;
            PG8_LDB(B0, 1, 0); PG8_SCHED; PG8_LDA(At, 1, 0); PG8_STAGE(PG8_SA(0, 1), a2 + hstep, voffA);
            PG8_WAIT_L(8); PG8_BAR; PG8_WAIT_L(0); PG8_MMA(0, 0, At, B0); PG8_BAR; PG8_SCHED;
            PG8_LDB(B1, 1, 1); PG8_STAGE(PG8_SB(1, 0), b3, voffB);
            PG8_BAR; PG8_WAIT_L(0); PG8_MMA(0, 1, At, B1); PG8_BAR;
            PG8_LDA(At, 1, 1); PG8_STAGE(PG8_SA(1, 0), a3, voffA);
            PG8_BAR; PG8_WAIT_L(0); PG8_MMA(1, 0, At, B0); PG8_BAR; PG8_SCHED;
            PG8_STAGE(PG8_SB(1, 1), b3 + hstep, voffB);
            PG8_WAIT_V(6); PG8_BAR; PG8_MMA(1, 1, At, B1); PG8_BAR;
            }
        }
        if constexpr (F8) asm volatile("s_nop 15\n\ts_nop 15" ::: "memory");
        if constexpr (ALIGN_EPI) { if (wr == 0) PG8_BAR; }
        if constexpr (!Epi::AFTER_DRAIN) { E(acc, cur, wr, wc, fr, fq); S.done(cur); }
        if (!has_next) break;
#pragma unroll
        for (int a = 0; a < 2; ++a)
#pragma unroll
            for (int b = 0; b < 2; ++b)
#pragma unroll
                for (int m = 0; m < 4; ++m)
#pragma unroll
                    for (int n = 0; n < 2; ++n) { acc[a][b][m][n] = (f32x4){0.f, 0.f, 0.f, 0.f}; }
        cur = nxt; cA = nA; cB = nB; ++ui;
        if constexpr (ALIGN_EPI) { if (wr == 1) PG8_BAR; }
    }
    PG8_WAIT_V(0);
    if constexpr (!ALIGN_EPI) { if (wr == 0) PG8_BAR; }
    PG8_BAR;
    if constexpr (Epi::AFTER_DRAIN) { E.fused(acc, cur, wr, wc, fr, fq, lds, wid, lane); S.done(cur); }
#undef PG8_SA
#undef PG8_SB
#undef PG8_STAGE
#undef PG8_LD2
#undef PG8_LDA
#undef PG8_LDB
#undef PG8_MMA
#undef PG8_CAT8
#undef PG8_WAIT_V
#undef PG8_WAIT_L
#undef PG8_BAR
#undef PG8_SCHED
}
}
namespace att {
#ifdef PROBE_ZERO_TYPE
#define PROBE_ZF(T) ((T)==PROBE_ZERO_TYPE?0.f:1.f)
#else
#define PROBE_ZF(T) 1.f
#endif
typedef unsigned short bf16_t;
using bf16x8=__attribute__((ext_vector_type(8)))short;
using s16x4=__attribute__((ext_vector_type(4)))short;
using f32x16=__attribute__((ext_vector_type(16)))float;
using f32x4=__attribute__((ext_vector_type(4)))float;
using u32x4=__attribute__((ext_vector_type(4)))unsigned;
constexpr int SEQ=8192,D=64,DM=1024;
constexpr int NW=8,QBLK=32,QB=QBLK*NW,KVBLK=64;
__device__ __forceinline__ int crow(int r,int hi){return (r&3)+8*(r>>2)+4*hi;}
#define SBAR() __builtin_amdgcn_sched_barrier(0)
__device__ __forceinline__ void cmask(f32x16&p0,f32x16&p1,int jb,int qrel,int hi){
  const float NEG=-INFINITY; int kb=64*jb+4*hi;
  #pragma unroll
  for(int r=0;r<16;++r){int kv=kb+(r&3)+8*(r>>2); if(kv>qrel)p0[r]=NEG; if(kv+32>qrel)p1[r]=NEG;}
}
constexpr int SLOTB=8192;
constexpr int RS=6, RD=4;
constexpr int LDS_K=0, LDS_V=RS*SLOTB, LDS_WS=2*RS*SLOTB, LDS_FK=LDS_WS+NW*64*4, LDS_BYTES=LDS_FK+32768+256;
constexpr int LDS_OST=0;
constexpr int LDS_MR=LDS_FK, LDS_FLG=LDS_FK+32768;
__device__ __forceinline__ void glds16(const void*gsrc,unsigned lds_dst){unsigned keep;
  asm volatile("s_mov_b32 %0, m0\n\ts_mov_b32 m0, %2\n\ts_nop 0\n\tglobal_load_lds_dwordx4 %1, off\n\ts_mov_b32 m0, %0":"=&s"(keep):"v"(gsrc),"s"(lds_dst):"memory");}
__device__ __forceinline__ void glds4(const void*gsrc,unsigned lds_dst){unsigned keep;
  asm volatile("s_mov_b32 %0, m0\n\ts_mov_b32 m0, %2\n\ts_nop 0\n\tglobal_load_lds_dword %1, off\n\ts_mov_b32 m0, %0":"=&s"(keep):"v"(gsrc),"s"(lds_dst):"memory");}
__device__ __forceinline__ float max3f(float a,float b,float c){float r;asm("v_max3_f32 %0, %1, %2, %3":"=v"(r):"v"(a),"v"(b),"v"(c));return r;}
__device__ __forceinline__ float max2f(float a,float b){float r;asm("v_max_f32_e32 %0, %1, %2":"=v"(r):"v"(a),"v"(b));return r;}
typedef float f32x2_t __attribute__((ext_vector_type(2))); typedef __bf16 bf16x2_t __attribute__((ext_vector_type(2)));
__device__ __forceinline__ unsigned cvtpk_s(float lo,float hi){f32x2_t v={lo,hi};bf16x2_t b=__builtin_convertvector(v,bf16x2_t);return __builtin_bit_cast(unsigned,b);}
__device__ __forceinline__ void xhalf_pair(float v,float&lo,float&hi_){unsigned a=__builtin_bit_cast(unsigned,v),b=a;
  asm volatile("s_nop 1\n\tv_permlane32_swap_b32 %0, %1\n\ts_nop 1":"+v"(a),"+v"(b)); lo=__builtin_bit_cast(float,a); hi_=__builtin_bit_cast(float,b);}
__device__ __forceinline__ float xhalf_sum(float v){float lo,h;xhalf_pair(v,lo,h);return lo+h;}
__device__ __forceinline__ float xhalf_max(float v){float lo,h;xhalf_pair(v,lo,h);return __builtin_fmaxf(lo,h);}
#define WAIT_ALL_BAR() asm volatile("s_waitcnt vmcnt(0) lgkmcnt(0)\n\ts_barrier":::"memory")

__device__ __forceinline__ void qkt(f32x16&p0,f32x16&p1,const char*Kslot,const bf16x8*qr,const f32x16&cinit,const f32x16&cinit1,int r32,int hi){
  const char*kb=Kslot+hi*1024+r32*16;
  #pragma unroll
  for(int d0=0;d0<4;++d0){
    const bf16x8 b0=*reinterpret_cast<const bf16x8*>(kb+d0*2048);
    const bf16x8 b1=*reinterpret_cast<const bf16x8*>(kb+d0*2048+512);
    if(d0==0){p0=__builtin_amdgcn_mfma_f32_32x32x16_bf16(b0,qr[0],cinit,0,0,0);p1=__builtin_amdgcn_mfma_f32_32x32x16_bf16(b1,qr[0],cinit1,0,0,0);}
    else{p0=__builtin_amdgcn_mfma_f32_32x32x16_bf16(b0,qr[d0],p0,0,0,0);p1=__builtin_amdgcn_mfma_f32_32x32x16_bf16(b1,qr[d0],p1,0,0,0);}}
}
__device__ __forceinline__ float rowmax(const f32x16&p0,const f32x16&p1){
  float a=max3f(p0[0],p0[1],p1[0]),b=max3f(p0[2],p0[3],p1[1]);a=max3f(a,p1[2],p1[3]);
  #pragma unroll
  for(int r=4;r<16;r+=4){a=max3f(a,p0[r],p0[r+1]);b=max3f(b,p0[r+2],p0[r+3]);a=max3f(a,p1[r],p1[r+1]);b=max3f(b,p1[r+2],p1[r+3]);}
  const float m=max2f(a,b);
  return xhalf_max(m);
}
__device__ __forceinline__ void pv(f32x16*o,f32x16&ol,int vb,bf16x8 pa0,bf16x8 pa1,bf16x8 pa2,bf16x8 pa3){
  #pragma unroll
  for(int d0=0;d0<2;++d0){s16x4 lo[4],hi[4];
    #pragma unroll
    for(int ks=0;ks<4;++ks){
      asm volatile("ds_read_b64_tr_b16 %0,%1 offset:%c2":"=&v"(lo[ks]):"v"(vb),"i"(d0*4096+ks*1024):"memory");
      asm volatile("ds_read_b64_tr_b16 %0,%1 offset:%c2":"=&v"(hi[ks]):"v"(vb),"i"(d0*4096+ks*1024+512):"memory");}
    if(d0==0){ const bf16x8 ones={(short)0x3f80,(short)0x3f80,(short)0x3f80,(short)0x3f80,(short)0x3f80,(short)0x3f80,(short)0x3f80,(short)0x3f80};
      ol=__builtin_amdgcn_mfma_f32_32x32x16_bf16(pa0,ones,ol,0,0,0); ol=__builtin_amdgcn_mfma_f32_32x32x16_bf16(pa1,ones,ol,0,0,0);
      ol=__builtin_amdgcn_mfma_f32_32x32x16_bf16(pa2,ones,ol,0,0,0); ol=__builtin_amdgcn_mfma_f32_32x32x16_bf16(pa3,ones,ol,0,0,0); }
    asm volatile("s_waitcnt lgkmcnt(0)":::"memory");SBAR();
    #define PK(k) (bf16x8){lo[k][0],lo[k][1],lo[k][2],lo[k][3],hi[k][0],hi[k][1],hi[k][2],hi[k][3]}
    o[d0]=__builtin_amdgcn_mfma_f32_32x32x16_bf16(pa0,PK(0),o[d0],0,0,0);
    o[d0]=__builtin_amdgcn_mfma_f32_32x32x16_bf16(pa1,PK(1),o[d0],0,0,0);
    o[d0]=__builtin_amdgcn_mfma_f32_32x32x16_bf16(pa2,PK(2),o[d0],0,0,0);
    o[d0]=__builtin_amdgcn_mfma_f32_32x32x16_bf16(pa3,PK(3),o[d0],0,0,0);
    #undef PK
  }
}

template<int TYPE> __device__ __forceinline__ void attn_unit(int b,int h16,int qb,const bf16_t*Q,const bf16_t*__restrict__ K,const bf16_t*__restrict__ V,unsigned char*O,
                                                              const float*__restrict__ F2,const unsigned long long*__restrict__ mask,char*shm,const float qkmax2,const int wave_in,
                                                              const int piece=0,const int np=1,const int per=0,float*part=nullptr,unsigned*pctr=nullptr,const int viscap=1<<20){
  const int lane=mk_lane(),r32=lane&31,hi=lane>>5; const int wid=__builtin_amdgcn_readfirstlane(wave_in); const int tid=wid*64+lane;
  const long rowbase=(long)b*SEQ; const int q0=qb*QB;
  const bf16_t*Qw=Q+(rowbase+q0+wid*QBLK)*DM+h16*D;
  const bf16_t*Kh=K+rowbase*DM+h16*D,*Vh=V+rowbase*DM+h16*D;
  const unsigned lds0=(unsigned)(uintptr_t)shm;
  float*wsf=(float*)(shm+LDS_WS)+wid*64;
  float*fk=(float*)(shm+LDS_FK);
  const bf16_t*ksrc=Kh+(long)lane*DM+wid*8;
  const bf16_t*vsrc=Vh+(long)(16*(wid&3)+(lane>>2))*DM+(wid>>2)*32+(lane&3)*8;
  const unsigned kdst=lds0+LDS_K+wid*1024, vdst=lds0+LDS_V+wid*1024;
  #define DMA_K(t,slot) glds16(ksrc+(long)(t)*KVBLK*DM,(unsigned)__builtin_amdgcn_readfirstlane(kdst+(slot)))
  #define DMA_V(t,slot) glds16(vsrc+(long)(t)*KVBLK*DM,(unsigned)__builtin_amdgcn_readfirstlane(vdst+(slot)))
  const int vb0=(int)(lds0+LDS_V)+((lane>>4)&1)*32+(lane&3)*8+(4*hi+((lane&15)>>2))*64;
  const int NT=(q0+QB)/KVBLK;
  const int tq=q0+wid*QBLK+r32;
  int t_begin=0;
  float Fq=0.f, sl2=0.f;
  if(TYPE==0){ const float*f2h=F2+((size_t)b*8+(h16-8))*SEQ; Fq=f2h[tq];
    { const float f0=f2h[q0]; const int j0=lane, j1=lane+64;
      const float e0=(j0<NT-4)?f2h[j0*KVBLK+KVBLK-1]:0.f, e1=(j1<NT-4)?f2h[j1*KVBLK+KVBLK-1]:0.f;
      const bool v0=(j0>=NT-4)||!(f0-e0+2.f*qkmax2 < -40.f), v1=(j1>=NT-4)||!(f0-e1+2.f*qkmax2 < -40.f);
      const unsigned long long b0=__ballot(v0), b1=__ballot(v1);
      t_begin=b0?(int)__builtin_ctzll(b0):64+(int)__builtin_ctzll(b1); if(t_begin>NT-4)t_begin=NT-4;
      if(t_begin<NT-viscap)t_begin=NT-viscap; }
    for(int i=t_begin*KVBLK+tid;i<NT*KVBLK;i+=NW*64)fk[i]=f2h[i];
    asm volatile("":"+v"(Fq));
    asm volatile("s_waitcnt vmcnt(0) lgkmcnt(0)\n\ts_barrier":::"memory"); }
  else { sl2=__builtin_amdgcn_exp2f(-(float)(h16+1))*1.4426950408889634f; }
  const int i_lo=(TYPE==1&&np>1)?piece*per:0, i_hi=(TYPE==1&&np>1&&piece<np-1)?((piece+1)*per<NT?(piece+1)*per:NT):NT;
  #define TILE_OF(i_) (NT-1-i_lo-(i_))
  const int nvis=(TYPE==0)?NT-t_begin:i_hi-i_lo;
  const unsigned*mrow=(const unsigned*)(mask+((size_t)rowbase+tq)*128);
  const unsigned mdst=lds0+LDS_MR+wid*256;
  typedef __attribute__((address_space(3))) const unsigned* lds_cup;
  lds_cup mring=(lds_cup)(__attribute__((address_space(3))) char*)(shm+LDS_MR);
  #define ISSUE(i_,st_) do{ const int t_=TILE_OF(i_); DMA_K(t_,(st_)*SLOTB); DMA_V(t_,(st_)*SLOTB); \
      if(TYPE==1){ glds4(mrow+2*t_,(unsigned)__builtin_amdgcn_readfirstlane(mdst+(st_)*4096)); glds4(mrow+2*t_+1,(unsigned)__builtin_amdgcn_readfirstlane(mdst+(st_)*4096+2048)); } }while(0)
  #pragma unroll
  for(int i=0;i<RD;++i) if(i<nvis) ISSUE(i,i);
  bf16x8 qr[4];
  #pragma unroll
  for(int d0=0;d0<4;++d0)qr[d0]=*reinterpret_cast<const bf16x8*>(&Qw[(long)r32*DM+d0*16+hi*8]);
  asm volatile("":"+v"(qr[0]),"+v"(qr[1]),"+v"(qr[2]),"+v"(qr[3]));
  float m_run=-INFINITY;f32x16 o[2];o[0]=f32x16{};o[1]=f32x16{}; f32x16 ol=f32x16{}; float mref=0.f; bool seen=false;
  const f32x16 zero16=f32x16{};
  typedef __attribute__((address_space(3))) volatile float* lds_vfp;
  lds_vfp wmin=(lds_vfp)(__attribute__((address_space(3))) char*)(shm+LDS_FLG);
  float kr[16];
  #pragma unroll
  for(int r=0;r<16;++r)kr[r]=sl2*(float)((r&3)+8*(r>>2));
  int stage=0; int ndone=0; bool pmine=false;
  if(wid>=4) __builtin_amdgcn_s_setprio(1);
  const bool grpB=wid>=4;
  u32x4 pw0=u32x4{},pw1=u32x4{},pw2=u32x4{},pw3=u32x4{};
  for(int i=0;i<nvis;++i){
    if(nvis-1-i>=RD-1){ if(TYPE==1) asm volatile("s_waitcnt vmcnt(12)":::"memory"); else asm volatile("s_waitcnt vmcnt(6)":::"memory"); }
    else asm volatile("s_waitcnt vmcnt(0)":::"memory");
    asm volatile("s_waitcnt lgkmcnt(0)\n\ts_barrier":::"memory");
    if(i>0 && (i&1)==0){
      float bmin=wmin[0];
      #pragma unroll
      for(int w_=1;w_<NW;++w_)bmin=__builtin_fminf(bmin,wmin[w_]);
      if(TYPE==1){ const int dist=q0-(TILE_OF(i)*KVBLK+KVBLK-1); if(dist>0 && qkmax2-sl2*(float)dist-bmin < -40.f) break; }
      else { if(TILE_OF(i)<NT-4 && qkmax2+(fk[q0]-fk[TILE_OF(i)*KVBLK+KVBLK-1])-bmin < -40.f) break; }
    }
    { const int in_=i+RD; if(in_<nvis){ const int sp_=(stage<2)?stage+RS-2:stage-2; ISSUE(in_,sp_); } }
    const int t=TILE_OF(i);
    const int slot=stage*SLOTB;
    const bool mine=(t*KVBLK<=q0+wid*QBLK+QBLK-1);
    if(grpB && i>0 && pmine){ const int sp_=((stage==0)?RS-1:stage-1)*SLOTB; pv(o,ol,vb0+sp_,__builtin_bit_cast(bf16x8,pw0),__builtin_bit_cast(bf16x8,pw1),__builtin_bit_cast(bf16x8,pw2),__builtin_bit_cast(bf16x8,pw3)); }
    if(mine){
    f32x16 p0,p1;
    {
      f32x16 c0,c1;
      if(TYPE==1){
        const float Bm=__builtin_fmaf(sl2,(float)(t*KVBLK+4*hi-tq),-mref), Bm1=__builtin_fmaf(sl2,32.f,Bm);
        #pragma unroll
        for(int r=0;r<16;++r){ asm("v_add_f32_e32 %0, %1, %2":"=v"(c0[r]):"v"(kr[r]),"v"(Bm)); asm("v_add_f32_e32 %0, %1, %2":"=v"(c1[r]):"v"(kr[r]),"v"(Bm1)); }
      } else {
        const float Bq=Fq-mref;
        #pragma unroll
        for(int j=0;j<4;++j){ const f32x4 a_=*(const f32x4*)(fk+t*KVBLK+8*j+4*hi), c_=*(const f32x4*)(fk+t*KVBLK+32+8*j+4*hi);
          #pragma unroll
          for(int i2=0;i2<4;++i2){c0[4*j+i2]=Bq-a_[i2];c1[4*j+i2]=Bq-c_[i2];} }
      }
      qkt(p0,p1,shm+LDS_K+slot,qr,c0,c1,r32,hi);
      if(TYPE==1){
        const unsigned lo=mring[stage*1024+wid*64+lane]>>(4*hi), hh=mring[stage*1024+512+wid*64+lane]>>(4*hi);
        #pragma unroll
        for(int r=0;r<16;++r){ const int c=(r&3)+8*(r>>2);
          const unsigned m0=(unsigned)__builtin_amdgcn_sbfe((int)lo,c,1), m1=(unsigned)__builtin_amdgcn_sbfe((int)hh,c,1);
          p0[r]=__uint_as_float((__float_as_uint(p0[r])&m0)|(0xff800000u&~m0)); p1[r]=__uint_as_float((__float_as_uint(p1[r])&m1)|(0xff800000u&~m1)); }
      } else { if(t>=NT-4)cmask(p0,p1,t-(NT-4),wid*QBLK+r32,hi); }
    }
    {
      const float rm=rowmax(p0,p1);
      const bool fin=rm>-INFINITY, adj=seen?(rm>8.f):fin;
      if(__any(adj)){
        const float dl=adj?rm:0.f, alpha=(adj&&seen)?__builtin_amdgcn_exp2f(-dl):1.f;
        mref+=dl;
        #pragma unroll
        for(int r=0;r<16;++r){p0[r]-=dl;p1[r]-=dl;}
        if(__any(alpha!=1.f)){
          if(hi==0)wsf[r32]=alpha;
          asm volatile("s_waitcnt lgkmcnt(0)":::"memory");
          #pragma unroll
          for(int r=0;r<16;++r){ const float al=wsf[crow(r,hi)]; o[0][r]*=al; o[1][r]*=al; ol[r]*=al; }
        }
      }
      seen=seen||fin;
      #pragma unroll
      for(int r=0;r<16;++r){p0[r]=__builtin_amdgcn_exp2f(p0[r]);p1[r]=__builtin_amdgcn_exp2f(p1[r]);}
      m_run=seen?mref:-INFINITY;
    }
    #define PKW(P,B) cvtpk_s(P[B],P[B+1])
    pw0=(u32x4){PKW(p0,0),PKW(p0,2),PKW(p0,4),PKW(p0,6)};pw1=(u32x4){PKW(p0,8),PKW(p0,10),PKW(p0,12),PKW(p0,14)};
    pw2=(u32x4){PKW(p1,0),PKW(p1,2),PKW(p1,4),PKW(p1,6)};pw3=(u32x4){PKW(p1,8),PKW(p1,10),PKW(p1,12),PKW(p1,14)};
    #undef PKW
    SBAR();
    if(!grpB) pv(o,ol,vb0+slot,__builtin_bit_cast(bf16x8,pw0),__builtin_bit_cast(bf16x8,pw1),__builtin_bit_cast(bf16x8,pw2),__builtin_bit_cast(bf16x8,pw3));
    }
    pmine=mine;
    if((i&1)==1){ float mn=m_run;
      #pragma unroll
      for(int o_=1;o_<32;o_<<=1)mn=__builtin_fminf(mn,__shfl_xor(mn,o_));
      if(lane==0)wmin[wid]=mn; }
    stage=(stage+1==RS)?0:stage+1; ++ndone;
  }
  if(grpB && ndone>0 && pmine){ const int sp_=((stage==0)?RS-1:stage-1)*SLOTB; pv(o,ol,vb0+sp_,__builtin_bit_cast(bf16x8,pw0),__builtin_bit_cast(bf16x8,pw1),__builtin_bit_cast(bf16x8,pw2),__builtin_bit_cast(bf16x8,pw3)); }
  __builtin_amdgcn_s_setprio(0);
  asm volatile("s_waitcnt vmcnt(0) lgkmcnt(0)\n\ts_barrier":::"memory");
  #undef ISSUE
  #undef TILE_OF
  if(TYPE==1 && np>1){
    float*pp=part+(size_t)piece*(49*512)+tid;
    #pragma unroll
    for(int r=0;r<16;++r){pp[r*512]=o[0][r];pp[(16+r)*512]=o[1][r];pp[(32+r)*512]=ol[r];}
    pp[48*512]=seen?mref:-INFINITY;
    asm volatile("s_waitcnt vmcnt(0)":::"memory");
    __syncthreads();
    typedef __attribute__((address_space(3))) volatile unsigned* lds_vup;
    lds_vup pflag=(lds_vup)(__attribute__((address_space(3))) char*)(shm+LDS_FLG+64);
    if(tid==0){
      __builtin_amdgcn_fence(__ATOMIC_RELEASE,"agent"); asm volatile("s_waitcnt vmcnt(0)":::"memory");
      const unsigned old_=__hip_atomic_fetch_add(pctr,1u,__ATOMIC_RELAXED,__HIP_MEMORY_SCOPE_AGENT);
      if(old_==(unsigned)(np-1)){ __builtin_amdgcn_fence(__ATOMIC_ACQUIRE,"agent"); asm volatile("s_waitcnt vmcnt(0)":::"memory"); }
      *pflag=old_; }
    __syncthreads();
    const unsigned arrived=*pflag;
    if(arrived!=(unsigned)(np-1)){ asm volatile("s_waitcnt vmcnt(0) lgkmcnt(0)\n\ts_barrier":::"memory"); return; }
    float M=-INFINITY;
    #pragma unroll 1
    for(int k=0;k<np;++k) M=__builtin_fmaxf(M,part[(size_t)k*(49*512)+48*512+tid]);
    if(M==-INFINITY)M=0.f;
    #pragma unroll
    for(int r=0;r<16;++r){o[0][r]=0.f;o[1][r]=0.f;ol[r]=0.f;}
    #pragma unroll 1
    for(int k=0;k<np;++k){ const float*pk=part+(size_t)k*(49*512)+tid;
      const float mk=pk[48*512], sk=(mk==-INFINITY)?0.f:__builtin_amdgcn_exp2f(mk-M);
      #pragma unroll
      for(int r=0;r<16;++r){o[0][r]=__builtin_fmaf(sk,pk[r*512],o[0][r]);o[1][r]=__builtin_fmaf(sk,pk[(16+r)*512],o[1][r]);ol[r]=__builtin_fmaf(sk,pk[(32+r)*512],ol[r]);} }
  }
  float rli[16];
  #pragma unroll
  for(int r=0;r<16;++r)rli[r]=__builtin_amdgcn_rcpf(ol[r]);
  unsigned char*Ow=O+(rowbase+q0+wid*QBLK)*DM+h16*D;
  { unsigned char*stg=(unsigned char*)(shm+LDS_OST)+wid*2048;
    #pragma unroll
    for(int r=0;r<16;++r){const int orow=crow(r,hi);
      #pragma unroll
      for(int d0=0;d0<2;++d0){ const unsigned pk=(unsigned)__builtin_amdgcn_cvt_pk_fp8_f32(o[d0][r]*rli[r]*PROBE_ZF(TYPE),0.f,0,false); stg[orow*64+d0*32+r32]=(unsigned char)(pk&0xffu);} }
    asm volatile("s_waitcnt lgkmcnt(0)":::"memory");
    { const int row=lane>>1,hf=lane&1; const u32x4 v0=*(const u32x4*)(stg+row*64+hf*32), v1=*(const u32x4*)(stg+row*64+hf*32+16);
      *(u32x4*)(Ow+(long)row*DM+hf*32)=v0; *(u32x4*)(Ow+(long)row*DM+hf*32+16)=v1; } }
  asm volatile("s_waitcnt lgkmcnt(0)\n\ts_barrier":::"memory");
  #undef DMA_K
  #undef DMA_V
}
#undef SBAR
#undef WAIT_ALL_BAR
}
constexpr int NWAVES = 8;
constexpr int N_PHASES = 14;
constexpr int N_LAUNCHES = MK_N_LAUNCHES;
static_assert(N_LAUNCHES == 1 || N_LAUNCHES == N_PHASES, "MK_N_LAUNCHES is 1 or 14");
constexpr int BATCH = 2, SEQ = 8192, D_MODEL = 1024, D_FF = 2816, IN_WIDTH = 5712, TOPK = 256;
constexpr int M = BATCH * SEQ;
constexpr int NA_COLS = 15 * 256;
constexpr size_t MiB = 1u << 20;
constexpr size_t WS_CTL = 0, CTL_ZERO_BYTES = 1 * MiB;
constexpr size_t WS_MOD = 1 * MiB, WS_GAINS = 1 * MiB + 131072, WS_AORDER = 1 * MiB + 262144;
constexpr int CW_AQUEUE = 2048, CW_CQUEUE = 3072, CW_PCTR = 3200;
constexpr int CW_DUMMY_ = 0;
constexpr size_t WS_WGU = 2 * MiB, WS_WD = 13 * MiB, WS_WINA = 19 * MiB, WS_WINB = 27 * MiB, WS_WBR = 31 * MiB, WS_WOUT = 35 * MiB;
constexpr size_t WS_H = 38 * MiB;
constexpr size_t WS_BIG = 70 * MiB;
constexpr size_t WS_Q16 = 70 * MiB, WS_K16 = 102 * MiB, WS_V16 = 134 * MiB;
constexpr size_t WS_QI = 166 * MiB, WS_KI = 182 * MiB, WS_WI = 184 * MiB, WS_LF = 185 * MiB, WS_F2 = 186 * MiB, WS_MASK = 188 * MiB, WS_H8B = 204 * MiB, WS_O8 = 220 * MiB, WS_END = 236 * MiB;
static_assert(WS_WGU + (size_t)2 * D_FF * D_MODEL * 2 <= WS_WD && WS_WD + (size_t)D_FF * D_MODEL * 2 <= WS_WINA && WS_WINA + (size_t)NA_COLS * D_MODEL * 2 <= WS_WINB, "ws map");
static_assert(WS_BIG + (size_t)M * D_FF * 2 <= WS_QI && WS_MASK + (size_t)M * SEQ / 8 <= WS_H8B, "ws map");
constexpr int CW_BAR = 4096;
constexpr int RING_BYTES = 131072, LDSCTL_OFF = 147456, MISC_OFF = LDSCTL_OFF + 320, LDS_BYTES = 148480;
typedef unsigned u32x4g __attribute__((ext_vector_type(4)));
typedef float f32x2g __attribute__((ext_vector_type(2)));
#define GAS __attribute__((address_space(1)))
#define LAS __attribute__((address_space(3)))
typedef unsigned short bf16;
typedef unsigned v4u __attribute__((ext_vector_type(4)));
typedef float f32x4 __attribute__((ext_vector_type(4)));
typedef short bf16x8 __attribute__((ext_vector_type(8)));
typedef GAS unsigned gu32;
typedef GAS unsigned long long gu64;
#define RLX_AGENT __ATOMIC_RELAXED, __HIP_MEMORY_SCOPE_AGENT
#define LDS_WAIT() asm volatile("s_waitcnt lgkmcnt(0)" ::: "memory")
#define VM_WAIT() asm volatile("s_waitcnt vmcnt(0)" ::: "memory")
__device__ __forceinline__ unsigned long long rt() { return __builtin_amdgcn_s_memrealtime(); }
__device__ __forceinline__ unsigned f2bf(float f) { unsigned u = __builtin_bit_cast(unsigned, f); return (u + 0x7fffu + ((u >> 16) & 1u)) >> 16; }
__device__ __forceinline__ unsigned pk2(float lo, float hi) { return f2bf(lo) | (f2bf(hi) << 16); }

#define XB_TMO      128
#define XB_XCNT(j)  (256  + 64 * (j))
#define XB_XSUB(j)  (1280 + 64 * (j))
#define XB_XGEN(j)  (2304 + 64 * (j))
#define XB_TOP      3328
#define XB_TOPGEN   3392
#define XCD_BAR_WORDS 3456
#define XB_SPIN_CAP (1u << 18)

__device__ __forceinline__ unsigned xb_ld(unsigned* p)              { return __hip_atomic_load(p, __ATOMIC_RELAXED, __HIP_MEMORY_SCOPE_AGENT); }
__device__ __forceinline__ unsigned xb_add(unsigned* p, unsigned v) { return __hip_atomic_fetch_add(p, v, __ATOMIC_RELAXED, __HIP_MEMORY_SCOPE_AGENT); }
__device__ __forceinline__ unsigned xb_xcc_id() { return (unsigned)__builtin_amdgcn_s_getreg((3 << 11) | 20) & 0xFu; }
#define XB_SPIN(cond, bar) do { unsigned _sp = 0; while (cond) { __builtin_amdgcn_s_sleep(1); \
    if ((++_sp & 255u) == 0u) { if (xb_ld(&(bar)[XB_TMO])) break; if (_sp > XB_SPIN_CAP) { atomicAdd(&(bar)[XB_TMO], 1u); break; } } } } while (0)

struct XcdBarrier {
    int wave;
    unsigned* bar; unsigned x;
    volatile LAS unsigned* st;
};

__device__ __forceinline__ XcdBarrier xcd_barrier_post(unsigned* bar, volatile LAS unsigned* st, int wave) {
    XcdBarrier b; b.wave = wave; b.bar = bar; b.x = xb_xcc_id(); b.st = st;
    if (wave == 0 && mk_lane() == 0) (void)xb_add(&bar[XB_XCNT(b.x)], 1u);
    return b;
}
__device__ __forceinline__ void xcd_barrier_complete(unsigned* bar, unsigned x, unsigned& nloc, unsigned& nx) {
    const unsigned G = gridDim.x * gridDim.y * gridDim.z;
    unsigned sum, cnt, mine, sp = 0u;
    for (;;) {
        sum = 0u; cnt = 0u; mine = 0u;
#pragma unroll
        for (unsigned j = 0; j < 16; ++j) { const unsigned c = xb_ld(&bar[XB_XCNT(j)]); sum += c; cnt += (c > 0u) ? 1u : 0u; mine = (j == x) ? c : mine; }
        if (sum == G) break;
        __builtin_amdgcn_s_sleep(1);
        if ((++sp & 255u) == 0u) { if (xb_ld(&bar[XB_TMO])) break; if (sp > XB_SPIN_CAP) { atomicAdd(&bar[XB_TMO], 1u); break; } }
    }
    nloc = mine > 0u ? mine : 1u; nx = cnt > 0u ? cnt : 1u;
}

__device__ __forceinline__ void xcd_barrier(const XcdBarrier& b) {
    asm volatile("s_waitcnt vmcnt(0)" ::: "memory");
    __syncthreads();
    if (b.wave == 0 && mk_lane() == 0) {
        unsigned* bar = b.bar;
        __builtin_amdgcn_s_waitcnt(0);
        unsigned nloc = b.st[0], nx = b.st[1];
        if (nloc == 0u) { xcd_barrier_complete(bar, b.x, nloc, nx); b.st[0] = nloc; b.st[1] = nx; }
        const unsigned old = xb_add(&bar[XB_XSUB(b.x)], 1u);
        const unsigned gen = old / nloc;
        if (old + 1u == (gen + 1u) * nloc) {
            __builtin_amdgcn_fence(__ATOMIC_RELEASE, "agent");
            asm volatile("s_waitcnt vmcnt(0)" ::: "memory");
            const unsigned og = xb_add(&bar[XB_TOP], 1u);
            const unsigned tg = og / nx;
            if (og + 1u == (tg + 1u) * nx) xb_add(&bar[XB_TOPGEN], 1u);
            else XB_SPIN(xb_ld(&bar[XB_TOPGEN]) == tg, bar);
            __builtin_amdgcn_fence(__ATOMIC_ACQUIRE, "agent");
            xb_add(&bar[XB_XGEN(b.x)], 1u);
            asm volatile("s_waitcnt vmcnt(0)" ::: "memory");
        } else {
            XB_SPIN(xb_ld(&bar[XB_XGEN(b.x)]) == gen, bar);
            __builtin_amdgcn_fence(__ATOMIC_ACQUIRE, "agent");
            asm volatile("s_waitcnt vmcnt(0)" ::: "memory");
        }
    }
    __syncthreads();
}
struct Frame {
    LAS unsigned char* lds;
    volatile LAS unsigned* MISC;
    gu32* ctl;
    int tid, lane, wave;
    int vcu, G;
    float* out;
    unsigned char* ws;
};
__device__ __forceinline__ float wave_sum(float v) {
#pragma unroll
    for (int o = 1; o < 64; o <<= 1) v += __shfl_xor(v, o);
    return v;
}

enum { J_GU = 0, J_D = 1, J_INA = 2, J_INB = 3, J_BR = 4, J_OUT = 5 };
struct SrcDesc { const float* W; int N; int n0; int k0; };
__device__ __forceinline__ SrcDesc wsrc(int job, int g, int kb, const float* w0, const float* w1) {
    SrcDesc s; s.W = w0; s.k0 = 64 * kb; const int v0 = 32 * g, pn = v0 >> 8, j = v0 & 255;
    switch (job) {
    case J_GU:  s.W = (j < 128) ? w0 : w1; s.N = D_FF; s.n0 = 128 * pn + (j & 127); break;
    case J_D:   s.N = D_MODEL; s.n0 = v0; break;
    case J_INA: { s.N = IN_WIDTH; const int sec = pn >> 1;
        if (sec == 0 || sec == 1 || sec == 3 || sec == 4) s.n0 = 512 * sec + ((pn & 1) * 4 + ((j & 127) >> 5)) * 64 + 32 * (j >> 7);
        else if (sec == 2 || sec == 5 || sec == 6) s.n0 = 512 * sec + 256 * (pn & 1) + j;
        else { if (j < 96) s.n0 = 3584 + j; else s.W = nullptr; } } break;
    case J_INB: s.N = IN_WIDTH; s.n0 = 3664 + v0; break;
    case J_BR:  { s.N = D_MODEL; s.n0 = 128 * pn + (j & 127);
        if (j < 128) { if (kb >= 8) s.W = nullptr; } else { if (kb < 8) s.W = nullptr; else { s.W = w1; s.k0 = 64 * kb - 512; } } } break;
    default:    s.N = D_MODEL; s.n0 = v0; break;
    }
    return s;
}
__device__ __forceinline__ void transpose_item(const SrcDesc s, bf16* WT, int Kd, int g, int kb, LAS float* scr, int lane) {
    const int c = lane & 7;
    if (s.W == nullptr) {
#pragma unroll
        for (int jj = 0; jj < 4; ++jj) { const int n = (lane >> 3) + 8 * jj; *(GAS v4u*)(WT + (size_t)(32 * g + n) * Kd + 64 * kb + 8 * c) = (v4u){0u, 0u, 0u, 0u}; }
        return;
    }
#pragma unroll 8
    for (int i = 0; i < 32; ++i) { const int kk = 2 * i + (lane >> 5); scr[kk * 33 + (lane & 31)] = s.W[(size_t)(s.k0 + kk) * s.N + s.n0 + (lane & 31)]; }
    LDS_WAIT(); asm volatile("" ::: "memory");
#pragma unroll
    for (int jj = 0; jj < 4; ++jj) { const int n = (lane >> 3) + 8 * jj; const LAS float* p = scr + (8 * c) * 33 + n;
        v4u o; o.x = pk2(p[0 * 33], p[1 * 33]); o.y = pk2(p[2 * 33], p[3 * 33]); o.z = pk2(p[4 * 33], p[5 * 33]); o.w = pk2(p[6 * 33], p[7 * 33]);
        *(GAS v4u*)(WT + (size_t)(32 * g + n) * Kd + 64 * kb + 8 * c) = o; }
    LDS_WAIT(); asm volatile("" ::: "memory");
}
__device__ __forceinline__ int transpose_job(Frame& F, int job, const float* w0, const float* w1, bf16* WT, int rows, int Kd, int base) {
    LAS float* scr = (LAS float*)(F.lds + F.wave * 16384);
    const int nkb = Kd / 64, nitem = (rows / 32) * nkb, gw = F.vcu * NWAVES + F.wave, NGW = F.G * NWAVES;
    int first = (gw - base % NGW + NGW) % NGW;
    for (int it = first; it < nitem; it += NGW) { const int g = it / nkb, kb = it % nkb; transpose_item(wsrc(job, g, kb, w0, w1), WT, Kd, g, kb, scr, F.lane); }
    return base + nitem;
}
template <bool F8> __device__ __forceinline__ void transpose_item64(const SrcDesc sA, const SrcDesc sB, void* WTv, int Kd, int g2, int kb, LAS float* scr, int lane, float wsc) {
    const int nq = (lane & 15) * 4, kr = lane >> 4;
    const SrcDesc s = (nq < 32) ? sA : sB;
    f32x4 v[16];
    if (s.W != nullptr) {
        const float* p = s.W + (size_t)(s.k0 + kr) * s.N + s.n0 + (nq & 31);
#pragma unroll
        for (int i = 0; i < 16; ++i) v[i] = *(const f32x4*)(p + (size_t)(4 * i) * s.N);
    } else {
#pragma unroll
        for (int i = 0; i < 16; ++i) v[i] = (f32x4){0.f, 0.f, 0.f, 0.f};
    }
#pragma unroll
    for (int i = 0; i < 16; ++i) { const int k = 4 * i + kr; scr[(nq + 0) * 65 + k] = v[i].x; scr[(nq + 1) * 65 + k] = v[i].y; scr[(nq + 2) * 65 + k] = v[i].z; scr[(nq + 3) * 65 + k] = v[i].w; }
    LDS_WAIT(); asm volatile("" ::: "memory");
    if constexpr (F8) {
        unsigned char* WT = (unsigned char*)WTv;
#pragma unroll
        for (int j = 0; j < 4; ++j) { const int n = (lane >> 2) + 16 * j, c = lane & 3; const LAS float* q = scr + n * 65 + 16 * c;
            v4u o; o.x = pg8::pk4_fp8(q[0] * wsc, q[1] * wsc, q[2] * wsc, q[3] * wsc); o.y = pg8::pk4_fp8(q[4] * wsc, q[5] * wsc, q[6] * wsc, q[7] * wsc);
            o.z = pg8::pk4_fp8(q[8] * wsc, q[9] * wsc, q[10] * wsc, q[11] * wsc); o.w = pg8::pk4_fp8(q[12] * wsc, q[13] * wsc, q[14] * wsc, q[15] * wsc);
            *(GAS v4u*)(WT + (size_t)(64 * g2 + n) * Kd + 64 * kb + 16 * c) = o; }
    } else {
        bf16* WT = (bf16*)WTv;
#pragma unroll
        for (int j = 0; j < 8; ++j) { const int n = (lane >> 3) + 8 * j, c = lane & 7; const LAS float* q = scr + n * 65 + 8 * c;
            v4u o; o.x = pk2(q[0], q[1]); o.y = pk2(q[2], q[3]); o.z = pk2(q[4], q[5]); o.w = pk2(q[6], q[7]);
            *(GAS v4u*)(WT + (size_t)(64 * g2 + n) * Kd + 64 * kb + 8 * c) = o; }
    }
    LDS_WAIT(); asm volatile("" ::: "memory");
}
template <bool F8> __device__ __forceinline__ int transpose_job64(Frame& F, int job, const float* w0, const float* w1, void* WT, int rows, int Kd, int base, float wsc, const int g2off = 0) {
    LAS float* scr = (LAS float*)(F.lds + F.wave * 16896);
    const int nkb = Kd / 64, nitem = (rows / 64) * nkb, gw = F.vcu * NWAVES + F.wave, NGW = F.G * NWAVES;
    int first = (gw - base % NGW + NGW) % NGW;
    for (int it = first; it < nitem; it += NGW) { const int g2 = it / nkb, kb = it % nkb;
        transpose_item64<F8>(wsrc(job, 2 * (g2 + g2off), kb, w0, w1), wsrc(job, 2 * (g2 + g2off) + 1, kb, w0, w1), WT, Kd, g2, kb, scr, F.lane, wsc); }
    return base + nitem;
}

__device__ __forceinline__ void ffn_copies_queue(Frame& F, gu32* counter, const float* wg, const float* wu, const float* wd, void* Wgu_, void* Wd_) {
    LAS float* scr = (LAS float*)(F.lds + F.wave * 16896);
    constexpr int N_GU = (2 * D_FF / 64) * (D_MODEL / 64), N_D = (D_MODEL / 64) * (D_FF / 64);
    for (;;) {
        int it0 = 0; if (F.lane == 0) it0 = (int)__hip_atomic_fetch_add((unsigned*)counter, 4u, __ATOMIC_RELAXED, __HIP_MEMORY_SCOPE_AGENT);
        it0 = __builtin_amdgcn_readfirstlane(it0);
        if (it0 >= N_GU + N_D) break;
      for (int it = it0; it < it0 + 4 && it < N_GU + N_D; ++it) {
        if (it < N_GU) { const int nkb = D_MODEL / 64, g2 = it / nkb, kb = it % nkb;
            transpose_item64<true>(wsrc(J_GU, 2 * g2, kb, wg, wu), wsrc(J_GU, 2 * g2 + 1, kb, wg, wu), Wgu_, D_MODEL, g2, kb, scr, F.lane, 32.f); }
        else { const int i2 = it - N_GU, nkb = D_FF / 64, g2 = i2 / nkb, kb = i2 % nkb;
            transpose_item64<true>(wsrc(J_D, 2 * g2, kb, wd, nullptr), wsrc(J_D, 2 * g2 + 1, kb, wd, nullptr), Wd_, D_FF, g2, kb, scr, F.lane, 64.f); }
      }
    }
}

__device__ __forceinline__ void dsa_plan(int h, int qb, int& np, int& per) {
    const float sl2 = exp2f(-(float)(h + 1)) * 1.4426950408889634f; const int cap = 5 + (int)((180.f + 68.f / sl2) * (1.f / 64.f));
    const int full = 4 * (qb + 1), L = full < cap ? full : cap;
    np = L > 64 ? 2 : 1; per = (L + np - 1) / np;
}
constexpr int AQ_CAP = 1024;
__device__ __forceinline__ void build_attn_queues(Frame& F, const float* b_forget, const float* qn_fox, const float* kn_fox) {
    LAS float* Lh = (LAS float*)(F.lds);
    LAS float* cs = (LAS float*)(F.lds + 64);
    LAS float* tot = (LAS float*)(F.lds + 64 + 2048);
    LAS int* hist = (LAS int*)(F.lds + 4096);
    LAS int* cnt = (LAS int*)(F.lds + 4096 + 8 * 132 * 4);
    unsigned* ord = (unsigned*)(F.ws + WS_AORDER);
    const int t = F.tid;
    for (int i = t; i < 8 * 132 + 8; i += NWAVES * 64) hist[i] = 0;
    if (F.wave == 0) { float mq = fabsf(qn_fox[F.lane]), mk = fabsf(kn_fox[F.lane]);
#pragma unroll
        for (int o = 1; o < 64; o <<= 1) { mq = fmaxf(mq, __shfl_xor(mq, o)); mk = fmaxf(mk, __shfl_xor(mk, o)); }
        const float qk2 = 64.f * 0.125f * 1.4426950408889634f * mq * mk;
        if (F.lane < 8) { float l = (40.f + 2.f * qk2) / (1.4426950408889634f * 1.65f * __expf(-b_forget[F.lane]) * 64.f); Lh[F.lane] = l < 1.f ? 1.f : (l > 128.f ? 128.f : l); } }
    __syncthreads();
    int len[3]; unsigned id[3]; float cost[3]; float mine = 0.f;
#pragma unroll
    for (int i = 0; i < 3; ++i) { const int s = 3 * t + i, b = s >= 768 ? 1 : 0, e = s - 768 * b; len[i] = 0; id[i] = 0u; cost[i] = 0.f;
        if (e < 512) { const int h = 7 - (e >> 6), qb = 31 - ((e >> 1) & 31), pc = e & 1; int np, per; dsa_plan(h, qb, np, per);
            if (pc < np) { const float sl2 = exp2f(-(float)(h + 1)) * 1.4426950408889634f; const int cap = 5 + (int)((180.f + 68.f / sl2) * (1.f / 64.f)); const int full = 4 * (qb + 1), L = full < cap ? full : cap;
                len[i] = np == 1 ? L : (pc == 0 ? per : L - per); cost[i] = (float)len[i] + 4.f; id[i] = 512u | (unsigned)(b << 8 | h << 5 | qb | pc << 10 | np << 12); } }
        else { const int h = (e - 512) >> 5, qb = 31 - (e & 31); const int full = 4 * (qb + 1), L0 = 4 + (int)Lh[h], L = full < L0 ? full : L0;
            len[i] = L; cost[i] = 0.8f * (float)L + 4.f; id[i] = (unsigned)(b << 8 | h << 5 | qb | 1 << 12); }
        mine += cost[i]; }
    float inc = mine;
#pragma unroll
    for (int o = 1; o < 64; o <<= 1) { const float v = __shfl_up(inc, o); if (F.lane >= o) inc += v; }
    if (F.lane == 63) cs[F.wave] = inc;
    __syncthreads();
    float wbase = 0.f, tot0 = 0.f, tot1 = 0.f;
#pragma unroll
    for (int w = 0; w < 8; ++w) { const float v = cs[w]; if (w < F.wave) wbase += v; if (w < 4) tot0 += v; else tot1 += v; }
    float run = wbase + inc - mine; int bin[3];
#pragma unroll
    for (int i = 0; i < 3; ++i) { const int s = 3 * t + i, b = s >= 768 ? 1 : 0; const float start = run - (b ? tot0 : 0.f); run += cost[i];
        int q = (int)(start * 4.f / (b ? tot1 : tot0)); q = q < 0 ? 0 : (q > 3 ? 3 : q); bin[i] = 4 * b + q;
        if (len[i] > 0) __hip_atomic_fetch_add(hist + bin[i] * 132 + len[i], 1, __ATOMIC_RELAXED, __HIP_MEMORY_SCOPE_WORKGROUP); }
    __syncthreads();
    {
        const int w = F.wave, l0 = 128 - 2 * F.lane, l1 = l0 - 1; const int c0 = hist[w * 132 + l0], c1 = hist[w * 132 + l1]; int incl = c0 + c1;
#pragma unroll
        for (int o = 1; o < 64; o <<= 1) { const int v = __shfl_up(incl, o); if (F.lane >= o) incl += v; }
        const int excl = incl - c0 - c1; hist[w * 132 + l0] = excl; hist[w * 132 + l1] = excl + c0;
        if (F.lane == 63) ord[8 * AQ_CAP + w] = (unsigned)(incl < AQ_CAP ? incl : AQ_CAP); }
    __syncthreads();
#pragma unroll
    for (int i = 0; i < 3; ++i) if (len[i] > 0) { const int pos = __hip_atomic_fetch_add(hist + bin[i] * 132 + len[i], 1, __ATOMIC_RELAXED, __HIP_MEMORY_SCOPE_WORKGROUP); if (pos < AQ_CAP) ord[bin[i] * AQ_CAP + pos] = id[i]; }
    __syncthreads();
}

__device__ __forceinline__ void mod_gemv(Frame& F, int item, const float* cin, const float* W, const float* bias) {
    float* mod = (float*)(F.ws + WS_MOD);
    LAS float* sc = (LAS float*)(F.lds);
    LAS float* red = (LAS float*)(F.lds + 8192);
    for (int i = F.tid; i < 2048; i += NWAVES * 64) { const float v = cin[i]; sc[i] = v / (1.f + __expf(-v)); }
    __syncthreads();
    const int col = 128 * item + 2 * F.lane, kbeg = 128 * F.wave;
    float a00 = 0.f, a01 = 0.f, a10 = 0.f, a11 = 0.f;
#pragma unroll 16
    for (int k = 0; k < 128; ++k) { const f32x2g w = *(const f32x2g*)(W + (size_t)(kbeg + k) * 9216 + col); const float s0 = sc[kbeg + k], s1 = sc[1024 + kbeg + k];
        a00 += s0 * w.x; a01 += s0 * w.y; a10 += s1 * w.x; a11 += s1 * w.y; }
    red[F.wave * 256 + 2 * F.lane] = a00; red[F.wave * 256 + 2 * F.lane + 1] = a01; red[F.wave * 256 + 128 + 2 * F.lane] = a10; red[F.wave * 256 + 128 + 2 * F.lane + 1] = a11;
    __syncthreads();
    if (F.tid < 256) { const int bb = F.tid >> 7, cc = F.tid & 127; float s = 0.f;
#pragma unroll
        for (int w = 0; w < 8; ++w) s += red[w * 256 + bb * 128 + cc];
        mod[bb * 9216 + 128 * item + cc] = s + bias[128 * item + cc]; }
    __syncthreads();
}
template <bool IN16 = false> __device__ __forceinline__ void norm_phase(Frame& F, const void* xin, const float* g, int nmod, bf16* H, unsigned char* H8 = nullptr) {
    const float* mod = (const float*)(F.ws + WS_MOD);
    const int gw = F.vcu * NWAVES + F.wave, NGW = F.G * NWAVES;
    for (int m = gw; m < M; m += NGW) {
        const int b = m >> 13;
        f32x4 v[4]; float s = 0.f;
        if constexpr (IN16) { const GAS unsigned long long* xr = (const GAS unsigned long long*)((const bf16*)xin + (size_t)m * D_MODEL) + F.lane;
#pragma unroll
            for (int j = 0; j < 4; ++j) { const unsigned long long r2 = xr[64 * j]; const unsigned r0 = (unsigned)r2, r1 = (unsigned)(r2 >> 32);
                v[j].x = __builtin_bit_cast(float, r0 << 16); v[j].y = __builtin_bit_cast(float, r0 & 0xffff0000u); v[j].z = __builtin_bit_cast(float, r1 << 16); v[j].w = __builtin_bit_cast(float, r1 & 0xffff0000u); } }
        else { const GAS f32x4* xr = (const GAS f32x4*)((const float*)xin + (size_t)m * D_MODEL) + F.lane;
#pragma unroll
            for (int j = 0; j < 4; ++j) v[j] = xr[64 * j]; }
#pragma unroll
        for (int j = 0; j < 4; ++j) s += (v[j].x * v[j].x + v[j].y * v[j].y) + (v[j].z * v[j].z + v[j].w * v[j].w);
        const float rstd = 1.f / sqrtf(wave_sum(s) * (1.f / D_MODEL) + 1e-6f);
        GAS unsigned long long* o8 = (GAS unsigned long long*)(H + (size_t)m * D_MODEL) + F.lane;
#pragma unroll
        for (int j = 0; j < 4; ++j) { const int c = 4 * F.lane + 256 * j;
            const f32x4 gg = *(const f32x4*)(g + c), shv = *(const f32x4*)(mod + b * 9216 + nmod * 1024 + c), scv = *(const f32x4*)(mod + b * 9216 + (nmod + 1) * 1024 + c);
            const f32x4 y = v[j] * rstd * gg * (scv + 1.f) + shv;
            o8[64 * j] = (unsigned long long)pk2(y.x, y.y) | ((unsigned long long)pk2(y.z, y.w) << 32);
            if (H8) ((GAS unsigned*)(H8 + (size_t)m * D_MODEL) + F.lane)[64 * j] = pg8::pk4_fp8(y.x, y.y, y.z, y.w); }
    }
}

__device__ __forceinline__ void transpose_item8(const SrcDesc s, unsigned char* WT, int Kd, int g, int kb, LAS float* scr, int lane, float wsc) {
#pragma unroll 8
    for (int i = 0; i < 32; ++i) { const int kk = 2 * i + (lane >> 5); scr[kk * 33 + (lane & 31)] = s.W[(size_t)(s.k0 + kk) * s.N + s.n0 + (lane & 31)]; }
    LDS_WAIT(); asm volatile("" ::: "memory");
    const int n = lane >> 1, h = lane & 1; const LAS float* p = scr + (32 * h) * 33 + n;
    v4u o0, o1;
#define T8W(i_) pg8::pk4_fp8(p[(4 * (i_) + 0) * 33] * wsc, p[(4 * (i_) + 1) * 33] * wsc, p[(4 * (i_) + 2) * 33] * wsc, p[(4 * (i_) + 3) * 33] * wsc)
    o0.x = T8W(0); o0.y = T8W(1); o0.z = T8W(2); o0.w = T8W(3); o1.x = T8W(4); o1.y = T8W(5); o1.z = T8W(6); o1.w = T8W(7);
#undef T8W
    unsigned char* d = WT + (size_t)(32 * g + n) * Kd + 64 * kb + 32 * h;
    *(GAS v4u*)d = o0; *(GAS v4u*)(d + 16) = o1;
    LDS_WAIT(); asm volatile("" ::: "memory");
}
__device__ __forceinline__ int transpose_job8(Frame& F, int job, const float* w0, const float* w1, unsigned char* WT, int rows, int Kd, int base, float wsc) {
    LAS float* scr = (LAS float*)(F.lds + F.wave * 16384);
    const int nkb = Kd / 64, nitem = (rows / 32) * nkb, gw = F.vcu * NWAVES + F.wave, NGW = F.G * NWAVES;
    int first = (gw - base % NGW + NGW) % NGW;
    for (int it = first; it < nitem; it += NGW) { const int g = it / nkb, kb = it % nkb; transpose_item8(wsrc(job, g, kb, w0, w1), WT, Kd, g, kb, scr, F.lane, wsc); }
    return base + nitem;
}
template <bool IN16 = false> __device__ __forceinline__ void norm_phase8(Frame& F, const void* xin, const float* g, int nmod, unsigned char* H8) {
    const float* mod = (const float*)(F.ws + WS_MOD);
    const int gw = F.vcu * NWAVES + F.wave, NGW = F.G * NWAVES;
    for (int m = gw; m < M; m += NGW) {
        const int b = m >> 13;
        f32x4 v[4]; float s = 0.f;
        if constexpr (IN16) { const GAS unsigned long long* xr = (const GAS unsigned long long*)((const bf16*)xin + (size_t)m * D_MODEL) + F.lane;
#pragma unroll
            for (int j = 0; j < 4; ++j) { const unsigned long long r2 = xr[64 * j]; const unsigned r0 = (unsigned)r2, r1 = (unsigned)(r2 >> 32);
                v[j].x = __builtin_bit_cast(float, r0 << 16); v[j].y = __builtin_bit_cast(float, r0 & 0xffff0000u); v[j].z = __builtin_bit_cast(float, r1 << 16); v[j].w = __builtin_bit_cast(float, r1 & 0xffff0000u); } }
        else { const GAS f32x4* xr = (const GAS f32x4*)((const float*)xin + (size_t)m * D_MODEL) + F.lane;
#pragma unroll
            for (int j = 0; j < 4; ++j) v[j] = xr[64 * j]; }
#pragma unroll
        for (int j = 0; j < 4; ++j) s += (v[j].x * v[j].x + v[j].y * v[j].y) + (v[j].z * v[j].z + v[j].w * v[j].w);
        const float rstd = 1.f / sqrtf(wave_sum(s) * (1.f / D_MODEL) + 1e-6f);
        GAS unsigned* o4 = (GAS unsigned*)(H8 + (size_t)m * D_MODEL) + F.lane;
#pragma unroll
        for (int j = 0; j < 4; ++j) { const int c = 4 * F.lane + 256 * j;
            const f32x4 gg = *(const f32x4*)(g + c), shv = *(const f32x4*)(mod + b * 9216 + nmod * 1024 + c), scv = *(const f32x4*)(mod + b * 9216 + (nmod + 1) * 1024 + c);
            const f32x4 y = v[j] * rstd * gg * (scv + 1.f) + shv;
            o4[64 * j] = pg8::pk4_fp8(y.x, y.y, y.z, y.w); }
    }
}

__device__ __forceinline__ unsigned sortable_key(float s) { unsigned u = __builtin_bit_cast(unsigned, s); if (u == 0x80000000u) u = 0u; return (u & 0x80000000u) ? ~u : (u | 0x80000000u); }
__device__ __forceinline__ void fscan_row(const float* lf, float* f2, int lane) {
    float carry = 0.f;
    for (int it = 0; it < SEQ / 256; ++it) {
        const f32x4 v = *(const f32x4*)(lf + it * 256 + lane * 4);
        const float p0 = v.x, p1 = p0 + v.y, p2 = p1 + v.z, p3 = p2 + v.w;
        float s = p3;
#pragma unroll
        for (int o = 1; o < 64; o <<= 1) { const float t = __shfl_up(s, o); if (lane >= o) s += t; }
        const float ex = s - p3 + carry;
        f32x4 r; r.x = (ex + p0) * 1.4426950408889634f; r.y = (ex + p1) * 1.4426950408889634f; r.z = (ex + p2) * 1.4426950408889634f; r.w = (ex + p3) * 1.4426950408889634f;
        *(f32x4*)(f2 + it * 256 + lane * 4) = r;
        carry += __shfl(s, 63);
    }
}
__device__ __forceinline__ void idx_unit(Frame& F, int b, int t4, const bf16* QI, const bf16* KI, const float* WI, unsigned long long* MASK, int rot, const int mode = 3) {
    typedef short bf16x8v __attribute__((ext_vector_type(8))); typedef float f32x16v __attribute__((ext_vector_type(16)));
    LAS unsigned* sc = (LAS unsigned*)(F.lds);
    LAS unsigned* hist = (LAS unsigned*)(F.lds + 131072);
    int lane = mk_lane(); asm volatile("" : "+v"(lane));
    const int r32 = lane & 31, hi = lane >> 5, wid = F.wave;
    const int t0 = 4 * t4, ntile = (t0 + 4 + 31) >> 5, n = ntile * 32;
    const size_t rb = (size_t)b * SEQ;
    bf16x8v qa[4];
    { const bf16* qp = QI + (rb + t0 + (r32 >> 3)) * 512 + (r32 & 7) * 64 + hi * 8;
#pragma unroll
      for (int ks = 0; ks < 4; ++ks) qa[ks] = *(const bf16x8v*)(qp + ks * 16); }
    float wv[16];
#pragma unroll
    for (int r = 0; r < 16; ++r) wv[r] = WI[(rb + t0 + (r >> 2)) * 8 + (r & 3) + 4 * hi];
    for (int i = F.tid; i < 4096; i += NWAVES * 64) hist[i] = 0u;
#define IDX_LOADK(dst, tile_) do { const bf16* kp_ = KI + ((rb >> 5) + (tile_)) * 2048 + (hi * 32 + r32) * 8; _Pragma("unroll") for (int ks = 0; ks < 4; ++ks) dst[ks] = *(const bf16x8v*)(kp_ + ks * 512); } while (0)
#define IDX_SCORE(kf, tile_) do { const int key = (tile_) * 32 + r32; f32x16v acc = {}; \
        _Pragma("unroll") for (int ks = 0; ks < 4; ++ks) acc = __builtin_amdgcn_mfma_f32_32x32x16_bf16(qa[ks], kf[ks], acc, 0, 0, 0); \
        unsigned u[4]; \
        _Pragma("unroll") for (int q_ = 0; q_ < 4; ++q_) { \
            float s = wv[4 * q_] * fmaxf(acc[4 * q_], 0.f); \
            s += wv[4 * q_ + 1] * fmaxf(acc[4 * q_ + 1], 0.f); s += wv[4 * q_ + 2] * fmaxf(acc[4 * q_ + 2], 0.f); s += wv[4 * q_ + 3] * fmaxf(acc[4 * q_ + 3], 0.f); \
            s = att::xhalf_sum(s); \
            u[q_] = (key <= t0 + q_) ? sortable_key(s) : 0u; } \
        if (hi == 0) { sc[key] = u[0]; sc[8192 + key] = u[1]; } else { sc[16384 + key] = u[2]; sc[24576 + key] = u[3]; } } while (0)
    {
        const int np = (ntile + 1) >> 1;
        const int cnt = ((mode & 1) && wid < np) ? ((np - wid + NWAVES - 1) / NWAVES) : 0;
        bf16x8v ka[4], kc[4], na[4], nc[4];
        int p = (wid + rot) % np;
        if (cnt > 0) { IDX_LOADK(ka, 2 * p); const int t1 = (2 * p + 1 < ntile) ? 2 * p + 1 : ntile - 1; IDX_LOADK(kc, t1); }
        for (int i = 0; i < cnt; ++i) {
            int pn = p;
            if (i + 1 < cnt) { pn = p + NWAVES; if (pn >= np) pn = pn % np; }
            { IDX_LOADK(na, 2 * pn); const int t1 = (2 * pn + 1 < ntile) ? 2 * pn + 1 : ntile - 1; IDX_LOADK(nc, t1); }
            IDX_SCORE(ka, 2 * p);
            if (2 * p + 1 < ntile) IDX_SCORE(kc, 2 * p + 1);
#pragma unroll
            for (int ks = 0; ks < 4; ++ks) { ka[ks] = na[ks]; kc[ks] = nc[ks]; }
            p = pn;
        }
    }
#undef IDX_LOADK
#undef IDX_SCORE
    __syncthreads();
    if (!(mode & 2)) { __syncthreads(); return; }
    const int q = wid >> 1, part = wid & 1;
    LAS unsigned* scq = sc + q * 8192;
    const int kk = (t0 + q + 1 < TOPK) ? (t0 + q + 1) : TOPK;
    const int nw = (n + 63) >> 6, nj = (nw - part + 1) >> 1;
    unsigned key[64];
#pragma unroll
    for (int g = 0; g < 8; ++g) {
        if (8 * g < nj) {
#pragma unroll
            for (int jj = 0; jj < 8; ++jj) { const int e = (2 * (8 * g + jj) + part) * 64 + lane; key[8 * g + jj] = (e < n) ? scq[e] : 0u; }
        } else {
#pragma unroll
            for (int jj = 0; jj < 8; ++jj) key[8 * g + jj] = 0u;
        }
    }
    const int sub = lane & 3;
    unsigned prefix = 0u, himask = 0u; int need = kk, n_eq = 0; bool done = false;
#pragma unroll 1
    for (int lvl = 0; lvl < 4; ++lvl) {
        const int shift = 24 - 8 * lvl;
        LAS unsigned* Hq = hist + (lvl & 1) * 2048 + q * 512;
        if (!done) {
#pragma unroll
            for (int g = 0; g < 8; ++g) {
                if (8 * g < nj) {
#pragma unroll
                    for (int jj = 0; jj < 8; ++jj) { const unsigned uu = key[8 * g + jj];
                        if (uu != 0u && (uu & himask) == prefix) { const unsigned d = (uu >> shift) & 255u;
                            __hip_atomic_fetch_add(Hq + ((d >> 1) << 2) + sub, (d & 1u) ? 65536u : 1u, __ATOMIC_RELAXED, __HIP_MEMORY_SCOPE_WORKGROUP); } }
                }
            }
        }
        __syncthreads();
        if (!done) {
            const u32x4g w0 = *(const LAS u32x4g*)(Hq + 8 * lane), w1 = *(const LAS u32x4g*)(Hq + 8 * lane + 4);
            const unsigned h0 = (w0.x & 0xffffu) + (w0.y & 0xffffu) + (w0.z & 0xffffu) + (w0.w & 0xffffu), h1 = (w0.x >> 16) + (w0.y >> 16) + (w0.z >> 16) + (w0.w >> 16);
            const unsigned h2 = (w1.x & 0xffffu) + (w1.y & 0xffffu) + (w1.z & 0xffffu) + (w1.w & 0xffffu), h3 = (w1.x >> 16) + (w1.y >> 16) + (w1.z >> 16) + (w1.w >> 16);
            const int lsum = (int)(h0 + h1 + h2 + h3);
            int incl = lsum;
#pragma unroll
            for (int o = 1; o < 64; o <<= 1) { const int t = __shfl_down(incl, o); if (lane + o < 64) incl += t; }
            const int S = incl - lsum;
            const bool has = (S < need) && (need <= incl);
            const int c3 = S + (int)h3, c2 = c3 + (int)h2, c1 = c2 + (int)h1;
            int bin, above, eqc;
            if (need <= c3) { bin = 3; above = S; eqc = (int)h3; } else if (need <= c2) { bin = 2; above = c3; eqc = (int)h2; } else if (need <= c1) { bin = 1; above = c2; eqc = (int)h1; } else { bin = 0; above = c1; eqc = (int)h0; }
            const unsigned long long bal = __ballot(has);
            const int src = (bal == 0ull) ? 0 : (__ffsll((long long)bal) - 1);
            bin = __shfl(4 * lane + bin, src); above = __shfl(above, src); n_eq = __shfl(eqc, src);
            prefix |= (unsigned)bin << shift; himask |= 255u << shift; need -= above;
            done = (need == n_eq);
        }
        { LAS unsigned* Hn = hist + ((lvl + 1) & 1) * 2048; Hn[F.tid] = 0u; Hn[F.tid + 512] = 0u; Hn[F.tid + 1024] = 0u; Hn[F.tid + 1536] = 0u; }
        __syncthreads();
    }
    const unsigned P = prefix;
    int idxs = 0x7fffffff;
    if (need < n_eq) {
        int running = 0;
        for (int c0 = 0; c0 < n; c0 += 64) {
            const int e = c0 + lane; const bool eq = (e < n) && (scq[e] == P);
            const unsigned long long bal = __ballot(eq); const int cnt2 = __popcll(bal);
            if (running + cnt2 >= need) {
                const int rank = __popcll(bal & ((1ull << lane) - 1ull)) + 1;
                const unsigned long long hit = __ballot(eq && (rank == need - running));
                idxs = c0 + (__ffsll((long long)hit) - 1); break; }
            running += cnt2;
        }
    }
    LAS unsigned long long* wrow = (LAS unsigned long long*)(hist) + wid * 64;
    wrow[lane] = 0ull;
#pragma unroll
    for (int g = 0; g < 8; ++g) {
        if (8 * g < nj) {
#pragma unroll
            for (int jj = 0; jj < 8; ++jj) { const int j = 8 * g + jj, e = (2 * j + part) * 64 + lane; const unsigned uu = key[j];
                const bool bsel = (uu > P) || (uu == P && e <= idxs && uu != 0u);
                const unsigned long long bal = __ballot(bsel);
                if (lane == 0) wrow[j] = bal; }
        }
    }
    MASK[(rb + t0 + q) * 128 + 2 * lane + part] = wrow[lane];
    __syncthreads();
}

constexpr int IDXC = 1024;
__device__ __forceinline__ int wave_total6(int c) { int t = 0;
#pragma unroll
    for (int bt = 0; bt < 6; ++bt) t += __popcll(__ballot((c >> bt) & 1)) << bt;
    return t; }
__device__ __forceinline__ int count_ge16(const unsigned (&e)[16], unsigned cand) {
    unsigned long long m0, m1, m2, m3, m4, m5, m6, m7;
#define CGE_(mm, j) asm("v_cmp_ge_u32_e64 %0, %1, %2" : "=s"(mm) : "v"(e[j]), "s"(cand))
    CGE_(m0, 0); CGE_(m1, 1); CGE_(m2, 2); CGE_(m3, 3); CGE_(m4, 4); CGE_(m5, 5); CGE_(m6, 6); CGE_(m7, 7);
    int c = ((__builtin_popcountll(m0) + __builtin_popcountll(m1)) + (__builtin_popcountll(m2) + __builtin_popcountll(m3))) + ((__builtin_popcountll(m4) + __builtin_popcountll(m5)) + (__builtin_popcountll(m6) + __builtin_popcountll(m7)));
    CGE_(m0, 8); CGE_(m1, 9); CGE_(m2, 10); CGE_(m3, 11); CGE_(m4, 12); CGE_(m5, 13); CGE_(m6, 14); CGE_(m7, 15);
#undef CGE_
    c += ((__builtin_popcountll(m0) + __builtin_popcountll(m1)) + (__builtin_popcountll(m2) + __builtin_popcountll(m3))) + ((__builtin_popcountll(m4) + __builtin_popcountll(m5)) + (__builtin_popcountll(m6) + __builtin_popcountll(m7)));
    return c;
}
__device__ __forceinline__ unsigned kth_largest16(const unsigned (&e)[16], int m, int total, int& cge_out, const int minbit = 0) {
    unsigned P = 0u; int cge = total;
#pragma unroll 1
    for (int bit = 31; bit >= minbit && cge != m; --bit) {
        const unsigned cand = P | (1u << bit);
        const int c = count_ge16(e, cand);
        if (c >= m) { P = cand; cge = c; }
    }
    cge_out = cge; return P;
}
__device__ __forceinline__ void xhalf_swap2(float& a, float& b) { asm volatile("s_nop 1\n\tv_permlane32_swap_b32 %0, %1\n\ts_nop 1" : "+v"(a), "+v"(b)); }
__device__ __forceinline__ float unsortable_key(unsigned u) { return __builtin_bit_cast(float, (u & 0x80000000u) ? (u & 0x7fffffffu) : ~u); }
typedef short i16_bf16x8v __attribute__((ext_vector_type(8)));
__device__ __forceinline__ void idx_load_q(i16_bf16x8v (&qa)[4][4], int b, int t16, const bf16* QI) {
    int lane = mk_lane(); const int r32 = lane & 31, hi = lane >> 5;
#pragma unroll
    for (int g = 0; g < 4; ++g) {
        const bf16* qp = QI + ((size_t)b * SEQ + 16 * t16 + 4 * g + (r32 >> 3)) * 512 + (r32 & 7) * 64 + hi * 8;
#pragma unroll
        for (int ks = 0; ks < 4; ++ks) qa[g][ks] = *(const i16_bf16x8v*)(qp + ks * 16);
    }
}
__device__ __forceinline__ void idx_unit16(Frame& F, int b, int t16, const bf16* QI, const bf16* KI, const float* WI, unsigned long long* MASK, int rot, i16_bf16x8v (&qa)[4][4], const int nb, const int nt16, const int mode = 3) {
    typedef short bf16x8v __attribute__((ext_vector_type(8))); typedef float f32x16v __attribute__((ext_vector_type(16)));
    LAS unsigned long long* be = (LAS unsigned long long*)(F.lds);
    LAS int* cnw = (LAS int*)(F.lds + 131072);
    LAS float* tau = (LAS float*)(F.lds + 131072 + 512);
    LAS int* flg = (LAS int*)(F.lds + 131072 + 576);
    LAS float* wl = (LAS float*)(F.lds + 132096);
    LAS unsigned* rows = (LAS unsigned*)(F.lds + 133120) + F.wave * 256;
    LAS unsigned long long* dump = (LAS unsigned long long*)(F.lds + 141312) + F.wave * 64;
    int lane = F.lane; asm volatile("" : "+v"(lane));
    const int tidv = F.wave * 64 + lane; const int r32 = lane & 31, hi = lane >> 5, wid = F.wave;
    const int t0 = 16 * t16, ntile = (t0 + 16 + 31) >> 5, npair = (ntile + 1) >> 1, nblk = (npair + 7) >> 3;
    const size_t rb = (size_t)b * SEQ;
    if (tidv < 16) { tau[tidv] = -INFINITY; flg[tidv] = 0; }
    if (tidv < 128) wl[tidv] = WI[(rb + t0) * 8 + tidv];
    __syncthreads();
    int cw[16];
#pragma unroll
    for (int i = 0; i < 16; ++i) cw[i] = 0;
#define I16_LOADK(dst, tile_) do { const bf16* kp_ = KI + ((rb >> 5) + (tile_)) * 2048 + (hi * 32 + r32) * 8; _Pragma("unroll") for (int ks = 0; ks < 4; ++ks) dst[ks] = *(const bf16x8v*)(kp_ + ks * 512); } while (0)
#define I16_TILE2(kfa, kfb, pair_, causal_) do { const int key = (pair_) * 64 + lane; LAS unsigned long long* dmp_ = dump + lane; \
        f32x4 w4n[4]; _Pragma("unroll") for (int q_ = 0; q_ < 4; ++q_) w4n[q_] = *(const LAS f32x4*)(wl + q_ * 8 + 4 * hi); \
        _Pragma("unroll") for (int g = 0; g < 4; ++g) { f32x16v acca = {}, accb = {}; \
            _Pragma("unroll") for (int ks = 0; ks < 4; ++ks) acca = __builtin_amdgcn_mfma_f32_32x32x16_bf16(qa[g][ks], kfa[ks], acca, 0, 0, 0); \
            _Pragma("unroll") for (int ks = 0; ks < 4; ++ks) accb = __builtin_amdgcn_mfma_f32_32x32x16_bf16(qa[g][ks], kfb[ks], accb, 0, 0, 0); \
            f32x4 w4c[4]; _Pragma("unroll") for (int q_ = 0; q_ < 4; ++q_) w4c[q_] = w4n[q_]; const f32x4 tq4 = *(const LAS f32x4*)(tau + 4 * g); \
            if (g < 3) { _Pragma("unroll") for (int q_ = 0; q_ < 4; ++q_) w4n[q_] = *(const LAS f32x4*)(wl + (4 * (g + 1) + q_) * 8 + 4 * hi); } \
            float ss_[4]; \
            _Pragma("unroll") for (int q_ = 0; q_ < 4; ++q_) { const int qq = 4 * g + q_; const f32x4 w4 = w4c[q_]; \
                  \
                  \
                float la = w4.x * acca[4 * q_], ma = w4.x * __builtin_fabsf(acca[4 * q_]); \
                la = __builtin_fmaf(w4.y, acca[4 * q_ + 1], la); ma = __builtin_fmaf(w4.y, __builtin_fabsf(acca[4 * q_ + 1]), ma); \
                la = __builtin_fmaf(w4.z, acca[4 * q_ + 2], la); ma = __builtin_fmaf(w4.z, __builtin_fabsf(acca[4 * q_ + 2]), ma); \
                la = __builtin_fmaf(w4.w, acca[4 * q_ + 3], la); ma = __builtin_fmaf(w4.w, __builtin_fabsf(acca[4 * q_ + 3]), ma); \
                float lb = w4.x * accb[4 * q_], mb = w4.x * __builtin_fabsf(accb[4 * q_]); \
                lb = __builtin_fmaf(w4.y, accb[4 * q_ + 1], lb); mb = __builtin_fmaf(w4.y, __builtin_fabsf(accb[4 * q_ + 1]), mb); \
                lb = __builtin_fmaf(w4.z, accb[4 * q_ + 2], lb); mb = __builtin_fmaf(w4.z, __builtin_fabsf(accb[4 * q_ + 2]), mb); \
                lb = __builtin_fmaf(w4.w, accb[4 * q_ + 3], lb); mb = __builtin_fmaf(w4.w, __builtin_fabsf(accb[4 * q_ + 3]), mb); \
                float sa = la + ma, sb = lb + mb; xhalf_swap2(sa, sb); \
                ss_[q_] = sa + sb; } \
            _Pragma("unroll") for (int q_ = 0; q_ < 4; ++q_) { const int qq = 4 * g + q_; const float s = ss_[q_];                                    \
                const float tq_ = q_ == 0 ? tq4.x : q_ == 1 ? tq4.y : q_ == 2 ? tq4.z : tq4.w; const bool pass = s >= tq_;                                                    \
                const unsigned long long bal = __builtin_amdgcn_ballot_w64(pass); \
                int pos_ = cw[qq] + (int)__builtin_amdgcn_mbcnt_hi((unsigned)(bal >> 32), __builtin_amdgcn_mbcnt_lo((unsigned)bal, 0u)); \
                pos_ = pos_ < 127 ? pos_ : 127;                                    \
                LAS unsigned long long* dst_ = pass ? (be + (qq * 8 + wid) * 128 + pos_) : dmp_; \
                *dst_ = (unsigned long long)__builtin_bit_cast(unsigned, s) | ((unsigned long long)(unsigned)key << 32); \
                cw[qq] += __popcll(bal); } } } while (0)
#define I16_PASS(sample_) do { bf16x8v ka[4], kb2[4], na[4], nb2[4]; int bb = -1, nb_ = -1; \
        for (int x = 0; x < nblk; ++x) { const int c_ = (sample_) ? x : ((x + rot) % nblk); if ((((c_ & 7) == 0) == (sample_)) && 8 * c_ + wid < npair) { bb = c_; nb_ = x; break; } } \
        if (bb >= 0) { const int p_ = 8 * bb + wid; I16_LOADK(ka, 2 * p_); I16_LOADK(kb2, (2 * p_ + 1 < ntile) ? 2 * p_ + 1 : ntile - 1); } \
        while (bb >= 0) { int nx = -1, nxi = -1; \
            for (int x = nb_ + 1; x < nblk; ++x) { const int c_ = (sample_) ? x : ((x + rot) % nblk); if ((((c_ & 7) == 0) == (sample_)) && 8 * c_ + wid < npair) { nx = c_; nxi = x; break; } } \
            { const int p_ = 8 * (nx >= 0 ? nx : bb) + wid; I16_LOADK(na, 2 * p_); I16_LOADK(nb2, (2 * p_ + 1 < ntile) ? 2 * p_ + 1 : ntile - 1); } \
            I16_TILE2(ka, kb2, 8 * bb + wid, true); \
            _Pragma("unroll") for (int ks = 0; ks < 4; ++ks) { ka[ks] = na[ks]; kb2[ks] = nb2[ks]; } \
            bb = nx; nb_ = nxi; } } while (0)
#define I16_PUBLISH() do { _Pragma("unroll") for (int i = 0; i < 16; ++i) { if (lane == 0) { cnw[i * 8 + wid] = cw[i] < 128 ? cw[i] : 128; if (cw[i] > 128) flg[i] = 1; } } } while (0)
#define I16_LOAD_LIST(qq_, e_, ix_, total_) do { total_ = 0; const u32x4g c0_ = *(const LAS u32x4g*)(cnw + (qq_) * 8), c1_ = *(const LAS u32x4g*)(cnw + (qq_) * 8 + 4); \
          \
        _Pragma("unroll") for (int j = 0; j < 16; ++j) { const int sg = j >> 1, p = (j & 1) * 64 + lane; \
            const int cs = (int)(sg == 0 ? c0_.x : sg == 1 ? c0_.y : sg == 2 ? c0_.z : sg == 3 ? c0_.w : sg == 4 ? c1_.x : sg == 5 ? c1_.y : sg == 6 ? c1_.z : c1_.w); \
            const unsigned long long en_ = be[((qq_) * 8 + sg) * 128 + p]; unsigned r_ = (unsigned)en_, x_ = (unsigned)(en_ >> 32); asm volatile("" : "+v"(r_), "+v"(x_));     \
            const bool ok_ = (p < cs) && ((int)x_ <= t0 + (qq_)); total_ += __popcll(__ballot(ok_)); e_[j] = ok_ ? sortable_key(__builtin_bit_cast(float, r_)) : 0u; ix_[j] = ok_ ? (unsigned short)x_ : (unsigned short)0xffff; } \
        } while (0)
    I16_PASS(true);
    I16_PUBLISH();
    __syncthreads();
    if (mode == 4) return;
#ifndef PROBE_TAU_REP
#define PROBE_TAU_REP 1
#endif
#pragma unroll 1
    for (int w2 = 0; w2 < 2 * PROBE_TAU_REP; ++w2) {
        const int qq = 2 * wid + (w2 & 1), nc = t0 + qq + 1, kk = nc < TOPK ? nc : TOPK;
        if (nc > IDXC) {
            unsigned e[16]; unsigned short ix[16]; int ns;
            I16_LOAD_LIST(qq, e, ix, ns);
            const float mu = (float)kk * (float)ns / (float)nc; const int m = __builtin_amdgcn_readfirstlane((int)(mu + 5.f * sqrtf(mu) + 9.f));
            if (m < ns) { int cge; const unsigned P = kth_largest16(e, m, ns, cge, 15); if (lane == 0) tau[qq] = unsortable_key(P); }
        }
    }
    __syncthreads();
    if (mode == 8) return;
#pragma unroll
    for (int i = 0; i < 16; ++i) { const float tv = tau[i];
        if (tv != -INFINITY) { const int cs = cw[i] < 128 ? cw[i] : 128; LAS unsigned long long* sk = be + (i * 8 + wid) * 128;
            const unsigned long long e0 = sk[lane], e1 = sk[lane + 64];
            const bool k0 = (lane < cs) && (__builtin_bit_cast(float, (unsigned)e0) >= tv), k1 = (lane + 64 < cs) && (__builtin_bit_cast(float, (unsigned)e1) >= tv); const unsigned long long b0 = __ballot(k0), b1 = __ballot(k1);
            const int p0 = (int)__builtin_amdgcn_mbcnt_hi((unsigned)(b0 >> 32), __builtin_amdgcn_mbcnt_lo((unsigned)b0, 0u)), n0 = __popcll(b0);
            const int p1 = n0 + (int)__builtin_amdgcn_mbcnt_hi((unsigned)(b1 >> 32), __builtin_amdgcn_mbcnt_lo((unsigned)b1, 0u));
            if (k0) sk[p0] = e0; if (k1) sk[p1] = e1;
            cw[i] = n0 + __popcll(b1); } }
    I16_PASS(false);
    I16_PUBLISH();
    if (nt16 >= 0) idx_load_q(qa, nb, nt16, QI);
    __syncthreads();
    if (!(mode & 2)) return;
#undef I16_PASS
#undef I16_TILE2
#undef I16_LOADK
#undef I16_PUBLISH
#pragma unroll 1
    for (int w2 = 0; w2 < 2; ++w2) {
        const int qq = 2 * wid + w2, nc = t0 + qq + 1, kk = nc < TOPK ? nc : TOPK;
        unsigned e[16]; unsigned short ix[16]; int c;
        I16_LOAD_LIST(qq, e, ix, c);
#ifdef PROBE_FORCE_FALLBACK
        if ((t16 % 5) == 1 && (qq & 4)) { if (lane == 0) flg[qq] = 1; continue; }
#endif
        if (c < kk || flg[qq]) { if (lane == 0) flg[qq] = 1; continue; }
        int cge; const unsigned P = kth_largest16(e, kk, c, cge);
        int ilim = 0xffff;
        if (cge > kk) {
            int cgt = 0;
#pragma unroll
            for (int j = 0; j < 16; ++j) cgt += (e[j] > P) ? 1 : 0;
            cgt = wave_total6(cgt);
            const int need = kk - cgt; int I = 0;
#pragma unroll 1
            for (int bit = 12; bit >= 0; --bit) { const int cand = I | (1 << bit); int c2 = 0;
#pragma unroll
                for (int j = 0; j < 16; ++j) c2 += (e[j] == P && (int)ix[j] < cand) ? 1 : 0;
                c2 = wave_total6(c2);
                if (c2 < need) I = cand; }
            ilim = I;
        }
        rows[lane] = 0u; rows[lane + 64] = 0u; rows[lane + 128] = 0u; rows[lane + 192] = 0u;
#pragma unroll
        for (int j = 0; j < 16; ++j) { const bool sel = (e[j] > P && e[j] != 0u) || (e[j] == P && e[j] != 0u && (int)ix[j] <= ilim);
            if (sel) __hip_atomic_fetch_or(rows + (ix[j] >> 5), 1u << (ix[j] & 31), __ATOMIC_RELAXED, __HIP_MEMORY_SCOPE_WORKGROUP); }
        const u32x4g rv = *(const LAS u32x4g*)(rows + 4 * lane);
        *(u32x4g*)((unsigned*)(MASK + (rb + t0 + qq) * 128) + 4 * lane) = rv;
    }
#undef I16_LOAD_LIST
    __syncthreads();
    { int fl = (flg[0] | flg[1] | flg[2] | flg[3]) | ((flg[4] | flg[5] | flg[6] | flg[7]) << 1) | ((flg[8] | flg[9] | flg[10] | flg[11]) << 2) | ((flg[12] | flg[13] | flg[14] | flg[15]) << 3);
      fl = __builtin_amdgcn_readfirstlane(fl);
      __syncthreads();
#ifndef PROBE_NO_FALLBACK
#pragma unroll 1
      for (int g = 0; g < 4; ++g) if ((fl >> g) & 1) idx_unit(F, b, 4 * t16 + g, QI, KI, WI, MASK, rot);
#endif
      if (fl != 0 && nt16 >= 0) idx_load_q(qa, nb, nt16, QI);
    }
}

struct Args { const float* in[22]; float* out; unsigned char* ws; int ph_lo, ph_hi, li, pad; };
__global__ void __launch_bounds__(NWAVES * 64, 2) fwd_mega(Args args) {
    extern __shared__ __attribute__((aligned(16))) unsigned char lds[];
    Frame F;
    F.lds = (LAS unsigned char*)lds;
    F.MISC = (volatile LAS unsigned*)(F.lds + MISC_OFF);
    F.wave = __builtin_amdgcn_readfirstlane((int)threadIdx.x >> 6); F.lane = mk_lane(); F.tid = F.wave * 64 + F.lane;
#define REFRESH_IDS() do { F.lane = mk_lane(); F.tid = F.wave * 64 + F.lane; } while (0)
    F.G = gridDim.x; { const int bx = blockIdx.x; F.vcu = (F.G % 8 == 0) ? (bx % 8) * (F.G / 8) + bx / 8 : bx; }
    unsigned char* ws = args.ws; F.ws = ws; F.out = args.out;
    F.ctl = (gu32*)(ws + WS_CTL);
    for (int u = F.tid; u < (LDS_BYTES - LDSCTL_OFF) / 4; u += NWAVES * 64) ((LAS unsigned*)(F.lds + LDSCTL_OFF))[u] = 0u;
    __syncthreads();
    XcdBarrier bar; bar.wave = F.wave; bar.bar = (unsigned*)(F.ctl + CW_BAR); bar.x = 0; bar.st = nullptr;
    if (N_LAUNCHES == 1) bar = xcd_barrier_post((unsigned*)(F.ctl + CW_BAR), F.MISC + 8, F.wave);
#ifdef PROBE_DOUBLE_BAR
#define GRID_BAR() do { if (N_LAUNCHES == 1) { xcd_barrier(bar); xcd_barrier(bar); } } while (0)
#else
#define GRID_BAR() do { if (N_LAUNCHES == 1) xcd_barrier(bar); } while (0)
#endif
    const int lo = args.ph_lo, hi = args.ph_hi;
#define IN(k) (lo <= (k) && (k) < hi)
#ifdef PROBE_REPEAT
#define PREP(k) int nrep_##k = ((PROBE_REPEAT == (k)) ? 2 : 1); asm volatile("" : "+s"(nrep_##k)); _Pragma("unroll 1") for (int rep_ = 0; rep_ < nrep_##k; ++rep_)
#else
#define PREP(k) for (int rep_ = 0; rep_ < 1; ++rep_)
#endif
#define BOTH(k) (IN(k) && IN((k) + 1))

    bf16* Wgu = (bf16*)(ws + WS_WGU); bf16* Wd = (bf16*)(ws + WS_WD); bf16* WinA = (bf16*)(ws + WS_WINA); bf16* WinB = (bf16*)(ws + WS_WINB);
    bf16* Wbr = (bf16*)(ws + WS_WBR); bf16* Wout = (bf16*)(ws + WS_WOUT);
    bf16* H = (bf16*)(ws + WS_H); bf16* A = (bf16*)(ws + WS_BIG);
    bf16* Q16 = (bf16*)(ws + WS_Q16); bf16* K16 = (bf16*)(ws + WS_K16); bf16* V16 = (bf16*)(ws + WS_V16); bf16* SG = K16;
    bf16* QI = (bf16*)(ws + WS_QI); bf16* KI = (bf16*)(ws + WS_KI); float* WI = (float*)(ws + WS_WI); float* LF = (float*)(ws + WS_LF); float* F2 = (float*)(ws + WS_F2);
    unsigned long long* MASK = (unsigned long long*)(ws + WS_MASK);
    const float* mod = (const float*)(ws + WS_MOD);
    bf16* X1B = (bf16*)F.out;
    bf16* X2B = (bf16*)(ws + WS_V16);

    if (IN(0)) { REFRESH_IDS();
#if defined(PROBE_REPEAT) && PROBE_REPEAT == 100
      for (int rep_ = 0; rep_ < 2; ++rep_) {
#else
      {
#endif
#ifdef PROBE_P0_NOGEMV
        if (rep_ == 1) {
#else
        {
#endif
        if ((int)blockIdx.x < 72) mod_gemv(F, (int)blockIdx.x, args.in[1], args.in[2], args.in[3]);
        }
        if ((int)blockIdx.x == 80 && F.tid < 264) { float* gd = (float*)(ws + WS_GAINS); const int t = F.tid;
            if (t == 0) { float mq = 0.f, mk = 0.f; for (int d = 0; d < 64; ++d) { mq = fmaxf(mq, fabsf(args.in[13][d])); mk = fmaxf(mk, fabsf(args.in[14][d])); } gd[264] = 64.f * 0.125f * 1.4426950408889634f * mq * mk; }
            if (t == 1) { float mq = 0.f, mk = 0.f; for (int d = 0; d < 64; ++d) { mq = fmaxf(mq, fabsf(args.in[11][d])); mk = fmaxf(mk, fabsf(args.in[12][d])); } gd[265] = 64.f * 0.125f * 1.4426950408889634f * mq * mk; }
            gd[t] = (t < 64) ? args.in[11][t] : (t < 128) ? args.in[12][t - 64] : (t < 192) ? args.in[13][t - 128] : (t < 256) ? args.in[14][t - 192] : args.in[10][t - 256]; }
#ifdef PROBE_P0_NOBUILD
        if ((int)blockIdx.x == 81 && rep_ == 1) build_attn_queues(F, args.in[10], args.in[13], args.in[14]);
#else
        if ((int)blockIdx.x == 81) build_attn_queues(F, args.in[10], args.in[13], args.in[14]);
#endif
        int base = 0;
        base = transpose_job64<true>(F, J_GU, args.in[5], args.in[6], Wgu, 2 * D_FF, D_MODEL, base, 32.f);
        base = transpose_job64<true>(F, J_D, args.in[7], nullptr, Wd, D_MODEL, D_FF, base, 64.f);
        base = transpose_job64<true>(F, J_INA, args.in[9], nullptr, ws + WS_WINA + 2 * MiB, 3072, D_MODEL, base, 32.f);
        base = transpose_job64<false>(F, J_INA, args.in[9], nullptr, WinA, 768, D_MODEL, base, 1.f, 48);
        base = transpose_job64<true>(F, J_INB, args.in[9], nullptr, WinB, 2048, D_MODEL, base, 32.f);
        base = transpose_job64<true>(F, J_BR, args.in[15], args.in[16], Wbr, 2048, D_MODEL, base, 32.f);
        base = transpose_job64<true>(F, J_OUT, args.in[17], nullptr, Wout, D_MODEL, D_MODEL, base, 32.f);
#ifdef PROBE_REPEAT
        __syncthreads();
#endif
      }
        if (BOTH(0)) GRID_BAR();
    }
    if (IN(1)) { REFRESH_IDS(); norm_phase8(F, args.in[0], args.in[4], 0, (unsigned char*)H); if (BOTH(1)) GRID_BAR(); }
    if (IN(2)) { REFRESH_IDS();
        pg8::Gemm g{H, Wgu, M, 2 * D_FF, D_MODEL / 2}; pg8::StaticOrder S; S.init(M, 2 * D_FF, F.G, (int)blockIdx.x);
        pg8::EpiSwiglu8 E{(unsigned char*)A, D_FF, 1.0f / 32.0f};
        pg8::gemm_phase<pg8::EpiSwiglu8, pg8::StaticOrder, true, true, true>(F.lds, g, S, E, F.wave);
#if defined(PROBE_REPEAT) && PROBE_REPEAT == 2
        __syncthreads(); pg8::gemm_phase<pg8::EpiSwiglu8, pg8::StaticOrder, true, true, true>(F.lds, g, S, E, F.wave);
#endif
        if (BOTH(2)) GRID_BAR();
    }
    if (IN(3)) { REFRESH_IDS();
        pg8::Gemm g{A, Wd, M, D_MODEL, D_FF / 2}; pg8::StaticOrder S; S.init(M, D_MODEL, F.G, (int)blockIdx.x);
        pg8::EpiResidT<false, true> E{args.in[0], X1B, mod + 2 * 1024, 0.5f / 64.0f};
        pg8::gemm_phase<pg8::EpiResidT<false, true>, pg8::StaticOrder, true, true, true>(F.lds, g, S, E, F.wave);
        if (BOTH(3)) GRID_BAR();
    }
    if (IN(4)) { REFRESH_IDS();
#if defined(PROBE_REPEAT) && PROBE_REPEAT == 104
      for (int rep_ = 0; rep_ < 2; ++rep_) {
#else
      {
#endif
        norm_phase<true>(F, X1B, args.in[8], 3, H, ws + WS_H8B);
      }
        if (BOTH(4)) GRID_BAR();
    }
    if (IN(5)) { REFRESH_IDS();
      PREP(5) {
        { pg8::Gemm g{H, WinA, M, 768, D_MODEL}; pg8::StaticOrder S; S.init(M, 768, F.G, (int)blockIdx.x);
          pg8::EpiInA E{Q16, QI, KI, WI, LF, (const float*)(ws + WS_GAINS), 12, 1.0f};
          pg8::gemm_phase<pg8::EpiInA, pg8::StaticOrder, true, true>(F.lds, g, S, E, F.wave); }
        { pg8::Gemm g{(const bf16*)(ws + WS_H8B), (const bf16*)(ws + WS_WINA + 2 * MiB), M, 3072, D_MODEL / 2}; pg8::StaticOrder S; S.init(M, 3072, F.G, (int)blockIdx.x);
          pg8::EpiInA E{Q16, QI, KI, WI, LF, (const float*)(ws + WS_GAINS), 0, 1.0f / 32.0f};
          pg8::gemm_phase<pg8::EpiInA, pg8::StaticOrder, true, true, true>(F.lds, g, S, E, F.wave); }
        __syncthreads(); }
        if (BOTH(5)) GRID_BAR();
    }
    if (IN(6)) { REFRESH_IDS();
        if ((int)blockIdx.x < 16 && F.wave == 0) fscan_row(LF + (size_t)blockIdx.x * SEQ, F2 + (size_t)blockIdx.x * SEQ, F.lane);
#ifdef PROBE_TWICE_P6
#pragma unroll 1
        for (int rep_ = 0; rep_ < 2; ++rep_) { int md = rep_ ? 3 : PROBE_TWICE_P6; asm volatile("" : "+s"(md));
#else
        { const int md = 3;
#endif
        i16_bf16x8v qa[4][4];
        { const int idx0 = F.vcu; if (idx0 < 1024) { const int j0 = 1023 - idx0; idx_load_q(qa, j0 & 1, j0 >> 1, QI); } }
#pragma unroll 1
        for (int i = 0; i * F.G < 1024; ++i) {
            const int idx = i * F.G + ((i & 1) ? (F.G - 1 - F.vcu) : F.vcu);
            if (idx >= 1024) continue;
            const int j = 1023 - idx;
            const int idxn = (i + 1) * F.G + (((i + 1) & 1) ? (F.G - 1 - F.vcu) : F.vcu), jn = 1023 - idxn;
            idx_unit16(F, j & 1, j >> 1, QI, KI, WI, MASK, F.vcu * 7 + i * 3, qa, jn & 1, idxn < 1024 ? (jn >> 1) : -1, md);
        }
        }
        if (BOTH(6)) GRID_BAR();
    }
    if (IN(7)) { REFRESH_IDS();
        const unsigned* ord = (const unsigned*)(ws + WS_AORDER); const float qmf = ((const float*)(ws + WS_GAINS))[264], qmd = ((const float*)(ws + WS_GAINS))[265];
        const int xg = (int)(blockIdx.x & 7);
      PREP(7) {
        int xs = 0;
        for (;;) {
            const int xq = (xg + xs) & 7;
            if (F.tid == 0) F.MISC[16] = __hip_atomic_fetch_add((unsigned*)(F.ctl + CW_AQUEUE + 64 * xq + 32 * rep_), 1u, __ATOMIC_RELAXED, __HIP_MEMORY_SCOPE_AGENT);
            __syncthreads();
            const unsigned qi = F.MISC[16];
            __syncthreads();
            if (qi >= ord[8 * AQ_CAP + xq]) { if (++xs == 8) break; continue; }
            const unsigned id = ord[xq * AQ_CAP + qi]; const int ty = (int)(id >> 9) & 1, b = (int)(id >> 8) & 1, h = (int)(id >> 5) & 7, qb = (int)(id & 31), pc = (int)(id >> 10) & 3, np = (int)(id >> 12) & 7;
#ifdef PROBE_SKIPTY
            if (rep_ == 0 && ty == PROBE_SKIPTY) continue;
#endif
            if (ty) { int np2, per; dsa_plan(h, qb, np2, per);
                      float* part = (float*)(ws + WS_H) + (size_t)((b * 2 + (h & 1)) * 16 + (qb & 15)) * (2 * 49 * 512);
                      att::attn_unit<1>(b, h, qb, Q16, K16, V16, ws + WS_O8, F2, MASK, (char*)lds, qmd, F.wave, pc, np, per, part, (unsigned*)(F.ctl + CW_PCTR + (b * 2 + (h & 1)) * 16 + (qb & 15) + 64 * rep_)); }
            else    att::attn_unit<0>(b, 8 + h, qb, Q16, K16, V16, ws + WS_O8, F2, MASK, (char*)lds, qmf, F.wave);
        }
      }
        REFRESH_IDS();
        ffn_copies_queue(F, F.ctl + CW_CQUEUE, args.in[19], args.in[20], args.in[21], Wgu, Wd);
        if (BOTH(7)) GRID_BAR();
    }
    if (IN(8)) { REFRESH_IDS();
        pg8::Gemm g{(const bf16*)(ws + WS_H8B), WinB, M, 2048, D_MODEL / 2}; pg8::StaticOrder S; S.init(M, 2048, F.G, (int)blockIdx.x);
        pg8::EpiGate E{SG, 1.0f / 32.0f};
        PREP(8) { pg8::gemm_phase<pg8::EpiGate, pg8::StaticOrder, true, true, true>(F.lds, g, S, E, F.wave); __syncthreads(); }
        if (BOTH(8)) GRID_BAR();
    }
    if (IN(9)) { REFRESH_IDS();
        pg8::Gemm g{(const bf16*)(ws + WS_O8), Wbr, M, 2048, D_MODEL / 2}; pg8::StaticOrder S; S.init(M, 2048, F.G, (int)blockIdx.x);
        pg8::EpiMerge E{SG, (unsigned char*)H, 1.0f / 32.0f};
        PREP(9) { pg8::gemm_phase<pg8::EpiMerge, pg8::StaticOrder, true, true, true>(F.lds, g, S, E, F.wave); __syncthreads(); }
        if (BOTH(9)) GRID_BAR();
    }
    if (IN(10)) { REFRESH_IDS();
        pg8::Gemm g{H, Wout, M, D_MODEL, D_MODEL / 2}; pg8::StaticOrder S; S.init(M, D_MODEL, F.G, (int)blockIdx.x);
        pg8::EpiResidT<true, true> E{X1B, X2B, mod + 5 * 1024, 1.0f / 32.0f};
        pg8::gemm_phase<pg8::EpiResidT<true, true>, pg8::StaticOrder, true, true, true>(F.lds, g, S, E, F.wave);
        if (BOTH(10)) GRID_BAR();
    }
    if (IN(11)) { REFRESH_IDS(); norm_phase8<true>(F, X2B, args.in[18], 6, (unsigned char*)H); if (BOTH(11)) GRID_BAR(); }
    if (IN(12)) { REFRESH_IDS();
        pg8::Gemm g{H, Wgu, M, 2 * D_FF, D_MODEL / 2}; pg8::StaticOrder S; S.init(M, 2 * D_FF, F.G, (int)blockIdx.x);
        pg8::EpiSwiglu8 E{(unsigned char*)A, D_FF, 1.0f / 32.0f};
        pg8::gemm_phase<pg8::EpiSwiglu8, pg8::StaticOrder, true, true, true>(F.lds, g, S, E, F.wave);
        if (BOTH(12)) GRID_BAR();
    }
    if (IN(13)) { REFRESH_IDS();
        pg8::Gemm g{A, Wd, M, D_MODEL, D_FF / 2}; pg8::StaticOrder S; S.init(M, D_MODEL, F.G, (int)blockIdx.x);
        pg8::EpiResidT<true, false> E{X2B, F.out, mod + 8 * 1024, 0.5f / 64.0f};
        pg8::gemm_phase<pg8::EpiResidT<true, false>, pg8::StaticOrder, true, true, true>(F.lds, g, S, E, F.wave);
    }
#undef IN
#undef BOTH
#undef GRID_BAR
}


#ifdef DBG_CHECK_MASK
__global__ void __launch_bounds__(512) dbg_check_mask(const unsigned char* ws, unsigned* counter) {
    __shared__ float s[8192];
    __shared__ float qv[512]; __shared__ float wv[8];
    const bf16* QI = (const bf16*)(ws + WS_QI); const bf16* KI = (const bf16*)(ws + WS_KI); const float* WI = (const float*)(ws + WS_WI);
    const unsigned long long* MASK = (const unsigned long long*)(ws + WS_MASK);
    const int b = blockIdx.x & 1, t = (int)(((unsigned)(blockIdx.x >> 1) * 2654435761u) % (unsigned)SEQ);
    if (t >= SEQ) return;
    const size_t rb = (size_t)b * SEQ;
    for (int i = threadIdx.x; i < 512; i += 512) qv[i] = __builtin_bit_cast(float, (unsigned)QI[(rb + t) * 512 + i] << 16);
    if (threadIdx.x < 8) wv[threadIdx.x] = WI[(rb + t) * 8 + threadIdx.x];
    __syncthreads();
    const int n = t + 1;
    for (int e = threadIdx.x; e < n; e += 512) {
        float sc = 0.f;
        _Pragma("unroll 1") for (int i = 0; i < 8; ++i) { float x = 0.f; _Pragma("unroll 4") for (int d = 0; d < 64; ++d) x += qv[i * 64 + d] * __builtin_bit_cast(float, (unsigned)KI[((rb + e) >> 5) * 2048 + ((d >> 3) * 32 + ((rb + e) & 31)) * 8 + (d & 7)] << 16); sc += wv[i] * fmaxf(x, 0.f); }
        s[e] = sc + 0.f;
    }
    __syncthreads();
    const int kk = n < 256 ? n : 256;
    unsigned bad = 0;
    for (int e = threadIdx.x; e < SEQ; e += 512) {
        bool sel = false;
        if (e < n) { const float se = s[e]; int rank = 0; _Pragma("unroll 4") for (int j = 0; j < n; ++j) { const float sj = s[j]; rank += (sj > se || (sj == se && j < e)) ? 1 : 0; } sel = rank < kk; }
        const bool got = (MASK[(rb + t) * 128 + (e >> 6)] >> (e & 63)) & 1ull;
        if (sel != got) ++bad;
    }
    if (bad) atomicAdd(counter, bad);
}
__global__ void dbg_report(float* out, const unsigned* counter) {
    const unsigned m = *counter; if (m == 0) return;
    int lg = 0; unsigned v = m; while (v > 1) { v >>= 1; ++lg; }
    out[0] += 100.f * (float)(1 + lg);
}
#endif

#ifdef DBG_CHECK_ATT
__device__ __forceinline__ float dbg_bf(unsigned short v) { return __builtin_bit_cast(float, (unsigned)v << 16); }
__device__ __forceinline__ void dbg_sample(int s, int& b, int& t, int& h) { b = s & 1; h = (s >> 1) & 15; t = (int)(((unsigned)(s >> 5) * 2654435761u + (unsigned)(s & 31) * 40503u) % (unsigned)SEQ); }
__global__ void dbg_save_q(const unsigned char* ws, float* save) {
    int b, t, h; dbg_sample(blockIdx.x, b, t, h);
    const bf16* Q16 = (const bf16*)(ws + WS_Q16);
    if (threadIdx.x < 64) save[blockIdx.x * 64 + threadIdx.x] = dbg_bf(Q16[((size_t)b * SEQ + t) * 1024 + h * 64 + threadIdx.x]);
}
__global__ void __launch_bounds__(256) dbg_check_att(const unsigned char* ws, const float* save, unsigned* counter) {
    __shared__ float lg[8192]; __shared__ int sel[512]; __shared__ int nsel; __shared__ float q[64]; __shared__ float red[2]; __shared__ float rm[256];
    int b, t, h; dbg_sample(blockIdx.x, b, t, h);
    const bf16* O16 = (const bf16*)(ws + WS_Q16); const bf16* K16 = (const bf16*)(ws + WS_K16); const bf16* V16 = (const bf16*)(ws + WS_V16);
    const unsigned long long* MASK = (const unsigned long long*)(ws + WS_MASK); const float* F2 = (const float*)(ws + WS_F2);
    const size_t rb = (size_t)b * SEQ;
    if (threadIdx.x < 64) q[threadIdx.x] = save[blockIdx.x * 64 + threadIdx.x];
    __syncthreads();
    const int n = t + 1;
    if (h < 8) {
        const float sl2 = exp2f(-(float)(h + 1)) * 1.4426950408889634f;
        for (int s = threadIdx.x; s < n; s += 256) { float x = -INFINITY;
            if ((MASK[(rb + t) * 128 + (s >> 6)] >> (s & 63)) & 1ull) { x = 0.f; _Pragma("unroll 4") for (int d = 0; d < 64; ++d) x += q[d] * dbg_bf(K16[(rb + s) * 1024 + h * 64 + d]); x += sl2 * (float)(s - t); }
            lg[s] = x; }
    } else {
        const float* f2 = F2 + ((size_t)b * 8 + (h - 8)) * SEQ; const float fq = f2[t];
        for (int s = threadIdx.x; s < n; s += 256) { float x = 0.f; _Pragma("unroll 4") for (int d = 0; d < 64; ++d) x += q[d] * dbg_bf(K16[(rb + s) * 1024 + h * 64 + d]); lg[s] = x + fq - f2[s]; }
    }
    __syncthreads();
    { float m = -INFINITY; for (int s = threadIdx.x; s < n; s += 256) m = fmaxf(m, lg[s]); rm[threadIdx.x] = m; }
    __syncthreads();
    if (threadIdx.x == 0) { float m = -INFINITY; for (int i = 0; i < 256; ++i) m = fmaxf(m, rm[i]); red[0] = m; }
    __syncthreads();
    { float l = 0.f; for (int s = threadIdx.x; s < n; s += 256) { const float p = exp2f(lg[s] - red[0]); lg[s] = p; l += p; } rm[threadIdx.x] = l; }
    __syncthreads();
    if (threadIdx.x == 0) { float l = 0.f; for (int i = 0; i < 256; ++i) l += rm[i]; red[1] = l; }
    __syncthreads();
    if (threadIdx.x < 64) { const int d = threadIdx.x; float o = 0.f;
        for (int s = 0; s < n; ++s) { const float p = lg[s]; if (p != 0.f) o += p * dbg_bf(V16[(rb + s) * 1024 + h * 64 + d]); }
        o /= red[1];
        const float got = dbg_bf(O16[(rb + t) * 1024 + h * 64 + d]);
        if (!(fabsf(got - o) <= 0.03f + 0.03f * fabsf(o))) atomicAdd(counter + (h < 8 ? 0 : 1), 1u); }
    (void)sel; (void)nsel;
}
__global__ void __launch_bounds__(256) dbg_check_proj(const unsigned char* ws, const float* w_in, unsigned* counter) {
    const bf16* H = (const bf16*)(ws + WS_H); const bf16* QI = (const bf16*)(ws + WS_QI); const bf16* KI = (const bf16*)(ws + WS_KI); const float* WI = (const float*)(ws + WS_WI);
    const int m = (blockIdx.x * 131 + 17) & (M - 1);
    __shared__ float hrow[1024];
    for (int i = threadIdx.x; i < 1024; i += 256) hrow[i] = dbg_bf(H[(size_t)m * 1024 + i]);
    __syncthreads();
    for (int c = threadIdx.x; c < 584; c += 256) {
        const int col = 3072 + c; float z = 0.f;
        _Pragma("unroll 4") for (int k2 = 0; k2 < 1024; ++k2) z += hrow[k2] * w_in[(size_t)k2 * IN_WIDTH + col];
        float got, ref;
        if (c < 512) { ref = z * 0.125f; got = dbg_bf(QI[(size_t)m * 512 + c]); }
        else if (c < 576) { ref = z; got = dbg_bf(KI[(size_t)m * 64 + (c - 512)]); }
        else { ref = z * 0.35355339059327373f; got = WI[(size_t)m * 8 + (c - 576)]; }
        const float tol = (c < 512 ? 0.125f : 1.f) * 0.04f + 0.02f * fabsf(ref);
        if (!(fabsf(got - ref) <= tol)) atomicAdd(counter + 2, 1u);
    }
}

__global__ void __launch_bounds__(256) dbg_check_qkv(const unsigned char* ws, const float* w_in, unsigned* counter) {
    const bf16* H = (const bf16*)(ws + WS_H); const bf16* QKV = (const bf16*)(ws + WS_Q16); const float* gains = (const float*)(ws + WS_GAINS);
    const int m = (blockIdx.x * 257 + 5) & (M - 1);
    __shared__ float hrow[1024]; __shared__ float zs[3072];
    for (int i = threadIdx.x; i < 1024; i += 256) hrow[i] = dbg_bf(H[(size_t)m * 1024 + i]);
    __syncthreads();
    for (int c = threadIdx.x; c < 3072; c += 256) { float z = 0.f; _Pragma("unroll 4") for (int k2 = 0; k2 < 1024; ++k2) z += hrow[k2] * w_in[(size_t)k2 * IN_WIDTH + c]; zs[c] = z; }
    __syncthreads();
    for (int c = threadIdx.x; c < 3072; c += 256) {
        const int sec = c >> 9, head = (c >> 6) & 7, d = c & 63;
        float ref = zs[c], scale = 1.f;
        if (sec != 2 && sec != 5) { float ss = 0.f; for (int j = 0; j < 64; ++j) { const float v = zs[(c & ~63) + j]; ss += v * v; }
            const float rstd = 1.f / sqrtf(ss / 64.f + 1e-6f); const int gi = sec - (sec >= 3 ? 1 : 0);
            ref = ref * rstd * gains[64 * gi + d]; if (sec == 0 || sec == 3) { ref *= 0.125f * 1.4426950408889634f; scale = 0.18f; } }
        const int which = (sec == 0 || sec == 3) ? 0 : (sec == 1 || sec == 4) ? 1 : 2;
        const float got = dbg_bf(QKV[(size_t)which * 16777216 + (size_t)m * 1024 + (sec >= 3 ? 512 : 0) + head * 64 + d]);
        if (!(fabsf(got - ref) <= 0.04f * scale + 0.03f * fabsf(ref))) atomicAdd(counter + 3, 1u);
    }
}
__global__ void __launch_bounds__(256) dbg_check_gate(const unsigned char* ws, const float* w_in, unsigned* counter) {
    const bf16* H = (const bf16*)(ws + WS_H); const bf16* SG = (const bf16*)(ws + WS_K16);
    const int m = (blockIdx.x * 263 + 11) & (M - 1);
    __shared__ float hrow[1024];
    for (int i = threadIdx.x; i < 1024; i += 256) hrow[i] = dbg_bf(H[(size_t)m * 1024 + i]);
    __syncthreads();
    for (int c = threadIdx.x; c < 2048; c += 256) { float z = 0.f; _Pragma("unroll 4") for (int k2 = 0; k2 < 1024; ++k2) z += hrow[k2] * w_in[(size_t)k2 * IN_WIDTH + 3664 + c];
        const float ref = 1.f / (1.f + expf(-z)), got = dbg_bf(SG[(size_t)m * 2048 + c]);
        if (!(fabsf(got - ref) <= 0.02f)) { atomicAdd(counter + 4, 1u); if (atomicAdd(counter + 32 + blockIdx.x, 1u) == 0u) atomicAdd(counter + 8, 1u); atomicOr(counter + 9, 1u << (c >> 8)); } }
}
__global__ void __launch_bounds__(256) dbg_check_merge(const unsigned char* ws, const float* wbd, const float* wbf, unsigned* counter) {
    const bf16* Hm = (const bf16*)(ws + WS_H); const bf16* SG = (const bf16*)(ws + WS_K16); const bf16* O16 = (const bf16*)(ws + WS_Q16);
    const int m = (blockIdx.x * 269 + 3) & (M - 1);
    __shared__ float orow[1024];
    for (int i = threadIdx.x; i < 1024; i += 256) orow[i] = dbg_bf(O16[(size_t)m * 1024 + i]);
    __syncthreads();
    for (int c = threadIdx.x; c < 1024; c += 256) { float yd = 0.f, yf = 0.f;
        _Pragma("unroll 4") for (int k2 = 0; k2 < 512; ++k2) { yd += orow[k2] * wbd[(size_t)k2 * 1024 + c]; yf += orow[512 + k2] * wbf[(size_t)k2 * 1024 + c]; }
        const float ref = dbg_bf(SG[(size_t)m * 2048 + c]) * yd + dbg_bf(SG[(size_t)m * 2048 + 1024 + c]) * yf, got = dbg_bf(Hm[(size_t)m * 1024 + c]);
        if (!(fabsf(got - ref) <= 0.03f + 0.03f * fabsf(ref))) atomicAdd(counter + 5, 1u); }
}
__global__ void dbg_save_out(const float* out, float* save) { const int m = (blockIdx.x * 271 + 7) & (M - 1); for (int i = threadIdx.x; i < 1024; i += 256) save[blockIdx.x * 1024 + i] = out[(size_t)m * 1024 + i]; }
__global__ void __launch_bounds__(256) dbg_check_out(const unsigned char* ws, const float* out, const float* save, const float* w_out, unsigned* counter) {
    const bf16* Hm = (const bf16*)(ws + WS_H); const float* mod = (const float*)(ws + WS_MOD);
    const int m = (blockIdx.x * 271 + 7) & (M - 1), b = m >> 13;
    __shared__ float hrow[1024];
    for (int i = threadIdx.x; i < 1024; i += 256) hrow[i] = dbg_bf(Hm[(size_t)m * 1024 + i]);
    __syncthreads();
    for (int c = threadIdx.x; c < 1024; c += 256) { float z = 0.f; _Pragma("unroll 4") for (int k2 = 0; k2 < 1024; ++k2) z += hrow[k2] * w_out[(size_t)k2 * 1024 + c];
        const float ref = save[blockIdx.x * 1024 + c] + mod[b * 9216 + 5 * 1024 + c] * z, got = out[(size_t)m * 1024 + c];
        if (!(fabsf(got - ref) <= 0.02f + 0.01f * fabsf(ref))) atomicAdd(counter + 6, 1u); }
}

__global__ void __launch_bounds__(256) dbg_check_ffn_a(const unsigned char* ws, const float* wg, const float* wu, unsigned* counter) {
    const bf16* H = (const bf16*)(ws + WS_H); const bf16* A = (const bf16*)(ws + WS_BIG);
    const int m = (blockIdx.x * 277 + 13) & (M - 1);
    __shared__ float hrow[1024];
    for (int i = threadIdx.x; i < 1024; i += 256) hrow[i] = dbg_bf(H[(size_t)m * 1024 + i]);
    __syncthreads();
    for (int c = threadIdx.x; c < D_FF; c += 256) { float zg = 0.f, zu = 0.f;
        _Pragma("unroll 4") for (int k2 = 0; k2 < 1024; ++k2) { zg += hrow[k2] * wg[(size_t)k2 * D_FF + c]; zu += hrow[k2] * wu[(size_t)k2 * D_FF + c]; }
        const float ref = zg / (1.f + expf(-zg)) * zu, got = dbg_bf(A[(size_t)m * D_FF + c]);
        if (!(fabsf(got - ref) <= 0.04f + 0.03f * fabsf(ref))) { atomicAdd(counter + 10, 1u); if (atomicAdd(counter + 320 + blockIdx.x, 1u) == 0u) atomicAdd(counter + 11, 1u); } }
}
__global__ void dbg_report2(float* out, const unsigned* counter) {
    if (counter[10]) { int d1 = 0; unsigned v = counter[11]; while (v) { v >>= 1; ++d1; } if (d1 > 9) d1 = 9;
        int d2 = 0; v = counter[10]; while (v > 1) { v >>= 1; ++d2; } d2 = d2 / 2; if (d2 > 9) d2 = 9;
        out[9] += (float)(d1 * 10 + d2) * 1e12f; }
    if (counter[4]) { int d1 = 0; unsigned v = counter[8]; while (v) { v >>= 1; ++d1; } if (d1 > 9) d1 = 9;
        int d2 = 0; v = counter[4]; while (v > 1) { v >>= 1; ++d2; } d2 = d2 / 2; if (d2 > 9) d2 = 9;
        out[7] += (float)(d1 * 10 + d2) * 1e9f; out[8] += (float)counter[9] * 1e7f; }
    const float code[7] = {1e2f, 1e3f, 1e4f, 1e8f, 1e7f, 1e6f, 1e5f};
    for (int j = 0; j < 7; ++j) { const unsigned m = counter[j]; if (m == 0) continue;
        int lgv = 0; unsigned v = m; while (v > 1) { v >>= 1; ++lgv; } if (lgv > 8) lgv = 8;
        out[j] += code[j] * (float)(1 + lgv); }
}
#endif
extern "C" void kernel_launch(void* const* d_in, const int* in_sizes, int n_in, void* d_out, int out_size, void* d_ws, size_t ws_size, hipStream_t stream) {
    static int grid = 0;
    if (grid == 0) {
        if (n_in != 22 || in_sizes[0] != M * D_MODEL || out_size != M * D_MODEL || ws_size < WS_END) {
            fprintf(stderr, "kernel_launch: unexpected shapes: n_in %d in0 %d out %d ws %zu (need %zu)\n", n_in, n_in > 0 ? in_sizes[0] : -1, out_size, ws_size, (size_t)WS_END); grid = -1; return; }
        int dev = 0, cus = 0, per_cu = 0;
        if (hipGetDevice(&dev) != hipSuccess || hipDeviceGetAttribute(&cus, hipDeviceAttributeMultiprocessorCount, dev) != hipSuccess) { grid = -1; return; }
        if (hipFuncSetAttribute((const void*)fwd_mega, hipFuncAttributeMaxDynamicSharedMemorySize, LDS_BYTES) != hipSuccess) { fprintf(stderr, "kernel_launch: hipFuncSetAttribute failed\n"); grid = -1; return; }
        if (hipOccupancyMaxActiveBlocksPerMultiprocessor(&per_cu, (const void*)fwd_mega, NWAVES * 64, LDS_BYTES) != hipSuccess || per_cu < 1) {
            fprintf(stderr, "kernel_launch: occupancy query reports %d blocks per CU; nothing launched\n", per_cu); (void)hipGetLastError(); grid = -1; return; }
        (void)hipGetLastError();
        if (cus != 256) { fprintf(stderr, "kernel_launch: built for a 256-CU device, found %d CUs; nothing launched\n", cus); grid = -1; return; }
        grid = cus;
        if (grid != 256) fprintf(stderr, "kernel_launch: note: %d CUs\n", grid);
    }
    if (grid < 0) return;
    if (hipMemsetAsync((char*)d_ws + WS_CTL, 0, CTL_ZERO_BYTES, stream) != hipSuccess) return;
    Args a{};
    for (int i = 0; i < 22; ++i) a.in[i] = (const float*)d_in[i];
    a.out = (float*)d_out; a.ws = (unsigned char*)d_ws;
    for (int li = 0; li < N_LAUNCHES; ++li) {
#ifdef PROBE_SKIP_LO
        if (li >= PROBE_SKIP_LO && li <= PROBE_SKIP_HI) continue;
#endif
        a.ph_lo = (N_LAUNCHES == 1) ? 0 : li; a.ph_hi = (N_LAUNCHES == 1) ? N_PHASES : li + 1; a.li = li;
        hipLaunchKernelGGL(fwd_mega, dim3(grid), dim3(NWAVES * 64), LDS_BYTES, stream, a);
        const hipError_t le = hipPeekAtLastError();
        if (le != hipSuccess) { fprintf(stderr, "kernel_launch: launch %d failed: %s\n", li, hipGetErrorName(le)); break; }
#ifdef DBG_CHECK_ATT
        if (li == 6) { hipLaunchKernelGGL(dbg_save_q, dim3(4096), dim3(64), 0, stream, (const unsigned char*)d_ws, (float*)((char*)d_ws + 210 * MiB));
                       hipLaunchKernelGGL(dbg_check_proj, dim3(128), dim3(256), 0, stream, (const unsigned char*)d_ws, (const float*)d_in[9], (unsigned*)d_ws + 16); }
        if (li == 2) hipLaunchKernelGGL(dbg_check_ffn_a, dim3(256), dim3(256), 0, stream, (const unsigned char*)d_ws, (const float*)d_in[5], (const float*)d_in[6], (unsigned*)d_ws + 16);
        if (li == 6) hipLaunchKernelGGL(dbg_check_qkv, dim3(256), dim3(256), 0, stream, (const unsigned char*)d_ws, (const float*)d_in[9], (unsigned*)d_ws + 16);
        if (li == 8) hipLaunchKernelGGL(dbg_check_gate, dim3(256), dim3(256), 0, stream, (const unsigned char*)d_ws, (const float*)d_in[9], (unsigned*)d_ws + 16);
        if (li == 9) { hipLaunchKernelGGL(dbg_check_merge, dim3(256), dim3(256), 0, stream, (const unsigned char*)d_ws, (const float*)d_in[15], (const float*)d_in[16], (unsigned*)d_ws + 16);
                       hipLaunchKernelGGL(dbg_save_out, dim3(256), dim3(256), 0, stream, (const float*)d_out, (float*)((char*)d_ws + 212 * MiB)); }
        if (li == 10) hipLaunchKernelGGL(dbg_check_out, dim3(256), dim3(256), 0, stream, (const unsigned char*)d_ws, (const float*)d_out, (const float*)((char*)d_ws + 212 * MiB), (const float*)d_in[17], (unsigned*)d_ws + 16);
        if (li == 7) hipLaunchKernelGGL(dbg_check_att, dim3(4096), dim3(256), 0, stream, (const unsigned char*)d_ws, (const float*)((char*)d_ws + 210 * MiB), (unsigned*)d_ws + 16);
#endif
#ifdef DBG_CHECK_MASK
        if (li == 6) hipLaunchKernelGGL(dbg_check_mask, dim3(1024), dim3(512), 0, stream, (const unsigned char*)d_ws, (unsigned*)d_ws + 8);
#endif
    }
#ifdef DBG_CHECK_ATT
    hipLaunchKernelGGL(dbg_report2, dim3(1), dim3(1), 0, stream, (float*)d_out, (const unsigned*)d_ws + 16);
#endif
#ifdef DBG_CHECK_MASK
    hipLaunchKernelGGL(dbg_report, dim3(1), dim3(1), 0, stream, (float*)d_out, (const unsigned*)d_ws + 8);
#endif
}
```

```cpp
#include <hip/hip_runtime.h>
#include <cstdio>
#include <cstdint>
#include <cmath>
#ifndef MK_N_LAUNCHES
#define MK_N_LAUNCHES 1
#endif
__device__ __forceinline__ int mk_lane() { int l; asm volatile("v_mbcnt_lo_u32_b32 %0, -1, 0\n\tv_mbcnt_hi_u32_b32 %0, -1, %0" : "=v"(l)); return l; }
namespace pg8 {
#define PG8_LAS __attribute__((address_space(3)))
typedef unsigned short bf16_t;
typedef short bf16x8 __attribute__((ext_vector_type(8)));
typedef float f32x4 __attribute__((ext_vector_type(4)));
typedef unsigned u32x4 __attribute__((ext_vector_type(4)));
typedef int v4i_t __attribute__((ext_vector_type(4)));
typedef int v8i_t __attribute__((ext_vector_type(8)));
typedef unsigned u32x2 __attribute__((ext_vector_type(2)));
constexpr int BM = 256, BK = 64, HALF = 128, HTB = HALF * BK * 2  , STAGE_BYTES = 8 * HTB, NXCD = 8, WGM = 8;

__host__ __device__ __forceinline__ int lds_byte(int r, int c) { const int st = (r >> 4) * 2 + (c >> 5), rr = r & 15, cc = c & 31, ob = rr * 64 + cc * 2; return st * 1024 + (ob ^ (((ob >> 9) & 1) << 5)); }
__host__ __device__ __forceinline__ void stage_rc(int b, int& R, int& C) { const int st = b / 1024, sb = b % 1024, swz = sb ^ (((sb >> 9) & 1) << 5); R = (st >> 1) * 16 + swz / 64; C = (st & 1) * 32 + (swz % 64) / 2; }
__host__ __device__ __forceinline__ int perm32(int rho) { const int n = rho >> 4, i = rho & 15; return 8 * (i >> 2) + 4 * n + (i & 3); }

struct Unit { int pm, pn; };
struct Gemm { const bf16_t* A; const bf16_t* Bt; int M, N, K; };

struct StaticOrder {
    int nM, nN, nwg, G, c;
    __host__ __device__ void init(int M, int N, int G_, int c_) { nM = M / BM; nN = N / BM; nwg = nM * nN; G = G_; c = c_; }
    __host__ __device__ bool next(int i, Unit& u) const {
        const long L = (long)i * G + c; if (L >= nwg) return false;
        int wgid = (int)L; { const int q = nwg / NXCD, r = nwg % NXCD, xcd = wgid % NXCD, off = wgid / NXCD; wgid = (xcd < r ? xcd * (q + 1) : r * (q + 1) + (xcd - r) * q) + off; }
        const int nig = WGM * nN, gid = wgid / nig, fm = gid * WGM, gsz = (nM - fm) < WGM ? (nM - fm) : WGM;
        u.pm = fm + ((wgid % nig) % gsz); u.pn = (wgid % nig) / gsz; return true;
    }
    __device__ __forceinline__ void a_ready(const Unit&) const {}
    __device__ __forceinline__ void done(const Unit&) const {}
};

typedef float f32x2c_t __attribute__((ext_vector_type(2))); typedef __bf16 bf16x2c_t __attribute__((ext_vector_type(2)));
__device__ __forceinline__ unsigned cvt_pk_bf16(float lo, float hi) { f32x2c_t v = {lo, hi}; bf16x2c_t b = __builtin_convertvector(v, bf16x2c_t); return __builtin_bit_cast(unsigned, b); }
typedef float f32x2 __attribute__((ext_vector_type(2)));
__device__ __forceinline__ float sigmoidf_fast(float v) { return __builtin_amdgcn_rcpf(1.f + __builtin_amdgcn_exp2f(-1.4426950408889634f * v)); }
__device__ __forceinline__ float bf_lo(unsigned w) { return __builtin_bit_cast(float, w << 16); }
__device__ __forceinline__ float bf_hi(unsigned w) { return __builtin_bit_cast(float, w & 0xffff0000u); }
__device__ __forceinline__ unsigned pk4_fp8(float a, float b, float c, float d) { unsigned w = 0u; w = __builtin_amdgcn_cvt_pk_fp8_f32(a, b, w, false); w = __builtin_amdgcn_cvt_pk_fp8_f32(c, d, w, true); return w; }

struct EpiSwiglu {
    static constexpr bool PERM = true, AFTER_DRAIN = false;
    bf16_t* O; int ldc;
    __device__ __forceinline__ void operator()(const f32x4 (&acc)[2][2][4][2], const Unit& u, int wr, int wc, int fr, int fq) const {
        const int row0 = u.pm * BM + wr * 64 + fr, col0 = u.pn * HALF + wc * 32 + 8 * fq;
#pragma unroll
        for (int ai = 0; ai < 2; ++ai)
#pragma unroll
            for (int m = 0; m < 4; ++m) { bf16_t* rowp = O + (size_t)(row0 + ai * HALF + m * 16) * ldc + col0;
                f32x4 v[2];
#pragma unroll
                for (int n = 0; n < 2; ++n) { const f32x4 g = acc[ai][0][m][n], up = acc[ai][1][m][n];
#pragma unroll
                    for (int e = 0; e < 4; ++e) v[n][e] = g[e] * sigmoidf_fast(g[e]) * up[e]; }
                u32x4 w; w.x = cvt_pk_bf16(v[0][0], v[0][1]); w.y = cvt_pk_bf16(v[0][2], v[0][3]); w.z = cvt_pk_bf16(v[1][0], v[1][1]); w.w = cvt_pk_bf16(v[1][2], v[1][3]);
                *(u32x4*)rowp = w; }
    }
};


struct EpiSwiglu8 {
    static constexpr bool PERM = true, AFTER_DRAIN = false;
    unsigned char* O; int ldc; float wscale;
    __device__ __forceinline__ void operator()(const f32x4 (&acc)[2][2][4][2], const Unit& u, int wr, int wc, int fr, int fq) const {
        asm volatile("" : "+v"(fr), "+v"(fq));
        const int row0 = u.pm * BM + wr * 64 + fr, col0 = u.pn * HALF + wc * 32 + 8 * fq;
#pragma unroll
        for (int ai = 0; ai < 2; ++ai)
#pragma unroll
            for (int m = 0; m < 4; ++m) { asm volatile("" ::: "memory"); unsigned char* rowp = O + (size_t)(row0 + ai * HALF + m * 16) * ldc + col0;
                f32x4 v[2];
#pragma unroll
                for (int n = 0; n < 2; ++n) { const f32x4 g = acc[ai][0][m][n] * wscale, up = acc[ai][1][m][n] * wscale;
#pragma unroll
                    for (int e = 0; e < 4; ++e) v[n][e] = g[e] * sigmoidf_fast(g[e]) * up[e]; }
                u32x2 w; w.x = pk4_fp8(v[0][0], v[0][1], v[0][2], v[0][3]); w.y = pk4_fp8(v[1][0], v[1][1], v[1][2], v[1][3]);
                *(u32x2*)rowp = w; }
    }
};

template <bool IN16, bool OUT16> struct EpiResidT {
    static constexpr bool PERM = false, AFTER_DRAIN = false;
    const void* base; void* out; const float* gate; float coef;
    __device__ __forceinline__ void operator()(const f32x4 (&acc)[2][2][4][2], const Unit& u, int wr, int wc, int fr, int fq) const {
        asm volatile("" : "+v"(fr), "+v"(fq));
        const int row0 = u.pm * BM + wr * 64 + fr, col0 = u.pn * BM + wc * 32 + 4 * fq;
        const float* gp = gate + (size_t)(u.pm / 32) * 9216 + col0;
        f32x4 gv[2][2];
#pragma unroll
        for (int bj = 0; bj < 2; ++bj)
#pragma unroll
            for (int n = 0; n < 2; ++n) gv[bj][n] = *(const f32x4*)(gp + bj * HALF + n * 16) * coef;
#pragma unroll
        for (int ai = 0; ai < 2; ++ai)
#pragma unroll
            for (int m = 0; m < 4; ++m) { asm volatile("" ::: "memory"); const size_t off = (size_t)(row0 + ai * HALF + m * 16) * 1024 + col0;
#pragma unroll
                for (int bj = 0; bj < 2; ++bj)
#pragma unroll
                    for (int n = 0; n < 2; ++n) { const size_t o2 = off + bj * HALF + n * 16; f32x4 bs;
                        if constexpr (IN16) { const u32x2 r = *(const u32x2*)((const bf16_t*)base + o2);
                            bs.x = __builtin_bit_cast(float, r.x << 16); bs.y = __builtin_bit_cast(float, r.x & 0xffff0000u); bs.z = __builtin_bit_cast(float, r.y << 16); bs.w = __builtin_bit_cast(float, r.y & 0xffff0000u); }
                        else bs = *(const f32x4*)((const float*)base + o2);
                        const f32x4 y = bs + gv[bj][n] * acc[ai][bj][m][n];
                        if constexpr (OUT16) { u32x2 w; w.x = cvt_pk_bf16(y.x, y.y); w.y = cvt_pk_bf16(y.z, y.w); *(u32x2*)((bf16_t*)out + o2) = w; }
                        else {
#ifdef PROBE_ROUND16
                            const unsigned w0 = cvt_pk_bf16(y.x, y.y), w1 = cvt_pk_bf16(y.z, y.w); f32x4 yr; yr.x = __builtin_bit_cast(float, w0 << 16); yr.y = __builtin_bit_cast(float, w0 & 0xffff0000u); yr.z = __builtin_bit_cast(float, w1 << 16); yr.w = __builtin_bit_cast(float, w1 & 0xffff0000u);
                            *(f32x4*)((float*)out + o2) = yr;
#else
                            __builtin_nontemporal_store(y, (f32x4*)((float*)out + o2));
#endif
                        } } }
    }
};

struct EpiGate {
    static constexpr bool PERM = true, AFTER_DRAIN = false;
    bf16_t* O; float wscale;
    __device__ __forceinline__ void operator()(const f32x4 (&acc)[2][2][4][2], const Unit& u, int wr, int wc, int fr, int fq) const {
        const int row0 = u.pm * BM + wr * 64 + fr, col0 = u.pn * BM + wc * 32 + 8 * fq;
#pragma unroll
        for (int ai = 0; ai < 2; ++ai)
#pragma unroll
            for (int m = 0; m < 4; ++m) { bf16_t* rowp = O + (size_t)(row0 + ai * HALF + m * 16) * 2048 + col0;
#pragma unroll
                for (int bj = 0; bj < 2; ++bj) { f32x4 v0 = acc[ai][bj][m][0], v1 = acc[ai][bj][m][1];
#pragma unroll
                    for (int e = 0; e < 4; ++e) { v0[e] = sigmoidf_fast(v0[e] * wscale); v1[e] = sigmoidf_fast(v1[e] * wscale); }
                    u32x4 w; w.x = cvt_pk_bf16(v0[0], v0[1]); w.y = cvt_pk_bf16(v0[2], v0[3]); w.z = cvt_pk_bf16(v1[0], v1[1]); w.w = cvt_pk_bf16(v1[2], v1[3]);
                    *(u32x4*)(rowp + bj * HALF) = w; } }
    }
};

struct EpiMerge {
    static constexpr bool PERM = true, AFTER_DRAIN = false;
    const bf16_t* SG; unsigned char* O; float wscale;
    __device__ __forceinline__ void operator()(const f32x4 (&acc)[2][2][4][2], const Unit& u, int wr, int wc, int fr, int fq) const {
        const int row0 = u.pm * BM + wr * 64 + fr, col0 = u.pn * HALF + wc * 32 + 8 * fq;
#pragma unroll
        for (int ai = 0; ai < 2; ++ai)
#pragma unroll
            for (int m = 0; m < 4; ++m) { const size_t r = (size_t)(row0 + ai * HALF + m * 16);
                const u32x4 ga = *(const u32x4*)(SG + r * 2048 + col0), gb = *(const u32x4*)(SG + r * 2048 + 1024 + col0);
                const f32x4 a0 = acc[ai][0][m][0], a1 = acc[ai][0][m][1], b0 = acc[ai][1][m][0], b1 = acc[ai][1][m][1];
                const float ws_ = wscale; u32x2 w;
                w.x = pk4_fp8((bf_lo(ga.x) * a0[0] + bf_lo(gb.x) * b0[0]) * ws_, (bf_hi(ga.x) * a0[1] + bf_hi(gb.x) * b0[1]) * ws_, (bf_lo(ga.y) * a0[2] + bf_lo(gb.y) * b0[2]) * ws_, (bf_hi(ga.y) * a0[3] + bf_hi(gb.y) * b0[3]) * ws_);
                w.y = pk4_fp8((bf_lo(ga.z) * a1[0] + bf_lo(gb.z) * b1[0]) * ws_, (bf_hi(ga.z) * a1[1] + bf_hi(gb.z) * b1[1]) * ws_, (bf_lo(ga.w) * a1[2] + bf_lo(gb.w) * b1[2]) * ws_, (bf_hi(ga.w) * a1[3] + bf_hi(gb.w) * b1[3]) * ws_);
                *(u32x2*)(O + r * 1024 + col0) = w; }
    }
};

struct EpiInA {
    static constexpr bool PERM = true, AFTER_DRAIN = false;
    bf16_t *QKV; bf16_t *QI, *KI; float *WI, *LF;
    const float *gains;
    int pn0; float wscale;
    __device__ __forceinline__ void operator()(const f32x4 (&acc0)[2][2][4][2], const Unit& u, int wr, int wc, int fr, int fq) const {
        const int row0 = u.pm * BM + wr * 64 + fr, pn = u.pn + pn0;
        const float ws_ = wscale;
#define acc(AI, BJ, MM, NN) (acc0[AI][BJ][MM][NN] * ws_)
        const int sec = pn >> 1;
        if (sec == 0 || sec == 1 || sec == 3 || sec == 4) {
            const bool isq = (sec == 0 || sec == 3), isfox = (sec >= 3);
            const float* gain = gains + 64 * (sec - (isfox ? 1 : 0));
            bf16_t* dst = QKV + (isq ? (size_t)0 : (size_t)16777216) + (isfox ? 512 : 0) + ((pn & 1) * 4 + wc) * 64 + 8 * fq;
            const float post = isq ? 0.125f * 1.4426950408889634f : 1.0f;
            f32x4 gv[2][2];
#pragma unroll
            for (int bj = 0; bj < 2; ++bj)
#pragma unroll
                for (int n = 0; n < 2; ++n) gv[bj][n] = *(const f32x4*)(gain + 32 * bj + 8 * fq + 4 * n) * post;
#pragma unroll
            for (int ai = 0; ai < 2; ++ai)
#pragma unroll
                for (int m = 0; m < 4; ++m) {
                    float ss = 0.f;
#pragma unroll
                    for (int bj = 0; bj < 2; ++bj)
#pragma unroll
                        for (int n = 0; n < 2; ++n) { const f32x4 x = acc(ai, bj, m, n); ss += (x[0] * x[0] + x[1] * x[1]) + (x[2] * x[2] + x[3] * x[3]); }
                    ss += __shfl_xor(ss, 16); ss += __shfl_xor(ss, 32);
                    const float rstd = __builtin_amdgcn_rsqf(ss * (1.0f / 64.0f) + 1e-6f);
                    bf16_t* rowp = dst + (size_t)(row0 + ai * HALF + m * 16) * 1024;
#pragma unroll
                    for (int bj = 0; bj < 2; ++bj) { const f32x4 v0 = acc(ai, bj, m, 0) * rstd * gv[bj][0], v1 = acc(ai, bj, m, 1) * rstd * gv[bj][1];
                        u32x4 w; w.x = cvt_pk_bf16(v0[0], v0[1]); w.y = cvt_pk_bf16(v0[2], v0[3]); w.z = cvt_pk_bf16(v1[0], v1[1]); w.w = cvt_pk_bf16(v1[2], v1[3]);
                        *(u32x4*)(rowp + 32 * bj) = w; } }
        } else if (sec == 2 || sec == 5 || sec == 6) {
            bf16_t* dst; int ld; float sc = 1.f;
            if (sec == 6) { dst = QI + (pn & 1) * 256; ld = 512; sc = 0.125f; } else { dst = QKV + (size_t)33554432 + (sec == 5 ? 512 : 0) + (pn & 1) * 256; ld = 1024; }
            dst += wc * 32 + 8 * fq;
#pragma unroll
            for (int ai = 0; ai < 2; ++ai)
#pragma unroll
                for (int m = 0; m < 4; ++m) { bf16_t* rowp = dst + (size_t)(row0 + ai * HALF + m * 16) * ld;
#pragma unroll
                    for (int bj = 0; bj < 2; ++bj) { const f32x4 v0 = acc(ai, bj, m, 0) * sc, v1 = acc(ai, bj, m, 1) * sc;
                        u32x4 w; w.x = cvt_pk_bf16(v0[0], v0[1]); w.y = cvt_pk_bf16(v0[2], v0[3]); w.z = cvt_pk_bf16(v1[0], v1[1]); w.w = cvt_pk_bf16(v1[2], v1[3]);
                        *(u32x4*)(rowp + bj * HALF) = w; } }
        } else {
            if (wc < 2) {
#pragma unroll
                for (int ai = 0; ai < 2; ++ai)
#pragma unroll
                    for (int m = 0; m < 4; ++m) { const f32x4 v0 = acc(ai, 0, m, 0), v1 = acc(ai, 0, m, 1);
                        u32x4 w; w.x = cvt_pk_bf16(v0[0], v0[1]); w.y = cvt_pk_bf16(v0[2], v0[3]); w.z = cvt_pk_bf16(v1[0], v1[1]); w.w = cvt_pk_bf16(v1[2], v1[3]);
                        const int row = row0 + ai * HALF + m * 16;
                        *(u32x4*)(KI + (size_t)(row >> 5) * 2048 + ((4 * wc + fq) * 32 + (row & 31)) * 8) = w; }
            } else if (wc == 2 && fq == 0) {
#pragma unroll
                for (int ai = 0; ai < 2; ++ai)
#pragma unroll
                    for (int m = 0; m < 4; ++m) { float* p = WI + (size_t)(row0 + ai * HALF + m * 16) * 8;
                        *(f32x4*)p = acc(ai, 0, m, 0) * 0.35355339059327373f; *(f32x4*)(p + 4) = acc(ai, 0, m, 1) * 0.35355339059327373f; }
            } else if (wc == 2 && fq == 1) {
                const f32x4 bf0 = *(const f32x4*)(gains + 256), bf1 = *(const f32x4*)(gains + 260);
#pragma unroll
                for (int ai = 0; ai < 2; ++ai)
#pragma unroll
                    for (int m = 0; m < 4; ++m) { const int row = row0 + ai * HALF + m * 16; float* p = LF + (size_t)(row >> 13) * 65536 + (row & 8191);
#pragma unroll
                        for (int n = 0; n < 2; ++n)
#pragma unroll
                            for (int e = 0; e < 4; ++e) { const float x = acc(ai, 0, m, n)[e] + (n ? bf1[e] : bf0[e]);
                                const float ls = fminf(x, 0.f) - __logf(1.f + __expf(-fabsf(x)));
                                p[(size_t)(4 * n + e) * 8192] = ls; } }
            }
        }
#undef acc
    }
};
template <class Epi, class Sched, bool ALIGN_EPI = false, bool SP2 = false, bool F8 = false>
__device__ __forceinline__ void gemm_phase(PG8_LAS unsigned char* lds, const Gemm g, const Sched& S, const Epi& E, const int wave_in) {
    const int lane = mk_lane(), wid = __builtin_amdgcn_readfirstlane(wave_in), tid = wid * 64 + lane, wr = wid >> 2, wc = wid & 3, fr = lane & 15, fq = lane >> 4;
    const int K = g.K, nt = K / BK;
    unsigned voffA[2], voffB[2];
#pragma unroll
    for (int i = 0; i < 2; ++i) { int R, C; stage_rc(tid * 16 + i * 8192, R, C); const int Rb = Epi::PERM ? ((R & ~31) + perm32(R & 31)) : R;
        voffA[i] = (unsigned)(R * K + C) * 2u; voffB[i] = (unsigned)(Rb * K + C) * 2u; }
    const size_t kstep = (size_t)(BK * 2);
    const size_t hstep = (size_t)HALF * K * 2;
    const size_t tstep = 2 * hstep;
    const unsigned ldsw = (unsigned)wid * 1024u;
    const int aoff = lds_byte(wr * 64 + fr, fq * 8), boff = lds_byte(wc * 32 + fr, fq * 8);
    const int aoff8 = lds_byte(wr * 64 + fr, fq * 16), boff8 = lds_byte(wc * 32 + fr, fq * 16);
#define PG8_SA(b, h) (((b) * 2 + (h)) * HTB)
#define PG8_SB(b, h) ((4 + (b) * 2 + (h)) * HTB)
#define PG8_STAGE(bufoff, gbase, voff) do { _Pragma("unroll") for (int _i = 0; _i < 2; ++_i) \
        __builtin_amdgcn_global_load_lds((const unsigned*)((const char*)(gbase) + (voff)[_i]), (PG8_LAS unsigned*)(lds + (bufoff) + ldsw + _i * 8192), 16, 0, 0); } while (0)
#define PG8_LD2(base_) __builtin_shufflevector(*(const PG8_LAS v4i_t*)(base_), *(const PG8_LAS v4i_t*)((base_) + 1024), 0, 1, 2, 3, 4, 5, 6, 7)
#define PG8_LDA(dst, b, h) do { if constexpr (F8) { _Pragma("unroll") for (int m = 0; m < 4; ++m) dst##8[m] = PG8_LD2(lds + PG8_SA(b, h) + aoff + m * 2048); } \
        else { _Pragma("unroll") for (int m = 0; m < 4; ++m) _Pragma("unroll") for (int k = 0; k < 2; ++k) dst[m][k] = *(const PG8_LAS bf16x8*)(lds + PG8_SA(b, h) + aoff + m * 2048 + k * 1024); } } while (0)
#define PG8_LDB(dst, b, h) do { if constexpr (F8) { _Pragma("unroll") for (int n = 0; n < 2; ++n) dst##8[n] = PG8_LD2(lds + PG8_SB(b, h) + boff + n * 2048); } \
        else { _Pragma("unroll") for (int n = 0; n < 2; ++n) _Pragma("unroll") for (int k = 0; k < 2; ++k) dst[n][k] = *(const PG8_LAS bf16x8*)(lds + PG8_SB(b, h) + boff + n * 2048 + k * 1024); } } while (0)
#define PG8_CAT8(x0, x1) __builtin_shufflevector(__builtin_bit_cast(v4i_t, x0), __builtin_bit_cast(v4i_t, x1), 0, 1, 2, 3, 4, 5, 6, 7)
#define PG8_MMA(ai, bj, At, Bt) do { __builtin_amdgcn_s_setprio(1); \
        if constexpr (F8) { _Pragma("unroll") for (int m = 0; m < 4; ++m) _Pragma("unroll") for (int n = 0; n < 2; ++n) \
            asm volatile("v_mfma_scale_f32_16x16x128_f8f6f4 %0, %1, %2, %0, %3, %3 op_sel_hi:[0,0,0]" : "+v"(acc[ai][bj][m][n]) : "v"(Bt##8[n]), "v"(At##8[m]), "v"(sc1)); } \
        else { _Pragma("unroll") for (int m = 0; m < 4; ++m) _Pragma("unroll") for (int n = 0; n < 2; ++n) _Pragma("unroll") for (int k = 0; k < 2; ++k) \
            acc[ai][bj][m][n] = __builtin_amdgcn_mfma_f32_16x16x32_bf16(Bt[n][k], At[m][k], acc[ai][bj][m][n], 0, 0, 0); } \
        __builtin_amdgcn_s_setprio(0); } while (0)
#define PG8_WAIT_V(n) asm volatile("s_waitcnt vmcnt(" #n ")" ::: "memory")
#define PG8_WAIT_L(n) asm volatile("s_waitcnt lgkmcnt(" #n ")" ::: "memory")
#define PG8_BAR __builtin_amdgcn_s_barrier()
#define PG8_SCHED __builtin_amdgcn_sched_barrier(0)
    Unit cur, nxt; int ui = 0;
    if (!S.next(0, cur)) return;
    f32x4 acc[2][2][4][2];
#pragma unroll
    for (int a = 0; a < 2; ++a)
#pragma unroll
        for (int b = 0; b < 2; ++b)
#pragma unroll
            for (int m = 0; m < 4; ++m)
#pragma unroll
                for (int n = 0; n < 2; ++n) { acc[a][b][m][n] = (f32x4){0.f, 0.f, 0.f, 0.f}; }
    bf16x8 At[4][2], B0[2][2], B1[2][2]; v8i_t At8[4], B08[2], B18[2];
    int sc1 = 0x7F7F7F7F; asm volatile("" : "+v"(sc1));
    const char* cA = (const char*)g.A + (size_t)cur.pm * tstep; const char* cB = (const char*)g.Bt + (size_t)cur.pn * tstep;
    S.a_ready(cur);
    if constexpr (SP2) {
        PG8_STAGE(PG8_SB(0, 0), cB, voffB); PG8_STAGE(PG8_SB(0, 1), cB + hstep, voffB); PG8_STAGE(PG8_SA(0, 0), cA, voffA); PG8_STAGE(PG8_SA(0, 1), cA + hstep, voffA);
        if (wr == 1) PG8_BAR;
        PG8_WAIT_V(2); PG8_BAR;
        PG8_STAGE(PG8_SB(1, 0), cB + kstep, voffB); PG8_STAGE(PG8_SA(1, 0), cA + kstep, voffA); PG8_STAGE(PG8_SB(1, 1), cB + hstep + kstep, voffB);
        PG8_WAIT_V(6); PG8_BAR;
    } else {
        PG8_STAGE(PG8_SB(0, 0), cB, voffB); PG8_STAGE(PG8_SA(0, 0), cA, voffA); PG8_STAGE(PG8_SB(0, 1), cB + hstep, voffB); PG8_STAGE(PG8_SA(0, 1), cA + hstep, voffA);
        if (wr == 1) PG8_BAR;
        PG8_WAIT_V(4); PG8_BAR;
        PG8_STAGE(PG8_SB(1, 0), cB + kstep, voffB); PG8_STAGE(PG8_SA(1, 0), cA + kstep, voffA); PG8_STAGE(PG8_SB(1, 1), cB + hstep + kstep, voffB);
        PG8_WAIT_V(6); PG8_BAR;
    }
    for (;;) {
        const bool has_next = S.next(ui + 1, nxt);
        const char* nA = has_next ? (const char*)g.A + (size_t)nxt.pm * tstep : cA; const char* nB = has_next ? (const char*)g.Bt + (size_t)nxt.pn * tstep : cB;
#pragma unroll 1
        for (int t = 0; t < nt; t += 2) {
            const bool last = (t == nt - 2);
            const char* a1 = cA + (size_t)(t + 1) * kstep;
            const char* a2 = last ? nA : cA + (size_t)(t + 2) * kstep; const char* b2 = last ? nB : cB + (size_t)(t + 2) * kstep;
            const char* a3 = a2 + kstep; const char* b3 = b2 + kstep;
            if (last && has_next) S.a_ready(nxt);
            if constexpr (SP2) {
            PG8_LDB(B0, 0, 0); PG8_LDB(B1, 0, 1); PG8_SCHED; PG8_LDA(At, 0, 0); PG8_STAGE(PG8_SA(1, 1), a1 + hstep, voffA);
            PG8_WAIT_V(8); PG8_WAIT_L(0); PG8_BAR; PG8_MMA(0, 0, At, B0); PG8_MMA(0, 1, At, B1); PG8_BAR; PG8_SCHED;
            PG8_LDA(At, 0, 1); PG8_STAGE(PG8_SB(0, 0), b2, voffB); PG8_STAGE(PG8_SB(0, 1), b2 + hstep, voffB); PG8_STAGE(PG8_SA(0, 0), a2, voffA);
            PG8_WAIT_V(8); PG8_WAIT_L(0); PG8_BAR; PG8_MMA(1, 0, At, B0); PG8_MMA(1, 1, At, B1); PG8_BAR; PG8_SCHED;
            PG8_LDB(B0, 1, 0); PG8_LDB(B1, 1, 1); PG8_SCHED; PG8_LDA(At, 1, 0); PG8_STAGE(PG8_SA(0, 1), a2 + hstep, voffA);
            PG8_WAIT_V(8); PG8_WAIT_L(0); PG8_BAR; PG8_MMA(0, 0, At, B0); PG8_MMA(0, 1, At, B1); PG8_BAR; PG8_SCHED;
            PG8_LDA(At, 1, 1); PG8_STAGE(PG8_SB(1, 0), b3, voffB); PG8_STAGE(PG8_SB(1, 1), b3 + hstep, voffB); PG8_STAGE(PG8_SA(1, 0), a3, voffA);
            PG8_WAIT_V(8); PG8_WAIT_L(0); PG8_BAR; PG8_MMA(1, 0, At, B0); PG8_MMA(1, 1, At, B1); PG8_BAR; PG8_SCHED;
            } else {
            PG8_LDB(B0, 0, 0); PG8_SCHED; PG8_LDA(At, 0, 0); PG8_STAGE(PG8_SA(1, 1), a1 + hstep, voffA);
            PG8_WAIT_L(8); PG8_BAR; PG8_WAIT_L(0); PG8_MMA(0, 0, At, B0); PG8_BAR; PG8_SCHED;
            PG8_LDB(B1, 0, 1); PG8_STAGE(PG8_SB(0, 0), b2, voffB);
            PG8_BAR; PG8_WAIT_L(0); PG8_MMA(0, 1, At, B1); PG8_BAR;
            PG8_LDA(At, 0, 1); PG8_STAGE(PG8_SA(0, 0), a2, voffA);
            PG8_BAR; PG8_WAIT_L(0); PG8_MMA(1, 0, At, B0); PG8_BAR; PG8_SCHED;
            PG8_STAGE(PG8_SB(0, 1), b2 + hstep, voffB);
            PG8_WAIT_V(6); PG8_BAR; PG8_MMA(1, 1, At, B1); PG8_BAR;
            PG8_LDB(B0, 1, 0); PG8_SCHED; PG8_LDA(At, 1, 0); PG8_STAGE(PG8_SA(0, 1), a2 + hstep, voffA);
            PG8_WAIT_L(8); PG8_BAR; PG8_WAIT_L(0); PG8_MMA(0, 0, At, B0); PG8_BAR; PG8_SCHED;
            PG8_LDB(B1, 1, 1); PG8_STAGE(PG8_SB(1, 0), b3, voffB);
            PG8_BAR; PG8_WAIT_L(0); PG8_MMA(0, 1, At, B1); PG8_BAR;
            PG8_LDA(At, 1, 1); PG8_STAGE(PG8_SA(1, 0), a3, voffA);
            PG8_BAR; PG8_WAIT_L(0); PG8_MMA(1, 0, At, B0); PG8_BAR; PG8_SCHED;
            PG8_STAGE(PG8_SB(1, 1), b3 + hstep, voffB);
            PG8_WAIT_V(6); PG8_BAR; PG8_MMA(1, 1, At, B1); PG8_BAR;
            }
        }
        if constexpr (F8) asm volatile("s_nop 15\n\ts_nop 15" ::: "memory");
        if constexpr (ALIGN_EPI) { if (wr == 0) PG8_BAR; }
        if constexpr (!Epi::AFTER_DRAIN) { E(acc, cur, wr, wc, fr, fq); S.done(cur); }
        if (!has_next) break;
#pragma unroll
        for (int a = 0; a < 2; ++a)
#pragma unroll
            for (int b = 0; b < 2; ++b)
#pragma unroll
                for (int m = 0; m < 4; ++m)
#pragma unroll
                    for (int n = 0; n < 2; ++n) { acc[a][b][m][n] = (f32x4){0.f, 0.f, 0.f, 0.f}; }
        cur = nxt; cA = nA; cB = nB; ++ui;
        if constexpr (ALIGN_EPI) { if (wr == 1) PG8_BAR; }
    }
    PG8_WAIT_V(0);
    if constexpr (!ALIGN_EPI) { if (wr == 0) PG8_BAR; }
    PG8_BAR;
    if constexpr (Epi::AFTER_DRAIN) { E.fused(acc, cur, wr, wc, fr, fq, lds, wid, lane); S.done(cur); }
#undef PG8_SA
#undef PG8_SB
#undef PG8_STAGE
#undef PG8_LD2
#undef PG8_LDA
#undef PG8_LDB
#undef PG8_MMA
#undef PG8_CAT8
#undef PG8_WAIT_V
#undef PG8_WAIT_L
#undef PG8_BAR
#undef PG8_SCHED
}
}
namespace att {
#ifdef PROBE_ZERO_TYPE
#define PROBE_ZF(T) ((T)==PROBE_ZERO_TYPE?0.f:1.f)
#else
#define PROBE_ZF(T) 1.f
#endif
typedef unsigned short bf16_t;
using bf16x8=__attribute__((ext_vector_type(8)))short;
using s16x4=__attribute__((ext_vector_type(4)))short;
using f32x16=__attribute__((ext_vector_type(16)))float;
using f32x4=__attribute__((ext_vector_type(4)))float;
using u32x4=__attribute__((ext_vector_type(4)))unsigned;
constexpr int SEQ=8192,D=64,DM=1024;
constexpr int NW=8,QBLK=32,QB=QBLK*NW,KVBLK=64;
__device__ __forceinline__ int crow(int r,int hi){return (r&3)+8*(r>>2)+4*hi;}
#define SBAR() __builtin_amdgcn_sched_barrier(0)
__device__ __forceinline__ void cmask(f32x16&p0,f32x16&p1,int jb,int qrel,int hi){
  const float NEG=-INFINITY; int kb=64*jb+4*hi;
  #pragma unroll
  for(int r=0;r<16;++r){int kv=kb+(r&3)+8*(r>>2); if(kv>qrel)p0[r]=NEG; if(kv+32>qrel)p1[r]=NEG;}
}
constexpr int SLOTB=8192;
constexpr int RS=6, RD=4;
constexpr int LDS_K=0, LDS_V=RS*SLOTB, LDS_WS=2*RS*SLOTB, LDS_FK=LDS_WS+NW*64*4, LDS_BYTES=LDS_FK+32768+256;
constexpr int LDS_OST=0;
constexpr int LDS_MR=LDS_FK, LDS_FLG=LDS_FK+32768;
__device__ __forceinline__ void glds16(const void*gsrc,unsigned lds_dst){unsigned keep;
  asm volatile("s_mov_b32 %0, m0\n\ts_mov_b32 m0, %2\n\ts_nop 0\n\tglobal_load_lds_dwordx4 %1, off\n\ts_mov_b32 m0, %0":"=&s"(keep):"v"(gsrc),"s"(lds_dst):"memory");}
__device__ __forceinline__ void glds4(const void*gsrc,unsigned lds_dst){unsigned keep;
  asm volatile("s_mov_b32 %0, m0\n\ts_mov_b32 m0, %2\n\ts_nop 0\n\tglobal_load_lds_dword %1, off\n\ts_mov_b32 m0, %0":"=&s"(keep):"v"(gsrc),"s"(lds_dst):"memory");}
__device__ __forceinline__ float max3f(float a,float b,float c){float r;asm("v_max3_f32 %0, %1, %2, %3":"=v"(r):"v"(a),"v"(b),"v"(c));return r;}
__device__ __forceinline__ float max2f(float a,float b){float r;asm("v_max_f32_e32 %0, %1, %2":"=v"(r):"v"(a),"v"(b));return r;}
typedef float f32x2_t __attribute__((ext_vector_type(2))); typedef __bf16 bf16x2_t __attribute__((ext_vector_type(2)));
__device__ __forceinline__ unsigned cvtpk_s(float lo,float hi){f32x2_t v={lo,hi};bf16x2_t b=__builtin_convertvector(v,bf16x2_t);return __builtin_bit_cast(unsigned,b);}
__device__ __forceinline__ void xhalf_pair(float v,float&lo,float&hi_){unsigned a=__builtin_bit_cast(unsigned,v),b=a;
  asm volatile("s_nop 1\n\tv_permlane32_swap_b32 %0, %1\n\ts_nop 1":"+v"(a),"+v"(b)); lo=__builtin_bit_cast(float,a); hi_=__builtin_bit_cast(float,b);}
__device__ __forceinline__ float xhalf_sum(float v){float lo,h;xhalf_pair(v,lo,h);return lo+h;}
__device__ __forceinline__ float xhalf_max(float v){float lo,h;xhalf_pair(v,lo,h);return __builtin_fmaxf(lo,h);}
#define WAIT_ALL_BAR() asm volatile("s_waitcnt vmcnt(0) lgkmcnt(0)\n\ts_barrier":::"memory")

__device__ __forceinline__ void qkt(f32x16&p0,f32x16&p1,const char*Kslot,const bf16x8*qr,const f32x16&cinit,const f32x16&cinit1,int r32,int hi){
  const char*kb=Kslot+hi*1024+r32*16;
  #pragma unroll
  for(int d0=0;d0<4;++d0){
    const bf16x8 b0=*reinterpret_cast<const bf16x8*>(kb+d0*2048);
    const bf16x8 b1=*reinterpret_cast<const bf16x8*>(kb+d0*2048+512);
    if(d0==0){p0=__builtin_amdgcn_mfma_f32_32x32x16_bf16(b0,qr[0],cinit,0,0,0);p1=__builtin_amdgcn_mfma_f32_32x32x16_bf16(b1,qr[0],cinit1,0,0,0);}
    else{p0=__builtin_amdgcn_mfma_f32_32x32x16_bf16(b0,qr[d0],p0,0,0,0);p1=__builtin_amdgcn_mfma_f32_32x32x16_bf16(b1,qr[d0],p1,0,0,0);}}
}
__device__ __forceinline__ float rowmax(const f32x16&p0,const f32x16&p1){
  float a=max3f(p0[0],p0[1],p1[0]),b=max3f(p0[2],p0[3],p1[1]);a=max3f(a,p1[2],p1[3]);
  #pragma unroll
  for(int r=4;r<16;r+=4){a=max3f(a,p0[r],p0[r+1]);b=max3f(b,p0[r+2],p0[r+3]);a=max3f(a,p1[r],p1[r+1]);b=max3f(b,p1[r+2],p1[r+3]);}
  const float m=max2f(a,b);
  return xhalf_max(m);
}
__device__ __forceinline__ void pv(f32x16*o,f32x16&ol,int vb,bf16x8 pa0,bf16x8 pa1,bf16x8 pa2,bf16x8 pa3){
  #pragma unroll
  for(int d0=0;d0<2;++d0){s16x4 lo[4],hi[4];
    #pragma unroll
    for(int ks=0;ks<4;++ks){
      asm volatile("ds_read_b64_tr_b16 %0,%1 offset:%c2":"=&v"(lo[ks]):"v"(vb),"i"(d0*4096+ks*1024):"memory");
      asm volatile("ds_read_b64_tr_b16 %0,%1 offset:%c2":"=&v"(hi[ks]):"v"(vb),"i"(d0*4096+ks*1024+512):"memory");}
    if(d0==0){ const bf16x8 ones={(short)0x3f80,(short)0x3f80,(short)0x3f80,(short)0x3f80,(short)0x3f80,(short)0x3f80,(short)0x3f80,(short)0x3f80};
      ol=__builtin_amdgcn_mfma_f32_32x32x16_bf16(pa0,ones,ol,0,0,0); ol=__builtin_amdgcn_mfma_f32_32x32x16_bf16(pa1,ones,ol,0,0,0);
      ol=__builtin_amdgcn_mfma_f32_32x32x16_bf16(pa2,ones,ol,0,0,0); ol=__builtin_amdgcn_mfma_f32_32x32x16_bf16(pa3,ones,ol,0,0,0); }
    asm volatile("s_waitcnt lgkmcnt(0)":::"memory");SBAR();
    #define PK(k) (bf16x8){lo[k][0],lo[k][1],lo[k][2],lo[k][3],hi[k][0],hi[k][1],hi[k][2],hi[k][3]}
    o[d0]=__builtin_amdgcn_mfma_f32_32x32x16_bf16(pa0,PK(0),o[d0],0,0,0);
    o[d0]=__builtin_amdgcn_mfma_f32_32x32x16_bf16(pa1,PK(1),o[d0],0,0,0);
    o[d0]=__builtin_amdgcn_mfma_f32_32x32x16_bf16(pa2,PK(2),o[d0],0,0,0);
    o[d0]=__builtin_amdgcn_mfma_f32_32x32x16_bf16(pa3,PK(3),o[d0],0,0,0);
    #undef PK
  }
}

template<int TYPE> __device__ __forceinline__ void attn_unit(int b,int h16,int qb,const bf16_t*Q,const bf16_t*__restrict__ K,const bf16_t*__restrict__ V,unsigned char*O,
                                                              const float*__restrict__ F2,const unsigned long long*__restrict__ mask,char*shm,const float qkmax2,const int wave_in,
                                                              const int piece=0,const int np=1,const int per=0,float*part=nullptr,unsigned*pctr=nullptr,const int viscap=1<<20){
  const int lane=mk_lane(),r32=lane&31,hi=lane>>5; const int wid=__builtin_amdgcn_readfirstlane(wave_in); const int tid=wid*64+lane;
  const long rowbase=(long)b*SEQ; const int q0=qb*QB;
  const bf16_t*Qw=Q+(rowbase+q0+wid*QBLK)*DM+h16*D;
  const bf16_t*Kh=K+rowbase*DM+h16*D,*Vh=V+rowbase*DM+h16*D;
  const unsigned lds0=(unsigned)(uintptr_t)shm;
  float*wsf=(float*)(shm+LDS_WS)+wid*64;
  float*fk=(float*)(shm+LDS_FK);
  const bf16_t*ksrc=Kh+(long)lane*DM+wid*8;
  const bf16_t*vsrc=Vh+(long)(16*(wid&3)+(lane>>2))*DM+(wid>>2)*32+(lane&3)*8;
  const unsigned kdst=lds0+LDS_K+wid*1024, vdst=lds0+LDS_V+wid*1024;
  #define DMA_K(t,slot) glds16(ksrc+(long)(t)*KVBLK*DM,(unsigned)__builtin_amdgcn_readfirstlane(kdst+(slot)))
  #define DMA_V(t,slot) glds16(vsrc+(long)(t)*KVBLK*DM,(unsigned)__builtin_amdgcn_readfirstlane(vdst+(slot)))
  const int vb0=(int)(lds0+LDS_V)+((lane>>4)&1)*32+(lane&3)*8+(4*hi+((lane&15)>>2))*64;
  const int NT=(q0+QB)/KVBLK;
  const int tq=q0+wid*QBLK+r32;
  int t_begin=0;
  float Fq=0.f, sl2=0.f;
  if(TYPE==0){ const float*f2h=F2+((size_t)b*8+(h16-8))*SEQ; Fq=f2h[tq];
    { const float f0=f2h[q0]; const int j0=lane, j1=lane+64;
      const float e0=(j0<NT-4)?f2h[j0*KVBLK+KVBLK-1]:0.f, e1=(j1<NT-4)?f2h[j1*KVBLK+KVBLK-1]:0.f;
      const bool v0=(j0>=NT-4)||!(f0-e0+2.f*qkmax2 < -40.f), v1=(j1>=NT-4)||!(f0-e1+2.f*qkmax2 < -40.f);
      const unsigned long long b0=__ballot(v0), b1=__ballot(v1);
      t_begin=b0?(int)__builtin_ctzll(b0):64+(int)__builtin_ctzll(b1); if(t_begin>NT-4)t_begin=NT-4;
      if(t_begin<NT-viscap)t_begin=NT-viscap; }
    for(int i=t_begin*KVBLK+tid;i<NT*KVBLK;i+=NW*64)fk[i]=f2h[i];
    asm volatile("":"+v"(Fq));
    asm volatile("s_waitcnt vmcnt(0) lgkmcnt(0)\n\ts_barrier":::"memory"); }
  else { sl2=__builtin_amdgcn_exp2f(-(float)(h16+1))*1.4426950408889634f; }
  const int i_lo=(TYPE==1&&np>1)?piece*per:0, i_hi=(TYPE==1&&np>1&&piece<np-1)?((piece+1)*per<NT?(piece+1)*per:NT):NT;
  #define TILE_OF(i_) (NT-1-i_lo-(i_))
  const int nvis=(TYPE==0)?NT-t_begin:i_hi-i_lo;
  const unsigned*mrow=(const unsigned*)(mask+((size_t)rowbase+tq)*128);
  const unsigned mdst=lds0+LDS_MR+wid*256;
  typedef __attribute__((address_space(3))) const unsigned* lds_cup;
  lds_cup mring=(lds_cup)(__attribute__((address_space(3))) char*)(shm+LDS_MR);
  #define ISSUE(i_,st_) do{ const int t_=TILE_OF(i_); DMA_K(t_,(st_)*SLOTB); DMA_V(t_,(st_)*SLOTB); \
      if(TYPE==1){ glds4(mrow+2*t_,(unsigned)__builtin_amdgcn_readfirstlane(mdst+(st_)*4096)); glds4(mrow+2*t_+1,(unsigned)__builtin_amdgcn_readfirstlane(mdst+(st_)*4096+2048)); } }while(0)
  #pragma unroll
  for(int i=0;i<RD;++i) if(i<nvis) ISSUE(i,i);
  bf16x8 qr[4];
  #pragma unroll
  for(int d0=0;d0<4;++d0)qr[d0]=*reinterpret_cast<const bf16x8*>(&Qw[(long)r32*DM+d0*16+hi*8]);
  asm volatile("":"+v"(qr[0]),"+v"(qr[1]),"+v"(qr[2]),"+v"(qr[3]));
  float m_run=-INFINITY;f32x16 o[2];o[0]=f32x16{};o[1]=f32x16{}; f32x16 ol=f32x16{}; float mref=0.f; bool seen=false;
  const f32x16 zero16=f32x16{};
  typedef __attribute__((address_space(3))) volatile float* lds_vfp;
  lds_vfp wmin=(lds_vfp)(__attribute__((address_space(3))) char*)(shm+LDS_FLG);
  float kr[16];
  #pragma unroll
  for(int r=0;r<16;++r)kr[r]=sl2*(float)((r&3)+8*(r>>2));
  int stage=0; int ndone=0; bool pmine=false;
  const bool grpB=wid>=4;
  u32x4 pw0=u32x4{},pw1=u32x4{},pw2=u32x4{},pw3=u32x4{};
  for(int i=0;i<nvis;++i){
    if(nvis-1-i>=RD-1){ if(TYPE==1) asm volatile("s_waitcnt vmcnt(12)":::"memory"); else asm volatile("s_waitcnt vmcnt(6)":::"memory"); }
    else asm volatile("s_waitcnt vmcnt(0)":::"memory");
    asm volatile("s_waitcnt lgkmcnt(0)\n\ts_barrier":::"memory");
    if(i>0 && (i&1)==0){
      float bmin=wmin[0];
      #pragma unroll
      for(int w_=1;w_<NW;++w_)bmin=__builtin_fminf(bmin,wmin[w_]);
      if(TYPE==1){ const int dist=q0-(TILE_OF(i)*KVBLK+KVBLK-1); if(dist>0 && qkmax2-sl2*(float)dist-bmin < -40.f) break; }
      else { if(TILE_OF(i)<NT-4 && qkmax2+(fk[q0]-fk[TILE_OF(i)*KVBLK+KVBLK-1])-bmin < -40.f) break; }
    }
    { const int in_=i+RD; if(in_<nvis){ const int sp_=(stage<2)?stage+RS-2:stage-2; ISSUE(in_,sp_); } }
    const int t=TILE_OF(i);
    const int slot=stage*SLOTB;
    const bool mine=(t*KVBLK<=q0+wid*QBLK+QBLK-1);
    if(grpB && i>0 && pmine){ const int sp_=((stage==0)?RS-1:stage-1)*SLOTB; pv(o,ol,vb0+sp_,__builtin_bit_cast(bf16x8,pw0),__builtin_bit_cast(bf16x8,pw1),__builtin_bit_cast(bf16x8,pw2),__builtin_bit_cast(bf16x8,pw3)); }
    if(mine){
    f32x16 p0,p1;
    {
      f32x16 c0,c1;
      if(TYPE==1){
        const float Bm=__builtin_fmaf(sl2,(float)(t*KVBLK+4*hi-tq),-mref), Bm1=__builtin_fmaf(sl2,32.f,Bm);
        #pragma unroll
        for(int r=0;r<16;++r){ asm("v_add_f32_e32 %0, %1, %2":"=v"(c0[r]):"v"(kr[r]),"v"(Bm)); asm("v_add_f32_e32 %0, %1, %2":"=v"(c1[r]):"v"(kr[r]),"v"(Bm1)); }
      } else {
        const float Bq=Fq-mref;
        #pragma unroll
        for(int j=0;j<4;++j){ const f32x4 a_=*(const f32x4*)(fk+t*KVBLK+8*j+4*hi), c_=*(const f32x4*)(fk+t*KVBLK+32+8*j+4*hi);
          #pragma unroll
          for(int i2=0;i2<4;++i2){c0[4*j+i2]=Bq-a_[i2];c1[4*j+i2]=Bq-c_[i2];} }
      }
      qkt(p0,p1,shm+LDS_K+slot,qr,c0,c1,r32,hi);
      if(TYPE==1){
        const unsigned lo=mring[stage*1024+wid*64+lane]>>(4*hi), hh=mring[stage*1024+512+wid*64+lane]>>(4*hi);
        #pragma unroll
        for(int r=0;r<16;++r){ const int c=(r&3)+8*(r>>2);
          const unsigned m0=(unsigned)__builtin_amdgcn_sbfe((int)lo,c,1), m1=(unsigned)__builtin_amdgcn_sbfe((int)hh,c,1);
          p0[r]=__uint_as_float((__float_as_uint(p0[r])&m0)|(0xff800000u&~m0)); p1[r]=__uint_as_float((__float_as_uint(p1[r])&m1)|(0xff800000u&~m1)); }
      } else { if(t>=NT-4)cmask(p0,p1,t-(NT-4),wid*QBLK+r32,hi); }
    }
    {
      const float rm=rowmax(p0,p1);
      const bool fin=rm>-INFINITY, adj=seen?(rm>8.f):fin;
      if(__any(adj)){
        const float dl=adj?rm:0.f, alpha=(adj&&seen)?__builtin_amdgcn_exp2f(-dl):1.f;
        mref+=dl;
        #pragma unroll
        for(int r=0;r<16;++r){p0[r]-=dl;p1[r]-=dl;}
        if(__any(alpha!=1.f)){
          if(hi==0)wsf[r32]=alpha;
          asm volatile("s_waitcnt lgkmcnt(0)":::"memory");
          #pragma unroll
          for(int r=0;r<16;++r){ const float al=wsf[crow(r,hi)]; o[0][r]*=al; o[1][r]*=al; ol[r]*=al; }
        }
      }
      seen=seen||fin;
      #pragma unroll
      for(int r=0;r<16;++r){p0[r]=__builtin_amdgcn_exp2f(p0[r]);p1[r]=__builtin_amdgcn_exp2f(p1[r]);}
      m_run=seen?mref:-INFINITY;
    }
    #define PKW(P,B) cvtpk_s(P[B],P[B+1])
    pw0=(u32x4){PKW(p0,0),PKW(p0,2),PKW(p0,4),PKW(p0,6)};pw1=(u32x4){PKW(p0,8),PKW(p0,10),PKW(p0,12),PKW(p0,14)};
    pw2=(u32x4){PKW(p1,0),PKW(p1,2),PKW(p1,4),PKW(p1,6)};pw3=(u32x4){PKW(p1,8),PKW(p1,10),PKW(p1,12),PKW(p1,14)};
    #undef PKW
    SBAR();
    if(!grpB) pv(o,ol,vb0+slot,__builtin_bit_cast(bf16x8,pw0),__builtin_bit_cast(bf16x8,pw1),__builtin_bit_cast(bf16x8,pw2),__builtin_bit_cast(bf16x8,pw3));
    }
    pmine=mine;
    if((i&1)==1){ float mn=m_run;
      #pragma unroll
      for(int o_=1;o_<32;o_<<=1)mn=__builtin_fminf(mn,__shfl_xor(mn,o_));
      if(lane==0)wmin[wid]=mn; }
    stage=(stage+1==RS)?0:stage+1; ++ndone;
  }
  if(grpB && ndone>0 && pmine){ const int sp_=((stage==0)?RS-1:stage-1)*SLOTB; pv(o,ol,vb0+sp_,__builtin_bit_cast(bf16x8,pw0),__builtin_bit_cast(bf16x8,pw1),__builtin_bit_cast(bf16x8,pw2),__builtin_bit_cast(bf16x8,pw3)); }
  asm volatile("s_waitcnt vmcnt(0) lgkmcnt(0)\n\ts_barrier":::"memory");
  #undef ISSUE
  #undef TILE_OF
  if(TYPE==1 && np>1){
    float*pp=part+(size_t)piece*(49*512)+tid;
    #pragma unroll
    for(int r=0;r<16;++r){pp[r*512]=o[0][r];pp[(16+r)*512]=o[1][r];pp[(32+r)*512]=ol[r];}
    pp[48*512]=seen?mref:-INFINITY;
    asm volatile("s_waitcnt vmcnt(0)":::"memory");
    __syncthreads();
    typedef __attribute__((address_space(3))) volatile unsigned* lds_vup;
    lds_vup pflag=(lds_vup)(__attribute__((address_space(3))) char*)(shm+LDS_FLG+64);
    if(tid==0){
      __builtin_amdgcn_fence(__ATOMIC_RELEASE,"agent"); asm volatile("s_waitcnt vmcnt(0)":::"memory");
      const unsigned old_=__hip_atomic_fetch_add(pctr,1u,__ATOMIC_RELAXED,__HIP_MEMORY_SCOPE_AGENT);
      if(old_==(unsigned)(np-1)){ __builtin_amdgcn_fence(__ATOMIC_ACQUIRE,"agent"); asm volatile("s_waitcnt vmcnt(0)":::"memory"); }
      *pflag=old_; }
    __syncthreads();
    const unsigned arrived=*pflag;
    if(arrived!=(unsigned)(np-1)){ asm volatile("s_waitcnt vmcnt(0) lgkmcnt(0)\n\ts_barrier":::"memory"); return; }
    float M=-INFINITY;
    #pragma unroll 1
    for(int k=0;k<np;++k) M=__builtin_fmaxf(M,part[(size_t)k*(49*512)+48*512+tid]);
    if(M==-INFINITY)M=0.f;
    #pragma unroll
    for(int r=0;r<16;++r){o[0][r]=0.f;o[1][r]=0.f;ol[r]=0.f;}
    #pragma unroll 1
    for(int k=0;k<np;++k){ const float*pk=part+(size_t)k*(49*512)+tid;
      const float mk=pk[48*512], sk=(mk==-INFINITY)?0.f:__builtin_amdgcn_exp2f(mk-M);
      #pragma unroll
      for(int r=0;r<16;++r){o[0][r]=__builtin_fmaf(sk,pk[r*512],o[0][r]);o[1][r]=__builtin_fmaf(sk,pk[(16+r)*512],o[1][r]);ol[r]=__builtin_fmaf(sk,pk[(32+r)*512],ol[r]);} }
  }
  float rli[16];
  #pragma unroll
  for(int r=0;r<16;++r)rli[r]=__builtin_amdgcn_rcpf(ol[r]);
  unsigned char*Ow=O+(rowbase+q0+wid*QBLK)*DM+h16*D;
  { unsigned char*stg=(unsigned char*)(shm+LDS_OST)+wid*2048;
    #pragma unroll
    for(int r=0;r<16;++r){const int orow=crow(r,hi);
      #pragma unroll
      for(int d0=0;d0<2;++d0){ const unsigned pk=(unsigned)__builtin_amdgcn_cvt_pk_fp8_f32(o[d0][r]*rli[r]*PROBE_ZF(TYPE),0.f,0,false); stg[orow*64+d0*32+r32]=(unsigned char)(pk&0xffu);} }
    asm volatile("s_waitcnt lgkmcnt(0)":::"memory");
    { const int row=lane>>1,hf=lane&1; const u32x4 v0=*(const u32x4*)(stg+row*64+hf*32), v1=*(const u32x4*)(stg+row*64+hf*32+16);
      *(u32x4*)(Ow+(long)row*DM+hf*32)=v0; *(u32x4*)(Ow+(long)row*DM+hf*32+16)=v1; } }
  asm volatile("s_waitcnt lgkmcnt(0)\n\ts_barrier":::"memory");
  #undef DMA_K
  #undef DMA_V
}
#undef SBAR
#undef WAIT_ALL_BAR
}
constexpr int NWAVES = 8;
constexpr int N_PHASES = 14;
constexpr int N_LAUNCHES = MK_N_LAUNCHES;
static_assert(N_LAUNCHES == 1 || N_LAUNCHES == N_PHASES, "MK_N_LAUNCHES is 1 or 14");
constexpr int BATCH = 2, SEQ = 8192, D_MODEL = 1024, D_FF = 2816, IN_WIDTH = 5712, TOPK = 256;
constexpr int M = BATCH * SEQ;
constexpr int NA_COLS = 15 * 256;
constexpr size_t MiB = 1u << 20;
constexpr size_t WS_CTL = 0, CTL_ZERO_BYTES = 1 * MiB;
constexpr size_t WS_MOD = 1 * MiB, WS_GAINS = 1 * MiB + 131072, WS_AORDER = 1 * MiB + 262144;
constexpr int CW_AQUEUE = 2048, CW_CQUEUE = 3072, CW_PCTR = 3200;
constexpr int CW_DUMMY_ = 0;
constexpr size_t WS_WGU = 2 * MiB, WS_WD = 13 * MiB, WS_WINA = 19 * MiB, WS_WINB = 27 * MiB, WS_WBR = 31 * MiB, WS_WOUT = 35 * MiB;
constexpr size_t WS_H = 38 * MiB;
constexpr size_t WS_BIG = 70 * MiB;
constexpr size_t WS_Q16 = 70 * MiB, WS_K16 = 102 * MiB, WS_V16 = 134 * MiB;
constexpr size_t WS_QI = 166 * MiB, WS_KI = 182 * MiB, WS_WI = 184 * MiB, WS_LF = 185 * MiB, WS_F2 = 186 * MiB, WS_MASK = 188 * MiB, WS_H8B = 204 * MiB, WS_O8 = 220 * MiB, WS_END = 236 * MiB;
static_assert(WS_WGU + (size_t)2 * D_FF * D_MODEL * 2 <= WS_WD && WS_WD + (size_t)D_FF * D_MODEL * 2 <= WS_WINA && WS_WINA + (size_t)NA_COLS * D_MODEL * 2 <= WS_WINB, "ws map");
static_assert(WS_BIG + (size_t)M * D_FF * 2 <= WS_QI && WS_MASK + (size_t)M * SEQ / 8 <= WS_H8B, "ws map");
constexpr int CW_BAR = 4096;
constexpr int RING_BYTES = 131072, LDSCTL_OFF = 147456, MISC_OFF = LDSCTL_OFF + 320, LDS_BYTES = 148480;
typedef unsigned u32x4g __attribute__((ext_vector_type(4)));
typedef float f32x2g __attribute__((ext_vector_type(2)));
#define GAS __attribute__((address_space(1)))
#define LAS __attribute__((address_space(3)))
typedef unsigned short bf16;
typedef unsigned v4u __attribute__((ext_vector_type(4)));
typedef float f32x4 __attribute__((ext_vector_type(4)));
typedef short bf16x8 __attribute__((ext_vector_type(8)));
typedef GAS unsigned gu32;
typedef GAS unsigned long long gu64;
#define RLX_AGENT __ATOMIC_RELAXED, __HIP_MEMORY_SCOPE_AGENT
#define LDS_WAIT() asm volatile("s_waitcnt lgkmcnt(0)" ::: "memory")
#define VM_WAIT() asm volatile("s_waitcnt vmcnt(0)" ::: "memory")
__device__ __forceinline__ unsigned long long rt() { return __builtin_amdgcn_s_memrealtime(); }
__device__ __forceinline__ unsigned f2bf(float f) { unsigned u = __builtin_bit_cast(unsigned, f); return (u + 0x7fffu + ((u >> 16) & 1u)) >> 16; }
__device__ __forceinline__ unsigned pk2(float lo, float hi) { return f2bf(lo) | (f2bf(hi) << 16); }

#define XB_TMO      128
#define XB_XCNT(j)  (256  + 64 * (j))
#define XB_XSUB(j)  (1280 + 64 * (j))
#define XB_XGEN(j)  (2304 + 64 * (j))
#define XB_TOP      3328
#define XB_TOPGEN   3392
#define XCD_BAR_WORDS 3456
#define XB_SPIN_CAP (1u << 18)

__device__ __forceinline__ unsigned xb_ld(unsigned* p)              { return __hip_atomic_load(p, __ATOMIC_RELAXED, __HIP_MEMORY_SCOPE_AGENT); }
__device__ __forceinline__ unsigned xb_add(unsigned* p, unsigned v) { return __hip_atomic_fetch_add(p, v, __ATOMIC_RELAXED, __HIP_MEMORY_SCOPE_AGENT); }
__device__ __forceinline__ unsigned xb_xcc_id() { return (unsigned)__builtin_amdgcn_s_getreg((3 << 11) | 20) & 0xFu; }
#define XB_SPIN(cond, bar) do { unsigned _sp = 0; while (cond) { __builtin_amdgcn_s_sleep(1); \
    if ((++_sp & 255u) == 0u) { if (xb_ld(&(bar)[XB_TMO])) break; if (_sp > XB_SPIN_CAP) { atomicAdd(&(bar)[XB_TMO], 1u); break; } } } } while (0)

struct XcdBarrier {
    int wave;
    unsigned* bar; unsigned x;
    volatile LAS unsigned* st;
};

__device__ __forceinline__ XcdBarrier xcd_barrier_post(unsigned* bar, volatile LAS unsigned* st, int wave) {
    XcdBarrier b; b.wave = wave; b.bar = bar; b.x = xb_xcc_id(); b.st = st;
    if (wave == 0 && mk_lane() == 0) (void)xb_add(&bar[XB_XCNT(b.x)], 1u);
    return b;
}
__device__ __forceinline__ void xcd_barrier_complete(unsigned* bar, unsigned x, unsigned& nloc, unsigned& nx) {
    const unsigned G = gridDim.x * gridDim.y * gridDim.z;
    unsigned sum, cnt, mine, sp = 0u;
    for (;;) {
        sum = 0u; cnt = 0u; mine = 0u;
#pragma unroll
        for (unsigned j = 0; j < 16; ++j) { const unsigned c = xb_ld(&bar[XB_XCNT(j)]); sum += c; cnt += (c > 0u) ? 1u : 0u; mine = (j == x) ? c : mine; }
        if (sum == G) break;
        __builtin_amdgcn_s_sleep(1);
        if ((++sp & 255u) == 0u) { if (xb_ld(&bar[XB_TMO])) break; if (sp > XB_SPIN_CAP) { atomicAdd(&bar[XB_TMO], 1u); break; } }
    }
    nloc = mine > 0u ? mine : 1u; nx = cnt > 0u ? cnt : 1u;
}

__device__ __forceinline__ void xcd_barrier(const XcdBarrier& b) {
    asm volatile("s_waitcnt vmcnt(0)" ::: "memory");
    __syncthreads();
    if (b.wave == 0 && mk_lane() == 0) {
        unsigned* bar = b.bar;
        __builtin_amdgcn_s_waitcnt(0);
        unsigned nloc = b.st[0], nx = b.st[1];
        if (nloc == 0u) { xcd_barrier_complete(bar, b.x, nloc, nx); b.st[0] = nloc; b.st[1] = nx; }
        const unsigned old = xb_add(&bar[XB_XSUB(b.x)], 1u);
        const unsigned gen = old / nloc;
        if (old + 1u == (gen + 1u) * nloc) {
            __builtin_amdgcn_fence(__ATOMIC_RELEASE, "agent");
            asm volatile("s_waitcnt vmcnt(0)" ::: "memory");
            const unsigned og = xb_add(&bar[XB_TOP], 1u);
            const unsigned tg = og / nx;
            if (og + 1u == (tg + 1u) * nx) xb_add(&bar[XB_TOPGEN], 1u);
            else XB_SPIN(xb_ld(&bar[XB_TOPGEN]) == tg, bar);
            __builtin_amdgcn_fence(__ATOMIC_ACQUIRE, "agent");
            xb_add(&bar[XB_XGEN(b.x)], 1u);
            asm volatile("s_waitcnt vmcnt(0)" ::: "memory");
        } else {
            XB_SPIN(xb_ld(&bar[XB_XGEN(b.x)]) == gen, bar);
            __builtin_amdgcn_fence(__ATOMIC_ACQUIRE, "agent");
            asm volatile("s_waitcnt vmcnt(0)" ::: "memory");
        }
    }
    __syncthreads();
}
struct Frame {
    LAS unsigned char* lds;
    volatile LAS unsigned* MISC;
    gu32* ctl;
    int tid, lane, wave;
    int vcu, G;
    float* out;
    unsigned char* ws;
};
__device__ __forceinline__ float wave_sum(float v) {
#pragma unroll
    for (int o = 1; o < 64; o <<= 1) v += __shfl_xor(v, o);
    return v;
}

enum { J_GU = 0, J_D = 1, J_INA = 2, J_INB = 3, J_BR = 4, J_OUT = 5 };
struct SrcDesc { const float* W; int N; int n0; int k0; };
__device__ __forceinline__ SrcDesc wsrc(int job, int g, int kb, const float* w0, const float* w1) {
    SrcDesc s; s.W = w0; s.k0 = 64 * kb; const int v0 = 32 * g, pn = v0 >> 8, j = v0 & 255;
    switch (job) {
    case J_GU:  s.W = (j < 128) ? w0 : w1; s.N = D_FF; s.n0 = 128 * pn + (j & 127); break;
    case J_D:   s.N = D_MODEL; s.n0 = v0; break;
    case J_INA: { s.N = IN_WIDTH; const int sec = pn >> 1;
        if (sec == 0 || sec == 1 || sec == 3 || sec == 4) s.n0 = 512 * sec + ((pn & 1) * 4 + ((j & 127) >> 5)) * 64 + 32 * (j >> 7);
        else if (sec == 2 || sec == 5 || sec == 6) s.n0 = 512 * sec + 256 * (pn & 1) + j;
        else { if (j < 96) s.n0 = 3584 + j; else s.W = nullptr; } } break;
    case J_INB: s.N = IN_WIDTH; s.n0 = 3664 + v0; break;
    case J_BR:  { s.N = D_MODEL; s.n0 = 128 * pn + (j & 127);
        if (j < 128) { if (kb >= 8) s.W = nullptr; } else { if (kb < 8) s.W = nullptr; else { s.W = w1; s.k0 = 64 * kb - 512; } } } break;
    default:    s.N = D_MODEL; s.n0 = v0; break;
    }
    return s;
}
__device__ __forceinline__ void transpose_item(const SrcDesc s, bf16* WT, int Kd, int g, int kb, LAS float* scr, int lane) {
    const int c = lane & 7;
    if (s.W == nullptr) {
#pragma unroll
        for (int jj = 0; jj < 4; ++jj) { const int n = (lane >> 3) + 8 * jj; *(GAS v4u*)(WT + (size_t)(32 * g + n) * Kd + 64 * kb + 8 * c) = (v4u){0u, 0u, 0u, 0u}; }
        return;
    }
#pragma unroll 8
    for (int i = 0; i < 32; ++i) { const int kk = 2 * i + (lane >> 5); scr[kk * 33 + (lane & 31)] = s.W[(size_t)(s.k0 + kk) * s.N + s.n0 + (lane & 31)]; }
    LDS_WAIT(); asm volatile("" ::: "memory");
#pragma unroll
    for (int jj = 0; jj < 4; ++jj) { const int n = (lane >> 3) + 8 * jj; const LAS float* p = scr + (8 * c) * 33 + n;
        v4u o; o.x = pk2(p[0 * 33], p[1 * 33]); o.y = pk2(p[2 * 33], p[3 * 33]); o.z = pk2(p[4 * 33], p[5 * 33]); o.w = pk2(p[6 * 33], p[7 * 33]);
        *(GAS v4u*)(WT + (size_t)(32 * g + n) * Kd + 64 * kb + 8 * c) = o; }
    LDS_WAIT(); asm volatile("" ::: "memory");
}
__device__ __forceinline__ int transpose_job(Frame& F, int job, const float* w0, const float* w1, bf16* WT, int rows, int Kd, int base) {
    LAS float* scr = (LAS float*)(F.lds + F.wave * 16384);
    const int nkb = Kd / 64, nitem = (rows / 32) * nkb, gw = F.vcu * NWAVES + F.wave, NGW = F.G * NWAVES;
    int first = (gw - base % NGW + NGW) % NGW;
    for (int it = first; it < nitem; it += NGW) { const int g = it / nkb, kb = it % nkb; transpose_item(wsrc(job, g, kb, w0, w1), WT, Kd, g, kb, scr, F.lane); }
    return base + nitem;
}
template <bool F8> __device__ __forceinline__ void transpose_item64(const SrcDesc sA, const SrcDesc sB, void* WTv, int Kd, int g2, int kb, LAS float* scr, int lane, float wsc) {
    const int nq = (lane & 15) * 4, kr = lane >> 4;
    const SrcDesc s = (nq < 32) ? sA : sB;
    f32x4 v[16];
    if (s.W != nullptr) {
        const float* p = s.W + (size_t)(s.k0 + kr) * s.N + s.n0 + (nq & 31);
#pragma unroll
        for (int i = 0; i < 16; ++i) v[i] = __builtin_nontemporal_load((const f32x4*)(p + (size_t)(4 * i) * s.N));
    } else {
#pragma unroll
        for (int i = 0; i < 16; ++i) v[i] = (f32x4){0.f, 0.f, 0.f, 0.f};
    }
#pragma unroll
    for (int i = 0; i < 16; ++i) { const int k = 4 * i + kr; scr[(nq + 0) * 65 + k] = v[i].x; scr[(nq + 1) * 65 + k] = v[i].y; scr[(nq + 2) * 65 + k] = v[i].z; scr[(nq + 3) * 65 + k] = v[i].w; }
    LDS_WAIT(); asm volatile("" ::: "memory");
    if constexpr (F8) {
        unsigned char* WT = (unsigned char*)WTv;
#pragma unroll
        for (int j = 0; j < 4; ++j) { const int n = (lane >> 2) + 16 * j, c = lane & 3; const LAS float* q = scr + n * 65 + 16 * c;
            v4u o; o.x = pg8::pk4_fp8(q[0] * wsc, q[1] * wsc, q[2] * wsc, q[3] * wsc); o.y = pg8::pk4_fp8(q[4] * wsc, q[5] * wsc, q[6] * wsc, q[7] * wsc);
            o.z = pg8::pk4_fp8(q[8] * wsc, q[9] * wsc, q[10] * wsc, q[11] * wsc); o.w = pg8::pk4_fp8(q[12] * wsc, q[13] * wsc, q[14] * wsc, q[15] * wsc);
            *(GAS v4u*)(WT + (size_t)(64 * g2 + n) * Kd + 64 * kb + 16 * c) = o; }
    } else {
        bf16* WT = (bf16*)WTv;
#pragma unroll
        for (int j = 0; j < 8; ++j) { const int n = (lane >> 3) + 8 * j, c = lane & 7; const LAS float* q = scr + n * 65 + 8 * c;
            v4u o; o.x = pk2(q[0], q[1]); o.y = pk2(q[2], q[3]); o.z = pk2(q[4], q[5]); o.w = pk2(q[6], q[7]);
            *(GAS v4u*)(WT + (size_t)(64 * g2 + n) * Kd + 64 * kb + 8 * c) = o; }
    }
    LDS_WAIT(); asm volatile("" ::: "memory");
}
template <bool F8> __device__ __forceinline__ int transpose_job64(Frame& F, int job, const float* w0, const float* w1, void* WT, int rows, int Kd, int base, float wsc, const int g2off = 0, const int sub_first = -1, const int sub_n = 0) {
    LAS float* scr = (LAS float*)(F.lds + F.wave * 16896);
    const int nkb = Kd / 64, nitem = (rows / 64) * nkb;
    if (sub_first >= 0 && ((int)blockIdx.x < sub_first || (int)blockIdx.x >= sub_first + sub_n)) return base;
    const int gw = sub_first >= 0 ? ((int)blockIdx.x - sub_first) * NWAVES + F.wave : F.vcu * NWAVES + F.wave, NGW = sub_first >= 0 ? sub_n * NWAVES : F.G * NWAVES;
    int first = (gw - base % NGW + NGW) % NGW;
    for (int it = first; it < nitem; it += NGW) { const int g2 = it / nkb, kb = it % nkb;
        transpose_item64<F8>(wsrc(job, 2 * (g2 + g2off), kb, w0, w1), wsrc(job, 2 * (g2 + g2off) + 1, kb, w0, w1), WT, Kd, g2, kb, scr, F.lane, wsc); }
    return sub_first >= 0 ? base : base + nitem;
}

__device__ __forceinline__ void ffn_copies_queue(Frame& F, gu32* counter, const float* wg, const float* wu, const float* wd, void* Wgu_, void* Wd_) {
    LAS float* scr = (LAS float*)(F.lds + F.wave * 16896);
    constexpr int N_GU = (2 * D_FF / 64) * (D_MODEL / 64), N_D = (D_MODEL / 64) * (D_FF / 64);
    for (;;) {
        int it0 = 0; if (F.lane == 0) it0 = (int)__hip_atomic_fetch_add((unsigned*)counter, 4u, __ATOMIC_RELAXED, __HIP_MEMORY_SCOPE_AGENT);
        it0 = __builtin_amdgcn_readfirstlane(it0);
        if (it0 >= N_GU + N_D) break;
      for (int it = it0; it < it0 + 4 && it < N_GU + N_D; ++it) {
        if (it < N_GU) { const int nkb = D_MODEL / 64, g2 = it / nkb, kb = it % nkb;
            transpose_item64<true>(wsrc(J_GU, 2 * g2, kb, wg, wu), wsrc(J_GU, 2 * g2 + 1, kb, wg, wu), Wgu_, D_MODEL, g2, kb, scr, F.lane, 32.f); }
        else { const int i2 = it - N_GU, nkb = D_FF / 64, g2 = i2 / nkb, kb = i2 % nkb;
            transpose_item64<true>(wsrc(J_D, 2 * g2, kb, wd, nullptr), wsrc(J_D, 2 * g2 + 1, kb, wd, nullptr), Wd_, D_FF, g2, kb, scr, F.lane, 64.f); }
      }
    }
}

__device__ __forceinline__ void dsa_plan(int h, int qb, int& np, int& per) {
    const float sl2 = exp2f(-(float)(h + 1)) * 1.4426950408889634f; const int cap = 5 + (int)((180.f + 68.f / sl2) * (1.f / 64.f));
    const int full = 4 * (qb + 1), L = full < cap ? full : cap;
    np = L > 64 ? 2 : 1; per = (L + np - 1) / np;
}
constexpr int AQ_CAP = 1024;
__device__ __forceinline__ void build_attn_queues(Frame& F, const float* b_forget, const float* qn_fox, const float* kn_fox) {
    LAS float* Lh = (LAS float*)(F.lds);
    LAS float* cs = (LAS float*)(F.lds + 64);
    LAS float* tot = (LAS float*)(F.lds + 64 + 2048);
    LAS int* hist = (LAS int*)(F.lds + 4096);
    LAS int* cnt = (LAS int*)(F.lds + 4096 + 8 * 132 * 4);
    unsigned* ord = (unsigned*)(F.ws + WS_AORDER);
    const int t = F.tid;
    for (int i = t; i < 8 * 132 + 8; i += NWAVES * 64) hist[i] = 0;
    if (F.wave == 0) { float mq = fabsf(qn_fox[F.lane]), mk = fabsf(kn_fox[F.lane]);
#pragma unroll
        for (int o = 1; o < 64; o <<= 1) { mq = fmaxf(mq, __shfl_xor(mq, o)); mk = fmaxf(mk, __shfl_xor(mk, o)); }
        const float qk2 = 64.f * 0.125f * 1.4426950408889634f * mq * mk;
        if (F.lane < 8) { float l = (40.f + 2.f * qk2) / (1.4426950408889634f * 1.65f * __expf(-b_forget[F.lane]) * 64.f); Lh[F.lane] = l < 1.f ? 1.f : (l > 128.f ? 128.f : l); } }
    __syncthreads();
    int len[3]; unsigned id[3]; float cost[3]; float mine = 0.f;
#pragma unroll
    for (int i = 0; i < 3; ++i) { const int s = 3 * t + i, b = s >= 768 ? 1 : 0, e = s - 768 * b; len[i] = 0; id[i] = 0u; cost[i] = 0.f;
        if (e < 512) { const int h = 7 - (e >> 6), qb = 31 - ((e >> 1) & 31), pc = e & 1; int np, per; dsa_plan(h, qb, np, per);
            if (pc < np) { const float sl2 = exp2f(-(float)(h + 1)) * 1.4426950408889634f; const int cap = 5 + (int)((180.f + 68.f / sl2) * (1.f / 64.f)); const int full = 4 * (qb + 1), L = full < cap ? full : cap;
                len[i] = np == 1 ? L : (pc == 0 ? per : L - per); cost[i] = (float)len[i] + 2.f; id[i] = 512u | (unsigned)(b << 8 | h << 5 | qb | pc << 10 | np << 12); } }
        else { const int h = (e - 512) >> 5, qb = 31 - (e & 31); const int full = 4 * (qb + 1), L0 = 4 + (int)Lh[h], L = full < L0 ? full : L0;
            len[i] = L; cost[i] = 0.7f * (float)L + 2.f; id[i] = (unsigned)(b << 8 | h << 5 | qb | 1 << 12); }
        mine += cost[i]; }
    float inc = mine;
#pragma unroll
    for (int o = 1; o < 64; o <<= 1) { const float v = __shfl_up(inc, o); if (F.lane >= o) inc += v; }
    if (F.lane == 63) cs[F.wave] = inc;
    __syncthreads();
    float wbase = 0.f, tot0 = 0.f, tot1 = 0.f;
#pragma unroll
    for (int w = 0; w < 8; ++w) { const float v = cs[w]; if (w < F.wave) wbase += v; if (w < 4) tot0 += v; else tot1 += v; }
    float run = wbase + inc - mine; int bin[3];
#pragma unroll
    for (int i = 0; i < 3; ++i) { const int s = 3 * t + i, b = s >= 768 ? 1 : 0; const float start = run - (b ? tot0 : 0.f); run += cost[i];
        int q = (int)(start * 4.f / (b ? tot1 : tot0)); q = q < 0 ? 0 : (q > 3 ? 3 : q); bin[i] = 4 * b + q;
        if (len[i] > 0) __hip_atomic_fetch_add(hist + bin[i] * 132 + len[i], 1, __ATOMIC_RELAXED, __HIP_MEMORY_SCOPE_WORKGROUP); }
    __syncthreads();
    {
        const int w = F.wave, l0 = 128 - 2 * F.lane, l1 = l0 - 1; const int c0 = hist[w * 132 + l0], c1 = hist[w * 132 + l1]; int incl = c0 + c1;
#pragma unroll
        for (int o = 1; o < 64; o <<= 1) { const int v = __shfl_up(incl, o); if (F.lane >= o) incl += v; }
        const int excl = incl - c0 - c1; hist[w * 132 + l0] = excl; hist[w * 132 + l1] = excl + c0;
        if (F.lane == 63) ord[8 * AQ_CAP + w] = (unsigned)(incl < AQ_CAP ? incl : AQ_CAP); }
    __syncthreads();
#pragma unroll
    for (int i = 0; i < 3; ++i) if (len[i] > 0) { const int pos = __hip_atomic_fetch_add(hist + bin[i] * 132 + len[i], 1, __ATOMIC_RELAXED, __HIP_MEMORY_SCOPE_WORKGROUP); if (pos < AQ_CAP) ord[bin[i] * AQ_CAP + pos] = id[i]; }
    __syncthreads();
}

__device__ __forceinline__ void mod_gemv(Frame& F, int item, const float* cin, const float* W, const float* bias) {
    float* mod = (float*)(F.ws + WS_MOD);
    LAS float* sc = (LAS float*)(F.lds);
    LAS float* red = (LAS float*)(F.lds + 8192);
    for (int i = F.tid; i < 2048; i += NWAVES * 64) { const float v = cin[i]; sc[i] = v / (1.f + __expf(-v)); }
    __syncthreads();
    const int col = 128 * item + 2 * F.lane, kbeg = 128 * F.wave;
    float a00 = 0.f, a01 = 0.f, a10 = 0.f, a11 = 0.f;
#pragma unroll 16
    for (int k = 0; k < 128; ++k) { const f32x2g w = __builtin_nontemporal_load((const f32x2g*)(W + (size_t)(kbeg + k) * 9216 + col)); const float s0 = sc[kbeg + k], s1 = sc[1024 + kbeg + k];
        a00 += s0 * w.x; a01 += s0 * w.y; a10 += s1 * w.x; a11 += s1 * w.y; }
    red[F.wave * 256 + 2 * F.lane] = a00; red[F.wave * 256 + 2 * F.lane + 1] = a01; red[F.wave * 256 + 128 + 2 * F.lane] = a10; red[F.wave * 256 + 128 + 2 * F.lane + 1] = a11;
    __syncthreads();
    if (F.tid < 256) { const int bb = F.tid >> 7, cc = F.tid & 127; float s = 0.f;
#pragma unroll
        for (int w = 0; w < 8; ++w) s += red[w * 256 + bb * 128 + cc];
        mod[bb * 9216 + 128 * item + cc] = s + bias[128 * item + cc]; }
    __syncthreads();
}
template <bool IN16 = false> __device__ __forceinline__ void norm_phase(Frame& F, const void* xin, const float* g, int nmod, bf16* H, unsigned char* H8 = nullptr) {
    const float* mod = (const float*)(F.ws + WS_MOD);
    const int gw = F.vcu * NWAVES + F.wave, NGW = F.G * NWAVES;
#pragma unroll 4
    for (int m = gw; m < M; m += NGW) {
        const int b = m >> 13;
        f32x4 v[4]; float s = 0.f;
        if constexpr (IN16) { const GAS unsigned long long* xr = (const GAS unsigned long long*)((const bf16*)xin + (size_t)m * D_MODEL) + F.lane;
#pragma unroll
            for (int j = 0; j < 4; ++j) { const unsigned long long r2 = xr[64 * j]; const unsigned r0 = (unsigned)r2, r1 = (unsigned)(r2 >> 32);
                v[j].x = __builtin_bit_cast(float, r0 << 16); v[j].y = __builtin_bit_cast(float, r0 & 0xffff0000u); v[j].z = __builtin_bit_cast(float, r1 << 16); v[j].w = __builtin_bit_cast(float, r1 & 0xffff0000u); } }
        else { const GAS f32x4* xr = (const GAS f32x4*)((const float*)xin + (size_t)m * D_MODEL) + F.lane;
#pragma unroll
            for (int j = 0; j < 4; ++j) v[j] = xr[64 * j]; }
#pragma unroll
        for (int j = 0; j < 4; ++j) s += (v[j].x * v[j].x + v[j].y * v[j].y) + (v[j].z * v[j].z + v[j].w * v[j].w);
        const float rstd = 1.f / sqrtf(wave_sum(s) * (1.f / D_MODEL) + 1e-6f);
        GAS unsigned long long* o8 = (GAS unsigned long long*)(H + (size_t)m * D_MODEL) + F.lane;
#pragma unroll
        for (int j = 0; j < 4; ++j) { const int c = 4 * F.lane + 256 * j;
            const f32x4 gg = *(const f32x4*)(g + c), shv = *(const f32x4*)(mod + b * 9216 + nmod * 1024 + c), scv = *(const f32x4*)(mod + b * 9216 + (nmod + 1) * 1024 + c);
            const f32x4 y = v[j] * rstd * gg * (scv + 1.f) + shv;
            o8[64 * j] = (unsigned long long)pk2(y.x, y.y) | ((unsigned long long)pk2(y.z, y.w) << 32);
            if (H8) ((GAS unsigned*)(H8 + (size_t)m * D_MODEL) + F.lane)[64 * j] = pg8::pk4_fp8(y.x, y.y, y.z, y.w); }
    }
}

__device__ __forceinline__ void transpose_item8(const SrcDesc s, unsigned char* WT, int Kd, int g, int kb, LAS float* scr, int lane, float wsc) {
#pragma unroll 8
    for (int i = 0; i < 32; ++i) { const int kk = 2 * i + (lane >> 5); scr[kk * 33 + (lane & 31)] = s.W[(size_t)(s.k0 + kk) * s.N + s.n0 + (lane & 31)]; }
    LDS_WAIT(); asm volatile("" ::: "memory");
    const int n = lane >> 1, h = lane & 1; const LAS float* p = scr + (32 * h) * 33 + n;
    v4u o0, o1;
#define T8W(i_) pg8::pk4_fp8(p[(4 * (i_) + 0) * 33] * wsc, p[(4 * (i_) + 1) * 33] * wsc, p[(4 * (i_) + 2) * 33] * wsc, p[(4 * (i_) + 3) * 33] * wsc)
    o0.x = T8W(0); o0.y = T8W(1); o0.z = T8W(2); o0.w = T8W(3); o1.x = T8W(4); o1.y = T8W(5); o1.z = T8W(6); o1.w = T8W(7);
#undef T8W
    unsigned char* d = WT + (size_t)(32 * g + n) * Kd + 64 * kb + 32 * h;
    *(GAS v4u*)d = o0; *(GAS v4u*)(d + 16) = o1;
    LDS_WAIT(); asm volatile("" ::: "memory");
}
__device__ __forceinline__ int transpose_job8(Frame& F, int job, const float* w0, const float* w1, unsigned char* WT, int rows, int Kd, int base, float wsc) {
    LAS float* scr = (LAS float*)(F.lds + F.wave * 16384);
    const int nkb = Kd / 64, nitem = (rows / 32) * nkb, gw = F.vcu * NWAVES + F.wave, NGW = F.G * NWAVES;
    int first = (gw - base % NGW + NGW) % NGW;
    for (int it = first; it < nitem; it += NGW) { const int g = it / nkb, kb = it % nkb; transpose_item8(wsrc(job, g, kb, w0, w1), WT, Kd, g, kb, scr, F.lane, wsc); }
    return base + nitem;
}
template <bool IN16 = false> __device__ __forceinline__ void norm_phase8(Frame& F, const void* xin, const float* g, int nmod, unsigned char* H8) {
    const float* mod = (const float*)(F.ws + WS_MOD);
    const int gw = F.vcu * NWAVES + F.wave, NGW = F.G * NWAVES;
#pragma unroll 4
    for (int m = gw; m < M; m += NGW) {
        const int b = m >> 13;
        f32x4 v[4]; float s = 0.f;
        if constexpr (IN16) { const GAS unsigned long long* xr = (const GAS unsigned long long*)((const bf16*)xin + (size_t)m * D_MODEL) + F.lane;
#pragma unroll
            for (int j = 0; j < 4; ++j) { const unsigned long long r2 = xr[64 * j]; const unsigned r0 = (unsigned)r2, r1 = (unsigned)(r2 >> 32);
                v[j].x = __builtin_bit_cast(float, r0 << 16); v[j].y = __builtin_bit_cast(float, r0 & 0xffff0000u); v[j].z = __builtin_bit_cast(float, r1 << 16); v[j].w = __builtin_bit_cast(float, r1 & 0xffff0000u); } }
        else { const GAS f32x4* xr = (const GAS f32x4*)((const float*)xin + (size_t)m * D_MODEL) + F.lane;
#pragma unroll
            for (int j = 0; j < 4; ++j) v[j] = xr[64 * j]; }
#pragma unroll
        for (int j = 0; j < 4; ++j) s += (v[j].x * v[j].x + v[j].y * v[j].y) + (v[j].z * v[j].z + v[j].w * v[j].w);
        const float rstd = 1.f / sqrtf(wave_sum(s) * (1.f / D_MODEL) + 1e-6f);
        GAS unsigned* o4 = (GAS unsigned*)(H8 + (size_t)m * D_MODEL) + F.lane;
#pragma unroll
        for (int j = 0; j < 4; ++j) { const int c = 4 * F.lane + 256 * j;
            const f32x4 gg = *(const f32x4*)(g + c), shv = *(const f32x4*)(mod + b * 9216 + nmod * 1024 + c), scv = *(const f32x4*)(mod + b * 9216 + (nmod + 1) * 1024 + c);
            const f32x4 y = v[j] * rstd * gg * (scv + 1.f) + shv;
            o4[64 * j] = pg8::pk4_fp8(y.x, y.y, y.z, y.w); }
    }
}

__device__ __forceinline__ unsigned sortable_key(float s) { unsigned u = __builtin_bit_cast(unsigned, s); if (u == 0x80000000u) u = 0u; return (u & 0x80000000u) ? ~u : (u | 0x80000000u); }
__device__ __forceinline__ void fscan_row(const float* lf, float* f2, int lane) {
    const f32x4* src = (const f32x4*)(lf + lane * 128);
    f32x4 v[32];
#pragma unroll
    for (int i = 0; i < 32; ++i) v[i] = src[i];
    float run = 0.f;
#pragma unroll
    for (int i = 0; i < 32; ++i) { v[i].x += run; v[i].y += v[i].x; v[i].z += v[i].y; v[i].w += v[i].z; run = v[i].w; }
    float s = run;
#pragma unroll
    for (int o = 1; o < 64; o <<= 1) { const float t = __shfl_up(s, o); if (lane >= o) s += t; }
    const float ex = s - run;
    f32x4* dst = (f32x4*)(f2 + lane * 128);
#pragma unroll
    for (int i = 0; i < 32; ++i) { f32x4 r; r.x = (ex + v[i].x) * 1.4426950408889634f; r.y = (ex + v[i].y) * 1.4426950408889634f; r.z = (ex + v[i].z) * 1.4426950408889634f; r.w = (ex + v[i].w) * 1.4426950408889634f; dst[i] = r; }
}
__device__ __forceinline__ void idx_unit(Frame& F, int b, int t4, const bf16* QI, const bf16* KI, const float* WI, unsigned long long* MASK, int rot, const int mode = 3) {
    typedef short bf16x8v __attribute__((ext_vector_type(8))); typedef float f32x16v __attribute__((ext_vector_type(16)));
    LAS unsigned* sc = (LAS unsigned*)(F.lds);
    LAS unsigned* hist = (LAS unsigned*)(F.lds + 131072);
    int lane = mk_lane(); asm volatile("" : "+v"(lane));
    const int r32 = lane & 31, hi = lane >> 5, wid = F.wave;
    const int t0 = 4 * t4, ntile = (t0 + 4 + 31) >> 5, n = ntile * 32;
    const size_t rb = (size_t)b * SEQ;
    bf16x8v qa[4];
    { const bf16* qp = QI + (rb + t0 + (r32 >> 3)) * 512 + (r32 & 7) * 64 + hi * 8;
#pragma unroll
      for (int ks = 0; ks < 4; ++ks) qa[ks] = *(const bf16x8v*)(qp + ks * 16); }
    float wv[16];
#pragma unroll
    for (int r = 0; r < 16; ++r) wv[r] = WI[(rb + t0 + (r >> 2)) * 8 + (r & 3) + 4 * hi];
    for (int i = F.tid; i < 4096; i += NWAVES * 64) hist[i] = 0u;
#define IDX_LOADK(dst, tile_) do { const bf16* kp_ = KI + ((rb >> 5) + (tile_)) * 2048 + (hi * 32 + r32) * 8; _Pragma("unroll") for (int ks = 0; ks < 4; ++ks) dst[ks] = *(const bf16x8v*)(kp_ + ks * 512); } while (0)
#define IDX_SCORE(kf, tile_) do { const int key = (tile_) * 32 + r32; f32x16v acc = {}; \
        _Pragma("unroll") for (int ks = 0; ks < 4; ++ks) acc = __builtin_amdgcn_mfma_f32_32x32x16_bf16(qa[ks], kf[ks], acc, 0, 0, 0); \
        unsigned u[4]; \
        _Pragma("unroll") for (int q_ = 0; q_ < 4; ++q_) { \
            float s = wv[4 * q_] * fmaxf(acc[4 * q_], 0.f); \
            s += wv[4 * q_ + 1] * fmaxf(acc[4 * q_ + 1], 0.f); s += wv[4 * q_ + 2] * fmaxf(acc[4 * q_ + 2], 0.f); s += wv[4 * q_ + 3] * fmaxf(acc[4 * q_ + 3], 0.f); \
            s = att::xhalf_sum(s); \
            u[q_] = (key <= t0 + q_) ? sortable_key(s) : 0u; } \
        if (hi == 0) { sc[key] = u[0]; sc[8192 + key] = u[1]; } else { sc[16384 + key] = u[2]; sc[24576 + key] = u[3]; } } while (0)
    {
        const int np = (ntile + 1) >> 1;
        const int cnt = ((mode & 1) && wid < np) ? ((np - wid + NWAVES - 1) / NWAVES) : 0;
        bf16x8v ka[4], kc[4], na[4], nc[4];
        int p = (wid + rot) % np;
        if (cnt > 0) { IDX_LOADK(ka, 2 * p); const int t1 = (2 * p + 1 < ntile) ? 2 * p + 1 : ntile - 1; IDX_LOADK(kc, t1); }
        for (int i = 0; i < cnt; ++i) {
            int pn = p;
            if (i + 1 < cnt) { pn = p + NWAVES; if (pn >= np) pn = pn % np; }
            { IDX_LOADK(na, 2 * pn); const int t1 = (2 * pn + 1 < ntile) ? 2 * pn + 1 : ntile - 1; IDX_LOADK(nc, t1); }
            IDX_SCORE(ka, 2 * p);
            if (2 * p + 1 < ntile) IDX_SCORE(kc, 2 * p + 1);
#pragma unroll
            for (int ks = 0; ks < 4; ++ks) { ka[ks] = na[ks]; kc[ks] = nc[ks]; }
            p = pn;
        }
    }
#undef IDX_LOADK
#undef IDX_SCORE
    __syncthreads();
    if (!(mode & 2)) { __syncthreads(); return; }
    const int q = wid >> 1, part = wid & 1;
    LAS unsigned* scq = sc + q * 8192;
    const int kk = (t0 + q + 1 < TOPK) ? (t0 + q + 1) : TOPK;
    const int nw = (n + 63) >> 6, nj = (nw - part + 1) >> 1;
    unsigned key[64];
#pragma unroll
    for (int g = 0; g < 8; ++g) {
        if (8 * g < nj) {
#pragma unroll
            for (int jj = 0; jj < 8; ++jj) { const int e = (2 * (8 * g + jj) + part) * 64 + lane; key[8 * g + jj] = (e < n) ? scq[e] : 0u; }
        } else {
#pragma unroll
            for (int jj = 0; jj < 8; ++jj) key[8 * g + jj] = 0u;
        }
    }
    const int sub = lane & 3;
    unsigned prefix = 0u, himask = 0u; int need = kk, n_eq = 0; bool done = false;
#pragma unroll 1
    for (int lvl = 0; lvl < 4; ++lvl) {
        const int shift = 24 - 8 * lvl;
        LAS unsigned* Hq = hist + (lvl & 1) * 2048 + q * 512;
        if (!done) {
#pragma unroll
            for (int g = 0; g < 8; ++g) {
                if (8 * g < nj) {
#pragma unroll
                    for (int jj = 0; jj < 8; ++jj) { const unsigned uu = key[8 * g + jj];
                        if (uu != 0u && (uu & himask) == prefix) { const unsigned d = (uu >> shift) & 255u;
                            __hip_atomic_fetch_add(Hq + ((d >> 1) << 2) + sub, (d & 1u) ? 65536u : 1u, __ATOMIC_RELAXED, __HIP_MEMORY_SCOPE_WORKGROUP); } }
                }
            }
        }
        __syncthreads();
        if (!done) {
            const u32x4g w0 = *(const LAS u32x4g*)(Hq + 8 * lane), w1 = *(const LAS u32x4g*)(Hq + 8 * lane + 4);
            const unsigned h0 = (w0.x & 0xffffu) + (w0.y & 0xffffu) + (w0.z & 0xffffu) + (w0.w & 0xffffu), h1 = (w0.x >> 16) + (w0.y >> 16) + (w0.z >> 16) + (w0.w >> 16);
            const unsigned h2 = (w1.x & 0xffffu) + (w1.y & 0xffffu) + (w1.z & 0xffffu) + (w1.w & 0xffffu), h3 = (w1.x >> 16) + (w1.y >> 16) + (w1.z >> 16) + (w1.w >> 16);
            const int lsum = (int)(h0 + h1 + h2 + h3);
            int incl = lsum;
#pragma unroll
            for (int o = 1; o < 64; o <<= 1) { const int t = __shfl_down(incl, o); if (lane + o < 64) incl += t; }
            const int S = incl - lsum;
            const bool has = (S < need) && (need <= incl);
            const int c3 = S + (int)h3, c2 = c3 + (int)h2, c1 = c2 + (int)h1;
            int bin, above, eqc;
            if (need <= c3) { bin = 3; above = S; eqc = (int)h3; } else if (need <= c2) { bin = 2; above = c3; eqc = (int)h2; } else if (need <= c1) { bin = 1; above = c2; eqc = (int)h1; } else { bin = 0; above = c1; eqc = (int)h0; }
            const unsigned long long bal = __ballot(has);
            const int src = (bal == 0ull) ? 0 : (__ffsll((long long)bal) - 1);
            bin = __shfl(4 * lane + bin, src); above = __shfl(above, src); n_eq = __shfl(eqc, src);
            prefix |= (unsigned)bin << shift; himask |= 255u << shift; need -= above;
            done = (need == n_eq);
        }
        { LAS unsigned* Hn = hist + ((lvl + 1) & 1) * 2048; Hn[F.tid] = 0u; Hn[F.tid + 512] = 0u; Hn[F.tid + 1024] = 0u; Hn[F.tid + 1536] = 0u; }
        __syncthreads();
    }
    const unsigned P = prefix;
    int idxs = 0x7fffffff;
    if (need < n_eq) {
        int running = 0;
        for (int c0 = 0; c0 < n; c0 += 64) {
            const int e = c0 + lane; const bool eq = (e < n) && (scq[e] == P);
            const unsigned long long bal = __ballot(eq); const int cnt2 = __popcll(bal);
            if (running + cnt2 >= need) {
                const int rank = __popcll(bal & ((1ull << lane) - 1ull)) + 1;
                const unsigned long long hit = __ballot(eq && (rank == need - running));
                idxs = c0 + (__ffsll((long long)hit) - 1); break; }
            running += cnt2;
        }
    }
    LAS unsigned long long* wrow = (LAS unsigned long long*)(hist) + wid * 64;
    wrow[lane] = 0ull;
#pragma unroll
    for (int g = 0; g < 8; ++g) {
        if (8 * g < nj) {
#pragma unroll
            for (int jj = 0; jj < 8; ++jj) { const int j = 8 * g + jj, e = (2 * j + part) * 64 + lane; const unsigned uu = key[j];
                const bool bsel = (uu > P) || (uu == P && e <= idxs && uu != 0u);
                const unsigned long long bal = __ballot(bsel);
                if (lane == 0) wrow[j] = bal; }
        }
    }
    MASK[(rb + t0 + q) * 128 + 2 * lane + part] = wrow[lane];
    __syncthreads();
}

constexpr int IDXC = 1024;
__device__ __forceinline__ int wave_total6(int c) { int t = 0;
#pragma unroll
    for (int bt = 0; bt < 6; ++bt) t += __popcll(__ballot((c >> bt) & 1)) << bt;
    return t; }
__device__ __forceinline__ int count_ge16(const unsigned (&e)[16], unsigned cand) {
    unsigned long long m0, m1, m2, m3, m4, m5, m6, m7;
#define CGE_(mm, j) asm("v_cmp_ge_u32_e64 %0, %1, %2" : "=s"(mm) : "v"(e[j]), "s"(cand))
    CGE_(m0, 0); CGE_(m1, 1); CGE_(m2, 2); CGE_(m3, 3); CGE_(m4, 4); CGE_(m5, 5); CGE_(m6, 6); CGE_(m7, 7);
    int c = ((__builtin_popcountll(m0) + __builtin_popcountll(m1)) + (__builtin_popcountll(m2) + __builtin_popcountll(m3))) + ((__builtin_popcountll(m4) + __builtin_popcountll(m5)) + (__builtin_popcountll(m6) + __builtin_popcountll(m7)));
    CGE_(m0, 8); CGE_(m1, 9); CGE_(m2, 10); CGE_(m3, 11); CGE_(m4, 12); CGE_(m5, 13); CGE_(m6, 14); CGE_(m7, 15);
#undef CGE_
    c += ((__builtin_popcountll(m0) + __builtin_popcountll(m1)) + (__builtin_popcountll(m2) + __builtin_popcountll(m3))) + ((__builtin_popcountll(m4) + __builtin_popcountll(m5)) + (__builtin_popcountll(m6) + __builtin_popcountll(m7)));
    return c;
}
__device__ __forceinline__ unsigned kth_largest16(const unsigned (&e)[16], int m, int total, int& cge_out, const int minbit = 0) {
    unsigned P = 0u; int cge = total;
#pragma unroll 1
    for (int bit = 31; bit >= minbit && cge != m; --bit) {
        const unsigned cand = P | (1u << bit);
        const int c = count_ge16(e, cand);
        if (c >= m) { P = cand; cge = c; }
    }
    cge_out = cge; return P;
}
__device__ __forceinline__ void xhalf_swap2(float& a, float& b) { asm volatile("s_nop 1\n\tv_permlane32_swap_b32 %0, %1\n\ts_nop 1" : "+v"(a), "+v"(b)); }
__device__ __forceinline__ float unsortable_key(unsigned u) { return __builtin_bit_cast(float, (u & 0x80000000u) ? (u & 0x7fffffffu) : ~u); }
typedef short i16_bf16x8v __attribute__((ext_vector_type(8)));
__device__ __forceinline__ void idx_load_q(i16_bf16x8v (&qa)[4][4], int b, int t16, const bf16* QI) {
    int lane = mk_lane(); const int r32 = lane & 31, hi = lane >> 5;
#pragma unroll
    for (int g = 0; g < 4; ++g) {
        const bf16* qp = QI + ((size_t)b * SEQ + 16 * t16 + 4 * g + (r32 >> 3)) * 512 + (r32 & 7) * 64 + hi * 8;
#pragma unroll
        for (int ks = 0; ks < 4; ++ks) qa[g][ks] = *(const i16_bf16x8v*)(qp + ks * 16);
    }
}
__device__ __forceinline__ void idx_unit16(Frame& F, int b, int t16, const bf16* QI, const bf16* KI, const float* WI, unsigned long long* MASK, int rot, i16_bf16x8v (&qa)[4][4], const int nb, const int nt16, const int mode = 3) {
    typedef short bf16x8v __attribute__((ext_vector_type(8))); typedef float f32x16v __attribute__((ext_vector_type(16)));
    LAS unsigned long long* be = (LAS unsigned long long*)(F.lds);
    LAS int* cnw = (LAS int*)(F.lds + 131072);
    LAS float* tau = (LAS float*)(F.lds + 131072 + 512);
    LAS int* flg = (LAS int*)(F.lds + 131072 + 576);
    LAS float* wl = (LAS float*)(F.lds + 132096);
    LAS unsigned* rows = (LAS unsigned*)(F.lds + 133120) + F.wave * 256;
    LAS unsigned long long* dump = (LAS unsigned long long*)(F.lds + 141312) + F.wave * 64;
    int lane = F.lane; asm volatile("" : "+v"(lane));
    const int tidv = F.wave * 64 + lane; const int r32 = lane & 31, hi = lane >> 5, wid = F.wave;
    const int t0 = 16 * t16, ntile = (t0 + 16 + 31) >> 5, npair = (ntile + 1) >> 1, nblk = (npair + 7) >> 3;
    const size_t rb = (size_t)b * SEQ;
    if (tidv < 16) { tau[tidv] = -INFINITY; flg[tidv] = 0; }
    if (tidv < 128) wl[tidv] = WI[(rb + t0) * 8 + tidv];
    __syncthreads();
    int cw[16];
#pragma unroll
    for (int i = 0; i < 16; ++i) cw[i] = 0;
#define I16_LOADK(dst, tile_) do { const bf16* kp_ = KI + ((rb >> 5) + (tile_)) * 2048 + (hi * 32 + r32) * 8; _Pragma("unroll") for (int ks = 0; ks < 4; ++ks) dst[ks] = *(const bf16x8v*)(kp_ + ks * 512); } while (0)
#define I16_TILE2(kfa, kfb, pair_, causal_) do { const int key = (pair_) * 64 + lane; LAS unsigned long long* dmp_ = dump + lane; \
        f32x4 w4n[4]; _Pragma("unroll") for (int q_ = 0; q_ < 4; ++q_) w4n[q_] = *(const LAS f32x4*)(wl + q_ * 8 + 4 * hi); \
        _Pragma("unroll") for (int g = 0; g < 4; ++g) { f32x16v acca = {}, accb = {}; \
            _Pragma("unroll") for (int ks = 0; ks < 4; ++ks) acca = __builtin_amdgcn_mfma_f32_32x32x16_bf16(qa[g][ks], kfa[ks], acca, 0, 0, 0); \
            _Pragma("unroll") for (int ks = 0; ks < 4; ++ks) accb = __builtin_amdgcn_mfma_f32_32x32x16_bf16(qa[g][ks], kfb[ks], accb, 0, 0, 0); \
            f32x4 w4c[4]; _Pragma("unroll") for (int q_ = 0; q_ < 4; ++q_) w4c[q_] = w4n[q_]; const f32x4 tq4 = *(const LAS f32x4*)(tau + 4 * g); \
            if (g < 3) { _Pragma("unroll") for (int q_ = 0; q_ < 4; ++q_) w4n[q_] = *(const LAS f32x4*)(wl + (4 * (g + 1) + q_) * 8 + 4 * hi); } \
            float ss_[4]; \
            _Pragma("unroll") for (int q_ = 0; q_ < 4; ++q_) { const int qq = 4 * g + q_; const f32x4 w4 = w4c[q_]; \
                  \
                  \
                float la = w4.x * acca[4 * q_], ma = w4.x * __builtin_fabsf(acca[4 * q_]); \
                la = __builtin_fmaf(w4.y, acca[4 * q_ + 1], la); ma = __builtin_fmaf(w4.y, __builtin_fabsf(acca[4 * q_ + 1]), ma); \
                la = __builtin_fmaf(w4.z, acca[4 * q_ + 2], la); ma = __builtin_fmaf(w4.z, __builtin_fabsf(acca[4 * q_ + 2]), ma); \
                la = __builtin_fmaf(w4.w, acca[4 * q_ + 3], la); ma = __builtin_fmaf(w4.w, __builtin_fabsf(acca[4 * q_ + 3]), ma); \
                float lb = w4.x * accb[4 * q_], mb = w4.x * __builtin_fabsf(accb[4 * q_]); \
                lb = __builtin_fmaf(w4.y, accb[4 * q_ + 1], lb); mb = __builtin_fmaf(w4.y, __builtin_fabsf(accb[4 * q_ + 1]), mb); \
                lb = __builtin_fmaf(w4.z, accb[4 * q_ + 2], lb); mb = __builtin_fmaf(w4.z, __builtin_fabsf(accb[4 * q_ + 2]), mb); \
                lb = __builtin_fmaf(w4.w, accb[4 * q_ + 3], lb); mb = __builtin_fmaf(w4.w, __builtin_fabsf(accb[4 * q_ + 3]), mb); \
                float sa = la + ma, sb = lb + mb; xhalf_swap2(sa, sb); \
                ss_[q_] = sa + sb; } \
            _Pragma("unroll") for (int q_ = 0; q_ < 4; ++q_) { const int qq = 4 * g + q_; const float s = ss_[q_];                                    \
                const float tq_ = q_ == 0 ? tq4.x : q_ == 1 ? tq4.y : q_ == 2 ? tq4.z : tq4.w; const bool pass = s >= tq_;                                                    \
                const unsigned long long bal = __builtin_amdgcn_ballot_w64(pass); \
                int pos_ = cw[qq] + (int)__builtin_amdgcn_mbcnt_hi((unsigned)(bal >> 32), __builtin_amdgcn_mbcnt_lo((unsigned)bal, 0u)); \
                pos_ = pos_ < 127 ? pos_ : 127;                                    \
                LAS unsigned long long* dst_ = pass ? (be + (qq * 8 + wid) * 128 + pos_) : dmp_; \
                *dst_ = (unsigned long long)__builtin_bit_cast(unsigned, s) | ((unsigned long long)(unsigned)key << 32); \
                cw[qq] += __popcll(bal); } } } while (0)
#define I16_PASS(sample_) do { bf16x8v ka[4], kb2[4], na[4], nb2[4]; int bb = -1, nb_ = -1; \
        for (int x = 0; x < nblk; ++x) { const int c_ = (sample_) ? x : ((x + rot) % nblk); if ((((c_ & 7) == 0) == (sample_)) && 8 * c_ + wid < npair) { bb = c_; nb_ = x; break; } } \
        if (bb >= 0) { const int p_ = 8 * bb + wid; I16_LOADK(ka, 2 * p_); I16_LOADK(kb2, (2 * p_ + 1 < ntile) ? 2 * p_ + 1 : ntile - 1); } \
        while (bb >= 0) { int nx = -1, nxi = -1; \
            for (int x = nb_ + 1; x < nblk; ++x) { const int c_ = (sample_) ? x : ((x + rot) % nblk); if ((((c_ & 7) == 0) == (sample_)) && 8 * c_ + wid < npair) { nx = c_; nxi = x; break; } } \
            { const int p_ = 8 * (nx >= 0 ? nx : bb) + wid; I16_LOADK(na, 2 * p_); I16_LOADK(nb2, (2 * p_ + 1 < ntile) ? 2 * p_ + 1 : ntile - 1); } \
            I16_TILE2(ka, kb2, 8 * bb + wid, true); \
            _Pragma("unroll") for (int ks = 0; ks < 4; ++ks) { ka[ks] = na[ks]; kb2[ks] = nb2[ks]; } \
            bb = nx; nb_ = nxi; } } while (0)
#define I16_PUBLISH() do { _Pragma("unroll") for (int i = 0; i < 16; ++i) { if (lane == 0) { cnw[i * 8 + wid] = cw[i] < 128 ? cw[i] : 128; if (cw[i] > 128) flg[i] = 1; } } } while (0)
#define I16_LOAD_LIST(qq_, e_, ix_, total_) do { total_ = 0; const u32x4g c0_ = *(const LAS u32x4g*)(cnw + (qq_) * 8), c1_ = *(const LAS u32x4g*)(cnw + (qq_) * 8 + 4); \
          \
        unsigned long long en_[16]; \
        _Pragma("unroll") for (int j = 0; j < 16; ++j) { const int sg = j >> 1, p = (j & 1) * 64 + lane; en_[j] = be[((qq_) * 8 + sg) * 128 + p]; } \
        asm volatile("" : "+v"(en_[0]), "+v"(en_[1]), "+v"(en_[2]), "+v"(en_[3]), "+v"(en_[4]), "+v"(en_[5]), "+v"(en_[6]), "+v"(en_[7]), "+v"(en_[8]), "+v"(en_[9]), "+v"(en_[10]), "+v"(en_[11]), "+v"(en_[12]), "+v"(en_[13]), "+v"(en_[14]), "+v"(en_[15]));     \
        _Pragma("unroll") for (int j = 0; j < 16; ++j) { const int sg = j >> 1, p = (j & 1) * 64 + lane; \
            const int cs = (int)(sg == 0 ? c0_.x : sg == 1 ? c0_.y : sg == 2 ? c0_.z : sg == 3 ? c0_.w : sg == 4 ? c1_.x : sg == 5 ? c1_.y : sg == 6 ? c1_.z : c1_.w); \
            const unsigned r_ = (unsigned)en_[j], x_ = (unsigned)(en_[j] >> 32); \
            const bool ok_ = (p < cs) && ((int)x_ <= t0 + (qq_)); total_ += __popcll(__ballot(ok_)); e_[j] = ok_ ? sortable_key(__builtin_bit_cast(float, r_)) : 0u; ix_[j] = ok_ ? (unsigned short)x_ : (unsigned short)0xffff; } \
        } while (0)
    I16_PASS(true);
    I16_PUBLISH();
    __syncthreads();
    if (mode == 4) return;
#ifndef PROBE_TAU_REP
#define PROBE_TAU_REP 1
#endif
#pragma unroll 1
    for (int w2 = 0; w2 < 2 * PROBE_TAU_REP; ++w2) {
        const int qq = 2 * wid + (w2 & 1), nc = t0 + qq + 1, kk = nc < TOPK ? nc : TOPK;
        if (nc > IDXC) {
            unsigned e[16]; unsigned short ix[16]; int ns;
            I16_LOAD_LIST(qq, e, ix, ns);
            const float mu = (float)kk * (float)ns / (float)nc; const int m = __builtin_amdgcn_readfirstlane((int)(mu + 5.f * sqrtf(mu) + 9.f));
            if (m < ns) { int cge; const unsigned P = kth_largest16(e, m, ns, cge, 15); if (lane == 0) tau[qq] = unsortable_key(P); }
        }
    }
    __syncthreads();
    if (mode == 8) return;
#pragma unroll
    for (int i = 0; i < 16; ++i) { const float tv = tau[i];
        if (tv != -INFINITY) { const int cs = cw[i] < 128 ? cw[i] : 128; LAS unsigned long long* sk = be + (i * 8 + wid) * 128;
            const unsigned long long e0 = sk[lane], e1 = sk[lane + 64];
            const bool k0 = (lane < cs) && (__builtin_bit_cast(float, (unsigned)e0) >= tv), k1 = (lane + 64 < cs) && (__builtin_bit_cast(float, (unsigned)e1) >= tv); const unsigned long long b0 = __ballot(k0), b1 = __ballot(k1);
            const int p0 = (int)__builtin_amdgcn_mbcnt_hi((unsigned)(b0 >> 32), __builtin_amdgcn_mbcnt_lo((unsigned)b0, 0u)), n0 = __popcll(b0);
            const int p1 = n0 + (int)__builtin_amdgcn_mbcnt_hi((unsigned)(b1 >> 32), __builtin_amdgcn_mbcnt_lo((unsigned)b1, 0u));
            if (k0) sk[p0] = e0; if (k1) sk[p1] = e1;
            cw[i] = n0 + __popcll(b1); } }
    I16_PASS(false);
    I16_PUBLISH();
    if (nt16 >= 0) idx_load_q(qa, nb, nt16, QI);
    __syncthreads();
    if (!(mode & 2)) return;
#undef I16_PASS
#undef I16_TILE2
#undef I16_LOADK
#undef I16_PUBLISH
#pragma unroll 1
    for (int w2 = 0; w2 < 2; ++w2) {
        const int qq = 2 * wid + w2, nc = t0 + qq + 1, kk = nc < TOPK ? nc : TOPK;
        unsigned e[16]; unsigned short ix[16]; int c;
        I16_LOAD_LIST(qq, e, ix, c);
#ifdef PROBE_FORCE_FALLBACK
        if ((t16 % 5) == 1 && (qq & 4)) { if (lane == 0) flg[qq] = 1; continue; }
#endif
        if (c < kk || flg[qq]) { if (lane == 0) flg[qq] = 1; continue; }
        int cge; const unsigned P = kth_largest16(e, kk, c, cge);
        int ilim = 0xffff;
        if (cge > kk) {
            int cgt = 0;
#pragma unroll
            for (int j = 0; j < 16; ++j) cgt += (e[j] > P) ? 1 : 0;
            cgt = wave_total6(cgt);
            const int need = kk - cgt; int I = 0;
#pragma unroll 1
            for (int bit = 12; bit >= 0; --bit) { const int cand = I | (1 << bit); int c2 = 0;
#pragma unroll
                for (int j = 0; j < 16; ++j) c2 += (e[j] == P && (int)ix[j] < cand) ? 1 : 0;
                c2 = wave_total6(c2);
                if (c2 < need) I = cand; }
            ilim = I;
        }
        rows[lane] = 0u; rows[lane + 64] = 0u; rows[lane + 128] = 0u; rows[lane + 192] = 0u;
#pragma unroll
        for (int j = 0; j < 16; ++j) { const bool sel = (e[j] > P && e[j] != 0u) || (e[j] == P && e[j] != 0u && (int)ix[j] <= ilim);
            if (sel) __hip_atomic_fetch_or(rows + (ix[j] >> 5), 1u << (ix[j] & 31), __ATOMIC_RELAXED, __HIP_MEMORY_SCOPE_WORKGROUP); }
        const u32x4g rv = *(const LAS u32x4g*)(rows + 4 * lane);
        *(u32x4g*)((unsigned*)(MASK + (rb + t0 + qq) * 128) + 4 * lane) = rv;
    }
#undef I16_LOAD_LIST
    __syncthreads();
    { int fl = (flg[0] | flg[1] | flg[2] | flg[3]) | ((flg[4] | flg[5] | flg[6] | flg[7]) << 1) | ((flg[8] | flg[9] | flg[10] | flg[11]) << 2) | ((flg[12] | flg[13] | flg[14] | flg[15]) << 3);
      fl = __builtin_amdgcn_readfirstlane(fl);
      __syncthreads();
#ifndef PROBE_NO_FALLBACK
#pragma unroll 1
      for (int g = 0; g < 4; ++g) if ((fl >> g) & 1) idx_unit(F, b, 4 * t16 + g, QI, KI, WI, MASK, rot);
#endif
      if (fl != 0 && nt16 >= 0) idx_load_q(qa, nb, nt16, QI);
    }
}

struct Args { const float* in[22]; float* out; unsigned char* ws; int ph_lo, ph_hi, li, pad; };
__global__ void __launch_bounds__(NWAVES * 64, 2) fwd_mega(Args args) {
    extern __shared__ __attribute__((aligned(16))) unsigned char lds[];
    Frame F;
    F.lds = (LAS unsigned char*)lds;
    F.MISC = (volatile LAS unsigned*)(F.lds + MISC_OFF);
    F.wave = __builtin_amdgcn_readfirstlane((int)threadIdx.x >> 6); F.lane = mk_lane(); F.tid = F.wave * 64 + F.lane;
#define REFRESH_IDS() do { F.lane = mk_lane(); F.tid = F.wave * 64 + F.lane; } while (0)
    F.G = gridDim.x; { const int bx = blockIdx.x; F.vcu = (F.G % 8 == 0) ? (bx % 8) * (F.G / 8) + bx / 8 : bx; }
    unsigned char* ws = args.ws; F.ws = ws; F.out = args.out;
    F.ctl = (gu32*)(ws + WS_CTL);
    for (int u = F.tid; u < (LDS_BYTES - LDSCTL_OFF) / 4; u += NWAVES * 64) ((LAS unsigned*)(F.lds + LDSCTL_OFF))[u] = 0u;
    __syncthreads();
    XcdBarrier bar; bar.wave = F.wave; bar.bar = (unsigned*)(F.ctl + CW_BAR); bar.x = 0; bar.st = nullptr;
    if (N_LAUNCHES == 1) bar = xcd_barrier_post((unsigned*)(F.ctl + CW_BAR), F.MISC + 8, F.wave);
#ifdef PROBE_DOUBLE_BAR
#define GRID_BAR() do { if (N_LAUNCHES == 1) { xcd_barrier(bar); xcd_barrier(bar); } } while (0)
#else
#define GRID_BAR() do { if (N_LAUNCHES == 1) xcd_barrier(bar); } while (0)
#endif
    const int lo = args.ph_lo, hi = args.ph_hi;
#define IN(k) (lo <= (k) && (k) < hi)
#ifdef PROBE_REPEAT
#define PREP(k) int nrep_##k = ((PROBE_REPEAT == (k)) ? 2 : 1); asm volatile("" : "+s"(nrep_##k)); _Pragma("unroll 1") for (int rep_ = 0; rep_ < nrep_##k; ++rep_)
#else
#define PREP(k) for (int rep_ = 0; rep_ < 1; ++rep_)
#endif
#define BOTH(k) (IN(k) && IN((k) + 1))

    bf16* Wgu = (bf16*)(ws + WS_WGU); bf16* Wd = (bf16*)(ws + WS_WD); bf16* WinA = (bf16*)(ws + WS_WINA); bf16* WinB = (bf16*)(ws + WS_WINB);
    bf16* Wbr = (bf16*)(ws + WS_WBR); bf16* Wout = (bf16*)(ws + WS_WOUT);
    bf16* H = (bf16*)(ws + WS_H); bf16* A = (bf16*)(ws + WS_BIG);
    bf16* Q16 = (bf16*)(ws + WS_Q16); bf16* K16 = (bf16*)(ws + WS_K16); bf16* V16 = (bf16*)(ws + WS_V16); bf16* SG = K16;
    bf16* QI = (bf16*)(ws + WS_QI); bf16* KI = (bf16*)(ws + WS_KI); float* WI = (float*)(ws + WS_WI); float* LF = (float*)(ws + WS_LF); float* F2 = (float*)(ws + WS_F2);
    unsigned long long* MASK = (unsigned long long*)(ws + WS_MASK);
    const float* mod = (const float*)(ws + WS_MOD);
    bf16* X1B = (bf16*)F.out;
    bf16* X2B = (bf16*)(ws + WS_V16);

    if (IN(0)) { REFRESH_IDS();
#if defined(PROBE_REPEAT) && PROBE_REPEAT == 100
      for (int rep_ = 0; rep_ < 2; ++rep_) {
#else
      {
#endif
#ifdef PROBE_P0_NOGEMV
        if (rep_ == 1) {
#else
        {
#endif
        if ((int)blockIdx.x < 72) mod_gemv(F, (int)blockIdx.x, args.in[1], args.in[2], args.in[3]);
        }
        if ((int)blockIdx.x == 80) { float* gd = (float*)(ws + WS_GAINS); const int t = F.tid;
            if (F.wave == 0) {
                float mqf = fabsf(args.in[13][F.lane]), mkf = fabsf(args.in[14][F.lane]), mqd = fabsf(args.in[11][F.lane]), mkd = fabsf(args.in[12][F.lane]);
#pragma unroll
                for (int o = 1; o < 64; o <<= 1) { mqf = fmaxf(mqf, __shfl_xor(mqf, o)); mkf = fmaxf(mkf, __shfl_xor(mkf, o)); mqd = fmaxf(mqd, __shfl_xor(mqd, o)); mkd = fmaxf(mkd, __shfl_xor(mkd, o)); }
                if (F.lane == 0) { gd[264] = 64.f * 0.125f * 1.4426950408889634f * mqf * mkf; gd[265] = 64.f * 0.125f * 1.4426950408889634f * mqd * mkd; } }
            if (t < 264) gd[t] = (t < 64) ? args.in[11][t] : (t < 128) ? args.in[12][t - 64] : (t < 192) ? args.in[13][t - 128] : (t < 256) ? args.in[14][t - 192] : args.in[10][t - 256]; }
        if ((int)blockIdx.x == 81) build_attn_queues(F, args.in[10], args.in[13], args.in[14]);
        int base = 0;
        base = transpose_job64<true>(F, J_GU, args.in[5], args.in[6], Wgu, 2 * D_FF, D_MODEL, base, 32.f);
        transpose_job64<true>(F, J_D, args.in[7], nullptr, Wd, D_MODEL, D_FF, 0, 64.f, 0, 72, F.G - 72);
        base = transpose_job64<true>(F, J_INA, args.in[9], nullptr, ws + WS_WINA + 2 * MiB, 3072, D_MODEL, base, 32.f);
        base = transpose_job64<false>(F, J_INA, args.in[9], nullptr, WinA, 768, D_MODEL, base, 1.f, 48);
        transpose_job64<true>(F, J_INB, args.in[9], nullptr, WinB, 2048, D_MODEL, 704, 32.f, 0, 72, F.G - 72);
        base = transpose_job64<true>(F, J_BR, args.in[15], args.in[16], Wbr, 2048, D_MODEL, base, 32.f);
        base = transpose_job64<true>(F, J_OUT, args.in[17], nullptr, Wout, D_MODEL, D_MODEL, base, 32.f);
#ifdef PROBE_REPEAT
        __syncthreads();
#endif
      }
        if (BOTH(0)) GRID_BAR();
    }
    if (IN(1)) { REFRESH_IDS(); norm_phase8(F, args.in[0], args.in[4], 0, (unsigned char*)H); if (BOTH(1)) GRID_BAR(); }
    if (IN(2)) { REFRESH_IDS();
        pg8::Gemm g{H, Wgu, M, 2 * D_FF, D_MODEL / 2}; pg8::StaticOrder S; S.init(M, 2 * D_FF, F.G, (int)blockIdx.x);
        pg8::EpiSwiglu8 E{(unsigned char*)A, D_FF, 1.0f / 32.0f};
        pg8::gemm_phase<pg8::EpiSwiglu8, pg8::StaticOrder, true, true, true>(F.lds, g, S, E, F.wave);
#if defined(PROBE_REPEAT) && PROBE_REPEAT == 2
        __syncthreads(); pg8::gemm_phase<pg8::EpiSwiglu8, pg8::StaticOrder, true, true, true>(F.lds, g, S, E, F.wave);
#endif
        if (BOTH(2)) GRID_BAR();
    }
    if (IN(3)) { REFRESH_IDS();
        pg8::Gemm g{A, Wd, M, D_MODEL, D_FF / 2}; pg8::StaticOrder S; S.init(M, D_MODEL, F.G, (int)blockIdx.x);
        pg8::EpiResidT<false, true> E{args.in[0], X1B, mod + 2 * 1024, 0.5f / 64.0f};
        pg8::gemm_phase<pg8::EpiResidT<false, true>, pg8::StaticOrder, true, true, true>(F.lds, g, S, E, F.wave);
        if (BOTH(3)) GRID_BAR();
    }
    if (IN(4)) { REFRESH_IDS();
#if defined(PROBE_REPEAT) && PROBE_REPEAT == 104
      for (int rep_ = 0; rep_ < 2; ++rep_) {
#else
      {
#endif
        norm_phase<true>(F, X1B, args.in[8], 3, H, ws + WS_H8B);
      }
        if (BOTH(4)) GRID_BAR();
    }
    if (IN(5)) { REFRESH_IDS();
      PREP(5) {
        { pg8::Gemm g{H, WinA, M, 768, D_MODEL}; pg8::StaticOrder S; S.init(M, 768, F.G, (int)blockIdx.x);
          pg8::EpiInA E{Q16, QI, KI, WI, LF, (const float*)(ws + WS_GAINS), 12, 1.0f};
          pg8::gemm_phase<pg8::EpiInA, pg8::StaticOrder, true, true>(F.lds, g, S, E, F.wave); }
        { pg8::Gemm g{(const bf16*)(ws + WS_H8B), (const bf16*)(ws + WS_WINA + 2 * MiB), M, 3072, D_MODEL / 2}; pg8::StaticOrder S; S.init(M, 3072, F.G, (int)blockIdx.x);
          pg8::EpiInA E{Q16, QI, KI, WI, LF, (const float*)(ws + WS_GAINS), 0, 1.0f / 32.0f};
          pg8::gemm_phase<pg8::EpiInA, pg8::StaticOrder, true, true, true>(F.lds, g, S, E, F.wave); }
        __syncthreads(); }
        if (BOTH(5)) GRID_BAR();
    }
    if (IN(6)) { REFRESH_IDS();
        if ((int)blockIdx.x < 16 && F.wave == 0) fscan_row(LF + (size_t)blockIdx.x * SEQ, F2 + (size_t)blockIdx.x * SEQ, F.lane);
#ifdef PROBE_TWICE_P6
#pragma unroll 1
        for (int rep_ = 0; rep_ < 2; ++rep_) { int md = rep_ ? 3 : PROBE_TWICE_P6; asm volatile("" : "+s"(md));
#else
        { const int md = 3;
#endif
        i16_bf16x8v qa[4][4];
        { const int idx0 = F.vcu; if (idx0 < 1024) { const int j0 = 1023 - idx0; idx_load_q(qa, j0 & 1, j0 >> 1, QI); } }
#pragma unroll 1
        for (int i = 0; i * F.G < 1024; ++i) {
            const int idx = i * F.G + ((i & 1) ? (F.G - 1 - F.vcu) : F.vcu);
            if (idx >= 1024) continue;
            const int j = 1023 - idx;
            const int idxn = (i + 1) * F.G + (((i + 1) & 1) ? (F.G - 1 - F.vcu) : F.vcu), jn = 1023 - idxn;
            idx_unit16(F, j & 1, j >> 1, QI, KI, WI, MASK, F.vcu * 7 + i * 3, qa, jn & 1, idxn < 1024 ? (jn >> 1) : -1, md);
        }
        }
        if (BOTH(6)) GRID_BAR();
    }
    if (IN(7)) { REFRESH_IDS();
        const unsigned* ord = (const unsigned*)(ws + WS_AORDER); const float qmf = ((const float*)(ws + WS_GAINS))[264], qmd = ((const float*)(ws + WS_GAINS))[265];
        const int xg = (int)(blockIdx.x & 7);
      PREP(7) {
        int xs = 0;
        for (;;) {
            const int xq = (xg + xs) & 7;
            if (F.tid == 0) F.MISC[16] = __hip_atomic_fetch_add((unsigned*)(F.ctl + CW_AQUEUE + 64 * xq + 32 * rep_), 1u, __ATOMIC_RELAXED, __HIP_MEMORY_SCOPE_AGENT);
            __syncthreads();
            const unsigned qi = F.MISC[16];
            __syncthreads();
            if (qi >= ord[8 * AQ_CAP + xq]) { if (++xs == 8) break; continue; }
            const unsigned id = ord[xq * AQ_CAP + qi]; const int ty = (int)(id >> 9) & 1, b = (int)(id >> 8) & 1, h = (int)(id >> 5) & 7, qb = (int)(id & 31), pc = (int)(id >> 10) & 3, np = (int)(id >> 12) & 7;
#ifdef PROBE_SKIPTY
            if (rep_ == 0 && ty == PROBE_SKIPTY) continue;
#endif
            if (ty) { int np2, per; dsa_plan(h, qb, np2, per);
                      float* part = (float*)(ws + WS_H) + (size_t)((b * 2 + (h & 1)) * 16 + (qb & 15)) * (2 * 49 * 512);
                      att::attn_unit<1>(b, h, qb, Q16, K16, V16, ws + WS_O8, F2, MASK, (char*)lds, qmd, F.wave, pc, np, per, part, (unsigned*)(F.ctl + CW_PCTR + (b * 2 + (h & 1)) * 16 + (qb & 15) + 64 * rep_)); }
            else    att::attn_unit<0>(b, 8 + h, qb, Q16, K16, V16, ws + WS_O8, F2, MASK, (char*)lds, qmf, F.wave);
        }
      }
        REFRESH_IDS();
        ffn_copies_queue(F, F.ctl + CW_CQUEUE, args.in[19], args.in[20], args.in[21], Wgu, Wd);
        if (BOTH(7)) GRID_BAR();
    }
    if (IN(8)) { REFRESH_IDS();
        pg8::Gemm g{(const bf16*)(ws + WS_H8B), WinB, M, 2048, D_MODEL / 2}; pg8::StaticOrder S; S.init(M, 2048, F.G, (int)blockIdx.x);
        pg8::EpiGate E{SG, 1.0f / 32.0f};
        PREP(8) { pg8::gemm_phase<pg8::EpiGate, pg8::StaticOrder, true, true, true>(F.lds, g, S, E, F.wave); __syncthreads(); }
        if (BOTH(8)) GRID_BAR();
    }
    if (IN(9)) { REFRESH_IDS();
        pg8::Gemm g{(const bf16*)(ws + WS_O8), Wbr, M, 2048, D_MODEL / 2}; pg8::StaticOrder S; S.init(M, 2048, F.G, (int)blockIdx.x);
        pg8::EpiMerge E{SG, (unsigned char*)H, 1.0f / 32.0f};
        PREP(9) { pg8::gemm_phase<pg8::EpiMerge, pg8::StaticOrder, true, true, true>(F.lds, g, S, E, F.wave); __syncthreads(); }
        if (BOTH(9)) GRID_BAR();
    }
    if (IN(10)) { REFRESH_IDS();
        pg8::Gemm g{H, Wout, M, D_MODEL, D_MODEL / 2}; pg8::StaticOrder S; S.init(M, D_MODEL, F.G, (int)blockIdx.x);
        pg8::EpiResidT<true, true> E{X1B, X2B, mod + 5 * 1024, 1.0f / 32.0f};
        pg8::gemm_phase<pg8::EpiResidT<true, true>, pg8::StaticOrder, true, true, true>(F.lds, g, S, E, F.wave);
        if (BOTH(10)) GRID_BAR();
    }
    if (IN(11)) { REFRESH_IDS(); norm_phase8<true>(F, X2B, args.in[18], 6, (unsigned char*)H); if (BOTH(11)) GRID_BAR(); }
    if (IN(12)) { REFRESH_IDS();
        pg8::Gemm g{H, Wgu, M, 2 * D_FF, D_MODEL / 2}; pg8::StaticOrder S; S.init(M, 2 * D_FF, F.G, (int)blockIdx.x);
        pg8::EpiSwiglu8 E{(unsigned char*)A, D_FF, 1.0f / 32.0f};
        pg8::gemm_phase<pg8::EpiSwiglu8, pg8::StaticOrder, true, true, true>(F.lds, g, S, E, F.wave);
        if (BOTH(12)) GRID_BAR();
    }
    if (IN(13)) { REFRESH_IDS();
        pg8::Gemm g{A, Wd, M, D_MODEL, D_FF / 2}; pg8::StaticOrder S; S.init(M, D_MODEL, F.G, (int)blockIdx.x);
        pg8::EpiResidT<true, false> E{X2B, F.out, mod + 8 * 1024, 0.5f / 64.0f};
        pg8::gemm_phase<pg8::EpiResidT<true, false>, pg8::StaticOrder, true, true, true>(F.lds, g, S, E, F.wave);
    }
#undef IN
#undef BOTH
#undef GRID_BAR
}


#ifdef DBG_CHECK_MASK
__global__ void __launch_bounds__(512) dbg_check_mask(const unsigned char* ws, unsigned* counter) {
    __shared__ float s[8192];
    __shared__ float qv[512]; __shared__ float wv[8];
    const bf16* QI = (const bf16*)(ws + WS_QI); const bf16* KI = (const bf16*)(ws + WS_KI); const float* WI = (const float*)(ws + WS_WI);
    const unsigned long long* MASK = (const unsigned long long*)(ws + WS_MASK);
    const int b = blockIdx.x & 1, t = (int)(((unsigned)(blockIdx.x >> 1) * 2654435761u) % (unsigned)SEQ);
    if (t >= SEQ) return;
    const size_t rb = (size_t)b * SEQ;
    for (int i = threadIdx.x; i < 512; i += 512) qv[i] = __builtin_bit_cast(float, (unsigned)QI[(rb + t) * 512 + i] << 16);
    if (threadIdx.x < 8) wv[threadIdx.x] = WI[(rb + t) * 8 + threadIdx.x];
    __syncthreads();
    const int n = t + 1;
    for (int e = threadIdx.x; e < n; e += 512) {
        float sc = 0.f;
        _Pragma("unroll 1") for (int i = 0; i < 8; ++i) { float x = 0.f; _Pragma("unroll 4") for (int d = 0; d < 64; ++d) x += qv[i * 64 + d] * __builtin_bit_cast(float, (unsigned)KI[((rb + e) >> 5) * 2048 + ((d >> 3) * 32 + ((rb + e) & 31)) * 8 + (d & 7)] << 16); sc += wv[i] * fmaxf(x, 0.f); }
        s[e] = sc + 0.f;
    }
    __syncthreads();
    const int kk = n < 256 ? n : 256;
    unsigned bad = 0;
    for (int e = threadIdx.x; e < SEQ; e += 512) {
        bool sel = false;
        if (e < n) { const float se = s[e]; int rank = 0; _Pragma("unroll 4") for (int j = 0; j < n; ++j) { const float sj = s[j]; rank += (sj > se || (sj == se && j < e)) ? 1 : 0; } sel = rank < kk; }
        const bool got = (MASK[(rb + t) * 128 + (e >> 6)] >> (e & 63)) & 1ull;
        if (sel != got) ++bad;
    }
    if (bad) atomicAdd(counter, bad);
}
__global__ void dbg_report(float* out, const unsigned* counter) {
    const unsigned m = *counter; if (m == 0) return;
    int lg = 0; unsigned v = m; while (v > 1) { v >>= 1; ++lg; }
    out[0] += 100.f * (float)(1 + lg);
}
#endif

#ifdef DBG_CHECK_ATT
__device__ __forceinline__ float dbg_bf(unsigned short v) { return __builtin_bit_cast(float, (unsigned)v << 16); }
__device__ __forceinline__ void dbg_sample(int s, int& b, int& t, int& h) { b = s & 1; h = (s >> 1) & 15; t = (int)(((unsigned)(s >> 5) * 2654435761u + (unsigned)(s & 31) * 40503u) % (unsigned)SEQ); }
__global__ void dbg_save_q(const unsigned char* ws, float* save) {
    int b, t, h; dbg_sample(blockIdx.x, b, t, h);
    const bf16* Q16 = (const bf16*)(ws + WS_Q16);
    if (threadIdx.x < 64) save[blockIdx.x * 64 + threadIdx.x] = dbg_bf(Q16[((size_t)b * SEQ + t) * 1024 + h * 64 + threadIdx.x]);
}
__global__ void __launch_bounds__(256) dbg_check_att(const unsigned char* ws, const float* save, unsigned* counter) {
    __shared__ float lg[8192]; __shared__ int sel[512]; __shared__ int nsel; __shared__ float q[64]; __shared__ float red[2]; __shared__ float rm[256];
    int b, t, h; dbg_sample(blockIdx.x, b, t, h);
    const bf16* O16 = (const bf16*)(ws + WS_Q16); const bf16* K16 = (const bf16*)(ws + WS_K16); const bf16* V16 = (const bf16*)(ws + WS_V16);
    const unsigned long long* MASK = (const unsigned long long*)(ws + WS_MASK); const float* F2 = (const float*)(ws + WS_F2);
    const size_t rb = (size_t)b * SEQ;
    if (threadIdx.x < 64) q[threadIdx.x] = save[blockIdx.x * 64 + threadIdx.x];
    __syncthreads();
    const int n = t + 1;
    if (h < 8) {
        const float sl2 = exp2f(-(float)(h + 1)) * 1.4426950408889634f;
        for (int s = threadIdx.x; s < n; s += 256) { float x = -INFINITY;
            if ((MASK[(rb + t) * 128 + (s >> 6)] >> (s & 63)) & 1ull) { x = 0.f; _Pragma("unroll 4") for (int d = 0; d < 64; ++d) x += q[d] * dbg_bf(K16[(rb + s) * 1024 + h * 64 + d]); x += sl2 * (float)(s - t); }
            lg[s] = x; }
    } else {
        const float* f2 = F2 + ((size_t)b * 8 + (h - 8)) * SEQ; const float fq = f2[t];
        for (int s = threadIdx.x; s < n; s += 256) { float x = 0.f; _Pragma("unroll 4") for (int d = 0; d < 64; ++d) x += q[d] * dbg_bf(K16[(rb + s) * 1024 + h * 64 + d]); lg[s] = x + fq - f2[s]; }
    }
    __syncthreads();
    { float m = -INFINITY; for (int s = threadIdx.x; s < n; s += 256) m = fmaxf(m, lg[s]); rm[threadIdx.x] = m; }
    __syncthreads();
    if (threadIdx.x == 0) { float m = -INFINITY; for (int i = 0; i < 256; ++i) m = fmaxf(m, rm[i]); red[0] = m; }
    __syncthreads();
    { float l = 0.f; for (int s = threadIdx.x; s < n; s += 256) { const float p = exp2f(lg[s] - red[0]); lg[s] = p; l += p; } rm[threadIdx.x] = l; }
    __syncthreads();
    if (threadIdx.x == 0) { float l = 0.f; for (int i = 0; i < 256; ++i) l += rm[i]; red[1] = l; }
    __syncthreads();
    if (threadIdx.x < 64) { const int d = threadIdx.x; float o = 0.f;
        for (int s = 0; s < n; ++s) { const float p = lg[s]; if (p != 0.f) o += p * dbg_bf(V16[(rb + s) * 1024 + h * 64 + d]); }
        o /= red[1];
        const float got = dbg_bf(O16[(rb + t) * 1024 + h * 64 + d]);
        if (!(fabsf(got - o) <= 0.03f + 0.03f * fabsf(o))) atomicAdd(counter + (h < 8 ? 0 : 1), 1u); }
    (void)sel; (void)nsel;
}
__global__ void __launch_bounds__(256) dbg_check_proj(const unsigned char* ws, const float* w_in, unsigned* counter) {
    const bf16* H = (const bf16*)(ws + WS_H); const bf16* QI = (const bf16*)(ws + WS_QI); const bf16* KI = (const bf16*)(ws + WS_KI); const float* WI = (const float*)(ws + WS_WI);
    const int m = (blockIdx.x * 131 + 17) & (M - 1);
    __shared__ float hrow[1024];
    for (int i = threadIdx.x; i < 1024; i += 256) hrow[i] = dbg_bf(H[(size_t)m * 1024 + i]);
    __syncthreads();
    for (int c = threadIdx.x; c < 584; c += 256) {
        const int col = 3072 + c; float z = 0.f;
        _Pragma("unroll 4") for (int k2 = 0; k2 < 1024; ++k2) z += hrow[k2] * w_in[(size_t)k2 * IN_WIDTH + col];
        float got, ref;
        if (c < 512) { ref = z * 0.125f; got = dbg_bf(QI[(size_t)m * 512 + c]); }
        else if (c < 576) { ref = z; got = dbg_bf(KI[(size_t)m * 64 + (c - 512)]); }
        else { ref = z * 0.35355339059327373f; got = WI[(size_t)m * 8 + (c - 576)]; }
        const float tol = (c < 512 ? 0.125f : 1.f) * 0.04f + 0.02f * fabsf(ref);
        if (!(fabsf(got - ref) <= tol)) atomicAdd(counter + 2, 1u);
    }
}

__global__ void __launch_bounds__(256) dbg_check_qkv(const unsigned char* ws, const float* w_in, unsigned* counter) {
    const bf16* H = (const bf16*)(ws + WS_H); const bf16* QKV = (const bf16*)(ws + WS_Q16); const float* gains = (const float*)(ws + WS_GAINS);
    const int m = (blockIdx.x * 257 + 5) & (M - 1);
    __shared__ float hrow[1024]; __shared__ float zs[3072];
    for (int i = threadIdx.x; i < 1024; i += 256) hrow[i] = dbg_bf(H[(size_t)m * 1024 + i]);
    __syncthreads();
    for (int c = threadIdx.x; c < 3072; c += 256) { float z = 0.f; _Pragma("unroll 4") for (int k2 = 0; k2 < 1024; ++k2) z += hrow[k2] * w_in[(size_t)k2 * IN_WIDTH + c]; zs[c] = z; }
    __syncthreads();
    for (int c = threadIdx.x; c < 3072; c += 256) {
        const int sec = c >> 9, head = (c >> 6) & 7, d = c & 63;
        float ref = zs[c], scale = 1.f;
        if (sec != 2 && sec != 5) { float ss = 0.f; for (int j = 0; j < 64; ++j) { const float v = zs[(c & ~63) + j]; ss += v * v; }
            const float rstd = 1.f / sqrtf(ss / 64.f + 1e-6f); const int gi = sec - (sec >= 3 ? 1 : 0);
            ref = ref * rstd * gains[64 * gi + d]; if (sec == 0 || sec == 3) { ref *= 0.125f * 1.4426950408889634f; scale = 0.18f; } }
        const int which = (sec == 0 || sec == 3) ? 0 : (sec == 1 || sec == 4) ? 1 : 2;
        const float got = dbg_bf(QKV[(size_t)which * 16777216 + (size_t)m * 1024 + (sec >= 3 ? 512 : 0) + head * 64 + d]);
        if (!(fabsf(got - ref) <= 0.04f * scale + 0.03f * fabsf(ref))) atomicAdd(counter + 3, 1u);
    }
}
__global__ void __launch_bounds__(256) dbg_check_gate(const unsigned char* ws, const float* w_in, unsigned* counter) {
    const bf16* H = (const bf16*)(ws + WS_H); const bf16* SG = (const bf16*)(ws + WS_K16);
    const int m = (blockIdx.x * 263 + 11) & (M - 1);
    __shared__ float hrow[1024];
    for (int i = threadIdx.x; i < 1024; i += 256) hrow[i] = dbg_bf(H[(size_t)m * 1024 + i]);
    __syncthreads();
    for (int c = threadIdx.x; c < 2048; c += 256) { float z = 0.f; _Pragma("unroll 4") for (int k2 = 0; k2 < 1024; ++k2) z += hrow[k2] * w_in[(size_t)k2 * IN_WIDTH + 3664 + c];
        const float ref = 1.f / (1.f + expf(-z)), got = dbg_bf(SG[(size_t)m * 2048 + c]);
        if (!(fabsf(got - ref) <= 0.02f)) { atomicAdd(counter + 4, 1u); if (atomicAdd(counter + 32 + blockIdx.x, 1u) == 0u) atomicAdd(counter + 8, 1u); atomicOr(counter + 9, 1u << (c >> 8)); } }
}
__global__ void __launch_bounds__(256) dbg_check_merge(const unsigned char* ws, const float* wbd, const float* wbf, unsigned* counter) {
    const bf16* Hm = (const bf16*)(ws + WS_H); const bf16* SG = (const bf16*)(ws + WS_K16); const bf16* O16 = (const bf16*)(ws + WS_Q16);
    const int m = (blockIdx.x * 269 + 3) & (M - 1);
    __shared__ float orow[1024];
    for (int i = threadIdx.x; i < 1024; i += 256) orow[i] = dbg_bf(O16[(size_t)m * 1024 + i]);
    __syncthreads();
    for (int c = threadIdx.x; c < 1024; c += 256) { float yd = 0.f, yf = 0.f;
        _Pragma("unroll 4") for (int k2 = 0; k2 < 512; ++k2) { yd += orow[k2] * wbd[(size_t)k2 * 1024 + c]; yf += orow[512 + k2] * wbf[(size_t)k2 * 1024 + c]; }
        const float ref = dbg_bf(SG[(size_t)m * 2048 + c]) * yd + dbg_bf(SG[(size_t)m * 2048 + 1024 + c]) * yf, got = dbg_bf(Hm[(size_t)m * 1024 + c]);
        if (!(fabsf(got - ref) <= 0.03f + 0.03f * fabsf(ref))) atomicAdd(counter + 5, 1u); }
}
__global__ void dbg_save_out(const float* out, float* save) { const int m = (blockIdx.x * 271 + 7) & (M - 1); for (int i = threadIdx.x; i < 1024; i += 256) save[blockIdx.x * 1024 + i] = out[(size_t)m * 1024 + i]; }
__global__ void __launch_bounds__(256) dbg_check_out(const unsigned char* ws, const float* out, const float* save, const float* w_out, unsigned* counter) {
    const bf16* Hm = (const bf16*)(ws + WS_H); const float* mod = (const float*)(ws + WS_MOD);
    const int m = (blockIdx.x * 271 + 7) & (M - 1), b = m >> 13;
    __shared__ float hrow[1024];
    for (int i = threadIdx.x; i < 1024; i += 256) hrow[i] = dbg_bf(Hm[(size_t)m * 1024 + i]);
    __syncthreads();
    for (int c = threadIdx.x; c < 1024; c += 256) { float z = 0.f; _Pragma("unroll 4") for (int k2 = 0; k2 < 1024; ++k2) z += hrow[k2] * w_out[(size_t)k2 * 1024 + c];
        const float ref = save[blockIdx.x * 1024 + c] + mod[b * 9216 + 5 * 1024 + c] * z, got = out[(size_t)m * 1024 + c];
        if (!(fabsf(got - ref) <= 0.02f + 0.01f * fabsf(ref))) atomicAdd(counter + 6, 1u); }
}

__global__ void __launch_bounds__(256) dbg_check_ffn_a(const unsigned char* ws, const float* wg, const float* wu, unsigned* counter) {
    const bf16* H = (const bf16*)(ws + WS_H); const bf16* A = (const bf16*)(ws + WS_BIG);
    const int m = (blockIdx.x * 277 + 13) & (M - 1);
    __shared__ float hrow[1024];
    for (int i = threadIdx.x; i < 1024; i += 256) hrow[i] = dbg_bf(H[(size_t)m * 1024 + i]);
    __syncthreads();
    for (int c = threadIdx.x; c < D_FF; c += 256) { float zg = 0.f, zu = 0.f;
        _Pragma("unroll 4") for (int k2 = 0; k2 < 1024; ++k2) { zg += hrow[k2] * wg[(size_t)k2 * D_FF + c]; zu += hrow[k2] * wu[(size_t)k2 * D_FF + c]; }
        const float ref = zg / (1.f + expf(-zg)) * zu, got = dbg_bf(A[(size_t)m * D_FF + c]);
        if (!(fabsf(got - ref) <= 0.04f + 0.03f * fabsf(ref))) { atomicAdd(counter + 10, 1u); if (atomicAdd(counter + 320 + blockIdx.x, 1u) == 0u) atomicAdd(counter + 11, 1u); } }
}
__global__ void dbg_report2(float* out, const unsigned* counter) {
    if (counter[10]) { int d1 = 0; unsigned v = counter[11]; while (v) { v >>= 1; ++d1; } if (d1 > 9) d1 = 9;
        int d2 = 0; v = counter[10]; while (v > 1) { v >>= 1; ++d2; } d2 = d2 / 2; if (d2 > 9) d2 = 9;
        out[9] += (float)(d1 * 10 + d2) * 1e12f; }
    if (counter[4]) { int d1 = 0; unsigned v = counter[8]; while (v) { v >>= 1; ++d1; } if (d1 > 9) d1 = 9;
        int d2 = 0; v = counter[4]; while (v > 1) { v >>= 1; ++d2; } d2 = d2 / 2; if (d2 > 9) d2 = 9;
        out[7] += (float)(d1 * 10 + d2) * 1e9f; out[8] += (float)counter[9] * 1e7f; }
    const float code[7] = {1e2f, 1e3f, 1e4f, 1e8f, 1e7f, 1e6f, 1e5f};
    for (int j = 0; j < 7; ++j) { const unsigned m = counter[j]; if (m == 0) continue;
        int lgv = 0; unsigned v = m; while (v > 1) { v >>= 1; ++lgv; } if (lgv > 8) lgv = 8;
        out[j] += code[j] * (float)(1 + lgv); }
}
#endif
extern "C" void kernel_launch(void* const* d_in, const int* in_sizes, int n_in, void* d_out, int out_size, void* d_ws, size_t ws_size, hipStream_t stream) {
    static int grid = 0;
    if (grid == 0) {
        if (n_in != 22 || in_sizes[0] != M * D_MODEL || out_size != M * D_MODEL || ws_size < WS_END) {
            fprintf(stderr, "kernel_launch: unexpected shapes: n_in %d in0 %d out %d ws %zu (need %zu)\n", n_in, n_in > 0 ? in_sizes[0] : -1, out_size, ws_size, (size_t)WS_END); grid = -1; return; }
        int dev = 0, cus = 0, per_cu = 0;
        if (hipGetDevice(&dev) != hipSuccess || hipDeviceGetAttribute(&cus, hipDeviceAttributeMultiprocessorCount, dev) != hipSuccess) { grid = -1; return; }
        if (hipFuncSetAttribute((const void*)fwd_mega, hipFuncAttributeMaxDynamicSharedMemorySize, LDS_BYTES) != hipSuccess) { fprintf(stderr, "kernel_launch: hipFuncSetAttribute failed\n"); grid = -1; return; }
        if (hipOccupancyMaxActiveBlocksPerMultiprocessor(&per_cu, (const void*)fwd_mega, NWAVES * 64, LDS_BYTES) != hipSuccess || per_cu < 1) {
            fprintf(stderr, "kernel_launch: occupancy query reports %d blocks per CU; nothing launched\n", per_cu); (void)hipGetLastError(); grid = -1; return; }
        (void)hipGetLastError();
        if (cus != 256) { fprintf(stderr, "kernel_launch: built for a 256-CU device, found %d CUs; nothing launched\n", cus); grid = -1; return; }
        grid = cus;
        if (grid != 256) fprintf(stderr, "kernel_launch: note: %d CUs\n", grid);
    }
    if (grid < 0) return;
    if (hipMemsetAsync((char*)d_ws + WS_CTL, 0, CTL_ZERO_BYTES, stream) != hipSuccess) return;
    Args a{};
    for (int i = 0; i < 22; ++i) a.in[i] = (const float*)d_in[i];
    a.out = (float*)d_out; a.ws = (unsigned char*)d_ws;
    for (int li = 0; li < N_LAUNCHES; ++li) {
#ifdef PROBE_SKIP_LO
        if (li >= PROBE_SKIP_LO && li <= PROBE_SKIP_HI) continue;
#endif
        a.ph_lo = (N_LAUNCHES == 1) ? 0 : li; a.ph_hi = (N_LAUNCHES == 1) ? N_PHASES : li + 1; a.li = li;
        hipLaunchKernelGGL(fwd_mega, dim3(grid), dim3(NWAVES * 64), LDS_BYTES, stream, a);
        const hipError_t le = hipPeekAtLastError();
        if (le != hipSuccess) { fprintf(stderr, "kernel_launch: launch %d failed: %s\n", li, hipGetErrorName(le)); break; }
#ifdef DBG_CHECK_ATT
        if (li == 6) { hipLaunchKernelGGL(dbg_save_q, dim3(4096), dim3(64), 0, stream, (const unsigned char*)d_ws, (float*)((char*)d_ws + 210 * MiB));
                       hipLaunchKernelGGL(dbg_check_proj, dim3(128), dim3(256), 0, stream, (const unsigned char*)d_ws, (const float*)d_in[9], (unsigned*)d_ws + 16); }
        if (li == 2) hipLaunchKernelGGL(dbg_check_ffn_a, dim3(256), dim3(256), 0, stream, (const unsigned char*)d_ws, (const float*)d_in[5], (const float*)d_in[6], (unsigned*)d_ws + 16);
        if (li == 6) hipLaunchKernelGGL(dbg_check_qkv, dim3(256), dim3(256), 0, stream, (const unsigned char*)d_ws, (const float*)d_in[9], (unsigned*)d_ws + 16);
        if (li == 8) hipLaunchKernelGGL(dbg_check_gate, dim3(256), dim3(256), 0, stream, (const unsigned char*)d_ws, (const float*)d_in[9], (unsigned*)d_ws + 16);
        if (li == 9) { hipLaunchKernelGGL(dbg_check_merge, dim3(256), dim3(256), 0, stream, (const unsigned char*)d_ws, (const float*)d_in[15], (const float*)d_in[16], (unsigned*)d_ws + 16);
                       hipLaunchKernelGGL(dbg_save_out, dim3(256), dim3(256), 0, stream, (const float*)d_out, (float*)((char*)d_ws + 212 * MiB)); }
        if (li == 10) hipLaunchKernelGGL(dbg_check_out, dim3(256), dim3(256), 0, stream, (const unsigned char*)d_ws, (const float*)d_out, (const float*)((char*)d_ws + 212 * MiB), (const float*)d_in[17], (unsigned*)d_ws + 16);
        if (li == 7) hipLaunchKernelGGL(dbg_check_att, dim3(4096), dim3(256), 0, stream, (const unsigned char*)d_ws, (const float*)((char*)d_ws + 210 * MiB), (unsigned*)d_ws + 16);
#endif
#ifdef DBG_CHECK_MASK
        if (li == 6) hipLaunchKernelGGL(dbg_check_mask, dim3(1024), dim3(512), 0, stream, (const unsigned char*)d_ws, (unsigned*)d_ws + 8);
#endif
    }
#ifdef DBG_CHECK_ATT
    hipLaunchKernelGGL(dbg_report2, dim3(1), dim3(1), 0, stream, (float*)d_out, (const unsigned*)d_ws + 16);
#endif
#ifdef DBG_CHECK_MASK
    hipLaunchKernelGGL(dbg_report, dim3(1), dim3(1), 0, stream, (float*)d_out, (const unsigned*)d_ws + 8);
#endif
}
```
